# Optimizing an MI355X kernel written in HIP

```python
import math
import jax, jax.numpy as jnp
from jax import lax
import numpy as np

D_MODEL = 2048
BATCH = 4
SEQ = 2048
DEPTH = 4
DEC_BATCH = 128
DEC_SEQ = 1
PAST_LEN = 16384
PAGE_SIZE = 128

D_CONV = D_MODEL // 2
D_GDN = D_MODEL - D_CONV
GDN_HEADS = 8
HEAD_DIM = D_GDN // GDN_HEADS
CONV_A_WIDTH = 3
CONV_QKV_WIDTH = 4
CHUNK = 64
EPS = 1e-6
SPLIT_SIZES = (D_CONV, D_CONV, D_CONV, D_CONV, 3 * D_GDN, D_GDN, GDN_HEADS, GDN_HEADS)
SPLIT_POINTS = tuple(int(v) for v in np.cumsum(SPLIT_SIZES)[:-1])
D_IN_PROJ = sum(SPLIT_SIZES)

kernel_name = 'hybrid_shortconv_gdn_adaln_step'


def rmsnorm(x, g):
    xf = x.astype(jnp.float32)
    y = xf * lax.rsqrt(jnp.mean(xf * xf, axis=-1, keepdims=True) + EPS)
    return (y * g.astype(jnp.float32)).astype(x.dtype)


def l2norm(x):
    return x * lax.rsqrt(jnp.sum(x * x, axis=-1, keepdims=True) + EPS)


def causal_depthwise_conv(x, buf, w):
    width = w.shape[0]
    t = x.shape[1]
    xx = jnp.concatenate([buf.astype(x.dtype), x], axis=1)
    y = sum(xx[:, j:j + t] * w[j].astype(x.dtype) for j in range(width))
    return y, xx[:, t:]


def gated_delta_rule(q, k, v, g, beta, s0):
    b, t, h, dk = q.shape
    dv = v.shape[-1]
    f32 = jnp.float32
    c = min(CHUNK, t)
    n = -(-t // c)
    pad = n * c - t

    def prep(a):
        a = a.astype(f32)
        a = jnp.pad(a, [(0, 0), (0, pad)] + [(0, 0)] * (a.ndim - 2))
        a = a.reshape((b, n, c) + a.shape[2:])
        return jnp.moveaxis(a, 3, 1)

    q, k, v, g, beta = prep(q), prep(k), prep(v), prep(g), prep(beta)
    q = q * (dk ** -0.5)
    gc = jnp.cumsum(g, axis=-1)
    idx = jnp.arange(c)
    strict = idx[:, None] > idx[None, :]
    causal = idx[:, None] >= idx[None, :]
    diff = gc[..., :, None] - gc[..., None, :]
    decay_strict = jnp.exp(jnp.where(strict, diff, -jnp.inf))
    decay_causal = jnp.exp(jnp.where(causal, diff, -jnp.inf))
    kb = k * beta[..., None]
    lmat = jnp.einsum('bhnid,bhnjd->bhnij', kb, k) * decay_strict
    eye = jnp.eye(c, dtype=f32)
    tmat = lax.linalg.triangular_solve(eye + lmat, jnp.broadcast_to(eye, lmat.shape),
                                       left_side=True, lower=True, unit_diagonal=True)
    eg = jnp.exp(gc)[..., None]
    u_base = tmat @ (v * beta[..., None])
    w_dec = tmat @ (kb * eg)
    attn = jnp.einsum('bhnid,bhnjd->bhnij', q, k) * decay_causal
    q_dec = q * eg
    k_tail = k * jnp.exp(gc[..., -1:] - gc)[..., None]
    g_last = jnp.exp(gc[..., -1])

    def step(s, xs):
        u_b, w_c, a_c, q_c, kt_c, gl_c = xs
        u = u_b - w_c @ s
        o = q_c @ s + a_c @ u
        s = s * gl_c[..., None, None] + jnp.einsum('bhcd,bhce->bhde', kt_c, u)
        return s, o

    xs = tuple(jnp.moveaxis(a, 2, 0) for a in (u_base, w_dec, attn, q_dec, k_tail, g_last))
    s, o = lax.scan(step, s0.astype(f32), xs)
    o = jnp.moveaxis(o, 0, 2).reshape(b, h, n * c, dv)[:, :, :t]
    return jnp.moveaxis(o, 1, 2), s


def mixer_layer(x, c, conv_a_buf, conv_qkv_buf, s0, norm_g, w_ada, b_ada, w_in, conv_a_w,
                conv_qkv_w, a_log, dt_bias, o_norm_g, w_out):
    f32 = jnp.float32
    bsz, t, _ = x.shape
    mod = jax.nn.silu(c) @ w_ada + b_ada
    shift, scale, gate = jnp.split(mod[:, None, :], 3, axis=-1)
    h = rmsnorm(x, norm_g) * (1.0 + scale) + shift
    z = h @ w_in
    b_a, c_a, h_a, g_a, qkv, g_b, beta_logit, alpha_logit = jnp.split(z, SPLIT_POINTS, axis=-1)
    conv_out, new_a_buf = causal_depthwise_conv(c_a * h_a, conv_a_buf, conv_a_w)
    y_a = b_a * conv_out * jax.nn.silu(g_a)
    qkv_c, new_qkv_buf = causal_depthwise_conv(qkv, conv_qkv_buf, conv_qkv_w)
    qkv_c = jax.nn.silu(qkv_c).astype(f32)
    q, k, v = [a.reshape(bsz, t, GDN_HEADS, HEAD_DIM) for a in jnp.split(qkv_c, 3, axis=-1)]
    q, k = l2norm(q), l2norm(k)
    beta = jax.nn.sigmoid(beta_logit.astype(f32))
    g = -jnp.exp(a_log.astype(f32)) * jax.nn.softplus(alpha_logit.astype(f32) + dt_bias.astype(f32))
    o, s = gated_delta_rule(q, k, v, g, beta, s0)
    o = rmsnorm(o, o_norm_g).reshape(bsz, t, D_GDN).astype(x.dtype) * jax.nn.silu(g_b)
    y = jnp.concatenate([y_a, o], axis=-1) @ w_out
    return x + gate * y, new_a_buf, new_qkv_buf, s.astype(s0.dtype)


def trunk(x, c, conv_a0, conv_qkv0, ssm0, norm_g, w_ada, b_ada, w_in, conv_a_w, conv_qkv_w,
          a_log, dt_bias, o_norm_g, w_out, final_norm_g):
    new_a, new_qkv, new_s = [], [], []
    for i in range(DEPTH):
        x, a_buf, qkv_buf, s = mixer_layer(x, c, conv_a0[i], conv_qkv0[i], ssm0[i], norm_g[i],
                                           w_ada[i], b_ada[i], w_in[i], conv_a_w[i], conv_qkv_w[i],
                                           a_log[i], dt_bias[i], o_norm_g[i], w_out[i])
        new_a.append(a_buf)
        new_qkv.append(qkv_buf)
        new_s.append(s)
    return rmsnorm(x, final_norm_g), jnp.stack(new_a), jnp.stack(new_qkv), jnp.stack(new_s)


def setup_inputs(seed: int = 0) -> dict:
    key = jax.random.key(seed)
    ks = jax.random.split(key, 18)
    f32 = jnp.float32

    def nrm(k, shape, s):
        return jax.random.normal(k, shape, f32) * s

    x_prompt = nrm(ks[0], (BATCH, SEQ, D_MODEL), 1.0)
    x_sample = nrm(ks[1], (DEC_BATCH, DEC_SEQ, D_MODEL), 1.0)
    state_conv_a = nrm(ks[2], (DEPTH, DEC_BATCH, CONV_A_WIDTH - 1, D_CONV), 1.0)
    state_conv_qkv = nrm(ks[3], (DEPTH, DEC_BATCH, CONV_QKV_WIDTH - 1, 3 * D_GDN), 1.0)
    state_ssm = nrm(ks[4], (DEPTH, DEC_BATCH, GDN_HEADS, HEAD_DIM, HEAD_DIM), 0.1)
    c_prompt = nrm(ks[5], (BATCH, D_MODEL), 1.0)
    c_sample = nrm(ks[6], (DEC_BATCH, D_MODEL), 1.0)
    norm_g = 1.0 + nrm(ks[7], (DEPTH, D_MODEL), 0.02)
    w_ada = nrm(ks[8], (DEPTH, D_MODEL, 3 * D_MODEL), 0.5 * D_MODEL ** -0.5)
    b_ada = nrm(ks[9], (DEPTH, 3 * D_MODEL), 0.02)
    w_in = nrm(ks[10], (DEPTH, D_MODEL, D_IN_PROJ), D_MODEL ** -0.5)
    conv_a_w = nrm(ks[11], (DEPTH, CONV_A_WIDTH, D_CONV), CONV_A_WIDTH ** -0.5)
    conv_qkv_w = nrm(ks[12], (DEPTH, CONV_QKV_WIDTH, 3 * D_GDN), CONV_QKV_WIDTH ** -0.5)
    a_log = jnp.log(jax.random.uniform(ks[13], (DEPTH, GDN_HEADS), f32, 1.0, 16.0))
    dt = jnp.exp(jax.random.uniform(ks[14], (DEPTH, GDN_HEADS), f32, math.log(1e-3), math.log(1e-1)))
    dt_bias = dt + jnp.log(-jnp.expm1(-dt))
    o_norm_g = 1.0 + nrm(ks[15], (DEPTH, HEAD_DIM), 0.02)
    w_out = nrm(ks[16], (DEPTH, D_MODEL, D_MODEL), D_MODEL ** -0.5)
    final_norm_g = 1.0 + nrm(ks[17], (D_MODEL,), 0.02)
    return {'x_prompt': x_prompt, 'x_sample': x_sample, 'state_conv_a': state_conv_a,
            'state_conv_qkv': state_conv_qkv, 'state_ssm': state_ssm, 'c_prompt': c_prompt,
            'c_sample': c_sample, 'norm_g': norm_g, 'w_ada': w_ada, 'b_ada': b_ada, 'w_in': w_in,
            'conv_a_w': conv_a_w, 'conv_qkv_w': conv_qkv_w, 'a_log': a_log, 'dt_bias': dt_bias,
            'o_norm_g': o_norm_g, 'w_out': w_out, 'final_norm_g': final_norm_g}


def reference(x_prompt, x_sample, state_conv_a, state_conv_qkv, state_ssm, c_prompt, c_sample,
              norm_g, w_ada, b_ada, w_in, conv_a_w, conv_qkv_w, a_log, dt_bias, o_norm_g, w_out,
              final_norm_g):
    bp = x_prompt.shape[0]
    zeros_a = jnp.zeros((DEPTH, bp, CONV_A_WIDTH - 1, D_CONV), x_prompt.dtype)
    zeros_qkv = jnp.zeros((DEPTH, bp, CONV_QKV_WIDTH - 1, 3 * D_GDN), x_prompt.dtype)
    zeros_s = jnp.zeros((DEPTH, bp, GDN_HEADS, HEAD_DIM, HEAD_DIM), state_ssm.dtype)
    y_prompt, conv_a_p, conv_qkv_p, ssm_p = trunk(
        x_prompt, c_prompt, zeros_a, zeros_qkv, zeros_s, norm_g, w_ada, b_ada, w_in, conv_a_w,
        conv_qkv_w, a_log, dt_bias, o_norm_g, w_out, final_norm_g)
    y_sample, conv_a_s, conv_qkv_s, ssm_s = trunk(
        x_sample, c_sample, state_conv_a, state_conv_qkv, state_ssm, norm_g, w_ada, b_ada, w_in,
        conv_a_w, conv_qkv_w, a_log, dt_bias, o_norm_g, w_out, final_norm_g)
    return (y_prompt, y_sample, conv_a_p, conv_qkv_p, ssm_p, conv_a_s, conv_qkv_s, ssm_s)
```

```cpp
#include <hip/hip_runtime.h>
#include <hip/hip_cooperative_groups.h>
#include <cstdio>
#include <cstdint>
namespace cg = cooperative_groups;
namespace pg8 {
#define PG8_LAS __attribute__((address_space(3)))
typedef unsigned short bf16_t;
typedef short bf16x8 __attribute__((ext_vector_type(8)));
typedef float f32x4 __attribute__((ext_vector_type(4)));
typedef unsigned u32x4 __attribute__((ext_vector_type(4)));
constexpr int BM = 256, BK = 64, HALF = 128, HTB = HALF * BK * 2  , STAGE_BYTES = 8 * HTB, NXCD = 8, WGM = 8;

__host__ __device__ __forceinline__ int lds_byte(int r, int c) { const int st = (r >> 4) * 2 + (c >> 5), rr = r & 15, cc = c & 31, ob = rr * 64 + cc * 2; return st * 1024 + (ob ^ (((ob >> 9) & 1) << 5)); }
__host__ __device__ __forceinline__ void stage_rc(int b, int& R, int& C) { const int st = b / 1024, sb = b % 1024, swz = sb ^ (((sb >> 9) & 1) << 5); R = (st >> 1) * 16 + swz / 64; C = (st & 1) * 32 + (swz % 64) / 2; }
__host__ __device__ __forceinline__ int perm32(int rho) { const int n = rho >> 4, i = rho & 15; return 8 * (i >> 2) + 4 * n + (i & 3); }

struct Unit { int pm, pn; };
struct Gemm { const bf16_t* A; const bf16_t* Bt; int M, N, K; };

struct StaticOrder {
    int nM, nN, nwg, G, c;
    __host__ __device__ void init(int M, int N, int G_, int c_) { nM = M / BM; nN = N / BM; nwg = nM * nN; G = G_; c = c_; }
    __host__ __device__ bool next(int i, Unit& u) const {
        const long L = (long)i * G + c; if (L >= nwg) return false;
        int wgid = (int)L; { const int q = nwg / NXCD, r = nwg % NXCD, xcd = wgid % NXCD, off = wgid / NXCD; wgid = (xcd < r ? xcd * (q + 1) : r * (q + 1) + (xcd - r) * q) + off; }
        const int nig = WGM * nN, gid = wgid / nig, fm = gid * WGM, gsz = (nM - fm) < WGM ? (nM - fm) : WGM;
        u.pm = fm + ((wgid % nig) % gsz); u.pn = (wgid % nig) / gsz; return true;
    }
    __device__ __forceinline__ void a_ready(const Unit&) const {}
    __device__ __forceinline__ void done(const Unit&) const {}
};

__device__ __forceinline__ unsigned cvt_pk_bf16(float lo, float hi) { unsigned r; asm("v_cvt_pk_bf16_f32 %0, %1, %2" : "=v"(r) : "v"(lo), "v"(hi)); return r; }
typedef float f32x2 __attribute__((ext_vector_type(2)));
__device__ __forceinline__ f32x2 gelu_pk(f32x2 v) {
    const f32x2 av = __builtin_elementwise_abs(v), d = av * 0.2316418882f + 1.0f;
    f32x2 t; t.x = __builtin_amdgcn_rcpf(d.x); t.y = __builtin_amdgcn_rcpf(d.y);
    f32x2 q = t * 0.5307027145f + (-0.7265760135f); q = q * t + 0.7107068705f; q = q * t + (-0.142248368f); q = q * t + 0.127414796f; q = q * t;
    const f32x2 s = (v * v) * (-0.72134752044f);
    f32x2 e; e.x = __builtin_amdgcn_exp2f(s.x); e.y = __builtin_amdgcn_exp2f(s.y);
    const f32x2 m = v * (q * e), r = v - m;
    f32x2 o; o.x = v.x < 0.f ? m.x : r.x; o.y = v.y < 0.f ? m.y : r.y; return o;
}

template <int ACT  > struct EpiBf16 {
    static constexpr bool PERM = true, AFTER_DRAIN = false; static_assert(ACT == 0 || ACT == 1, "EpiBf16: ACT is 0 (none) or 1 (gelu_pk)");
    bf16_t* O; int ldc; const float* bias; int split_cols; size_t split_stride; float scale0;
    __device__ __forceinline__ void operator()(const f32x4 (&acc)[2][2][4][2], const Unit& u, int wr, int wc, int fr, int fq) const {
        const int row0 = u.pm * BM + wr * 64 + fr; int colt = u.pn * BM; bf16_t* base = O;
        float sc = 1.f; if (split_cols) { const int t = colt / split_cols; base += (size_t)t * split_stride; colt -= t * split_cols; if (t == 0) sc = scale0; }
        const int col0 = colt + wc * 32 + 8 * fq, bcol0 = u.pn * BM + wc * 32 + 8 * fq;
        f32x4 bv[2][2];
#pragma unroll
        for (int bj = 0; bj < 2; ++bj)
#pragma unroll
            for (int n = 0; n < 2; ++n) bv[bj][n] = bias ? *(const f32x4*)(bias + bcol0 + bj * HALF + 4 * n) : (f32x4){0.f, 0.f, 0.f, 0.f};
#pragma unroll
        for (int ai = 0; ai < 2; ++ai)
#pragma unroll
            for (int m = 0; m < 4; ++m) { bf16_t* rowp = base + (size_t)(row0 + ai * HALF + m * 16) * ldc + col0;
#pragma unroll
                for (int bj = 0; bj < 2; ++bj) { f32x4 v0 = acc[ai][bj][m][0] + bv[bj][0], v1 = acc[ai][bj][m][1] + bv[bj][1];
                    if (ACT == 1) { f32x2 a = gelu_pk((f32x2){v0[0], v0[1]}), b = gelu_pk((f32x2){v0[2], v0[3]}), c = gelu_pk((f32x2){v1[0], v1[1]}), d = gelu_pk((f32x2){v1[2], v1[3]});
                        v0 = (f32x4){a.x, a.y, b.x, b.y}; v1 = (f32x4){c.x, c.y, d.x, d.y}; }
                    v0 = v0 * sc; v1 = v1 * sc; u32x4 w; w.x = cvt_pk_bf16(v0[0], v0[1]); w.y = cvt_pk_bf16(v0[2], v0[3]); w.z = cvt_pk_bf16(v1[0], v1[1]); w.w = cvt_pk_bf16(v1[2], v1[3]);
                    *(u32x4*)(rowp + bj * HALF) = w; } }
    }
};
template <class Epi, class Sched, bool ALIGN_EPI = false, bool SP2 = false>
__device__ __forceinline__ void gemm_phase(PG8_LAS unsigned char* lds, const Gemm g, const Sched& S, const Epi& E, int tid_in) {
    int tid_ = tid_in; asm volatile("" : "+v"(tid_));
    const int tid = tid_, wid = __builtin_amdgcn_readfirstlane(tid >> 6), lane = tid & 63, wr = wid >> 2, wc = wid & 3, fr = lane & 15, fq = lane >> 4;
    const int K = g.K, nt = K / BK;
    unsigned voffA[2], voffB[2];
#pragma unroll
    for (int i = 0; i < 2; ++i) { int R, C; stage_rc(tid * 16 + i * 8192, R, C); const int Rb = Epi::PERM ? ((R & ~31) + perm32(R & 31)) : R;
        voffA[i] = (unsigned)(R * K + C) * 2u; voffB[i] = (unsigned)(Rb * K + C) * 2u; }
    const size_t kstep = (size_t)(BK * 2);
    const size_t hstep = (size_t)HALF * K * 2;
    const size_t tstep = 2 * hstep;
    const unsigned ldsw = (unsigned)wid * 1024u;
    const int aoff = lds_byte(wr * 64 + fr, fq * 8), boff = lds_byte(wc * 32 + fr, fq * 8);
#define PG8_SA(b, h) (((b) * 2 + (h)) * HTB)
#define PG8_SB(b, h) ((4 + (b) * 2 + (h)) * HTB)
#define PG8_STAGE(bufoff, gbase, voff) do { _Pragma("unroll") for (int _i = 0; _i < 2; ++_i) \
        __builtin_amdgcn_global_load_lds((const unsigned*)((const char*)(gbase) + (voff)[_i]), (PG8_LAS unsigned*)(lds + (bufoff) + ldsw + _i * 8192), 16, 0, 0); } while (0)
#define PG8_LDA(dst, b, h) do { _Pragma("unroll") for (int m = 0; m < 4; ++m) _Pragma("unroll") for (int k = 0; k < 2; ++k) dst[m][k] = *(const PG8_LAS bf16x8*)(lds + PG8_SA(b, h) + aoff + m * 2048 + k * 1024); } while (0)
#define PG8_LDB(dst, b, h) do { _Pragma("unroll") for (int n = 0; n < 2; ++n) _Pragma("unroll") for (int k = 0; k < 2; ++k) dst[n][k] = *(const PG8_LAS bf16x8*)(lds + PG8_SB(b, h) + boff + n * 2048 + k * 1024); } while (0)
#define PG8_MMA(ai, bj, At, Bt) do { __builtin_amdgcn_s_setprio(1); _Pragma("unroll") for (int m = 0; m < 4; ++m) _Pragma("unroll") for (int n = 0; n < 2; ++n) _Pragma("unroll") for (int k = 0; k < 2; ++k) \
        acc[ai][bj][m][n] = __builtin_amdgcn_mfma_f32_16x16x32_bf16(Bt[n][k], At[m][k], acc[ai][bj][m][n], 0, 0, 0); __builtin_amdgcn_s_setprio(0); } while (0)
#define PG8_WAIT_V(n) asm volatile("s_waitcnt vmcnt(" #n ")" ::: "memory")
#define PG8_WAIT_L(n) asm volatile("s_waitcnt lgkmcnt(" #n ")" ::: "memory")
#define PG8_BAR __builtin_amdgcn_s_barrier()
#define PG8_SCHED __builtin_amdgcn_sched_barrier(0)
    Unit cur, nxt; int ui = 0;
    if (!S.next(0, cur)) return;
    f32x4 acc[2][2][4][2];
#pragma unroll
    for (int a = 0; a < 2; ++a)
#pragma unroll
        for (int b = 0; b < 2; ++b)
#pragma unroll
            for (int m = 0; m < 4; ++m)
#pragma unroll
                for (int n = 0; n < 2; ++n) acc[a][b][m][n] = (f32x4){0.f, 0.f, 0.f, 0.f};
    bf16x8 At[4][2], B0[2][2], B1[2][2];
    const char* cA = (const char*)g.A + (size_t)cur.pm * tstep; const char* cB = (const char*)g.Bt + (size_t)cur.pn * tstep;
    S.a_ready(cur);
    if constexpr (SP2) {
        PG8_STAGE(PG8_SB(0, 0), cB, voffB); PG8_STAGE(PG8_SB(0, 1), cB + hstep, voffB); PG8_STAGE(PG8_SA(0, 0), cA, voffA); PG8_STAGE(PG8_SA(0, 1), cA + hstep, voffA);
        if (wr == 1) PG8_BAR;
        PG8_WAIT_V(2); PG8_BAR;
        PG8_STAGE(PG8_SB(1, 0), cB + kstep, voffB); PG8_STAGE(PG8_SA(1, 0), cA + kstep, voffA); PG8_STAGE(PG8_SB(1, 1), cB + hstep + kstep, voffB);
        PG8_WAIT_V(6); PG8_BAR;
    } else {
        PG8_STAGE(PG8_SB(0, 0), cB, voffB); PG8_STAGE(PG8_SA(0, 0), cA, voffA); PG8_STAGE(PG8_SB(0, 1), cB + hstep, voffB); PG8_STAGE(PG8_SA(0, 1), cA + hstep, voffA);
        if (wr == 1) PG8_BAR;
        PG8_WAIT_V(4); PG8_BAR;
        PG8_STAGE(PG8_SB(1, 0), cB + kstep, voffB); PG8_STAGE(PG8_SA(1, 0), cA + kstep, voffA); PG8_STAGE(PG8_SB(1, 1), cB + hstep + kstep, voffB);
        PG8_WAIT_V(6); PG8_BAR;
    }
    for (;;) {
        const bool has_next = S.next(ui + 1, nxt);
        const char* nA = has_next ? (const char*)g.A + (size_t)nxt.pm * tstep : cA; const char* nB = has_next ? (const char*)g.Bt + (size_t)nxt.pn * tstep : cB;
        for (int t = 0; t < nt; t += 2) {
            const bool last = (t == nt - 2);
            const char* a1 = cA + (size_t)(t + 1) * kstep;
            const char* a2 = last ? nA : cA + (size_t)(t + 2) * kstep; const char* b2 = last ? nB : cB + (size_t)(t + 2) * kstep;
            const char* a3 = a2 + kstep; const char* b3 = b2 + kstep;
            if (last && has_next) S.a_ready(nxt);
            if constexpr (SP2) {
            PG8_LDB(B0, 0, 0); PG8_LDB(B1, 0, 1); PG8_SCHED; PG8_LDA(At, 0, 0); PG8_STAGE(PG8_SA(1, 1), a1 + hstep, voffA);
            PG8_WAIT_V(8); PG8_WAIT_L(0); PG8_BAR; PG8_MMA(0, 0, At, B0); PG8_MMA(0, 1, At, B1); PG8_BAR; PG8_SCHED;
            PG8_LDA(At, 0, 1); PG8_STAGE(PG8_SB(0, 0), b2, voffB); PG8_STAGE(PG8_SB(0, 1), b2 + hstep, voffB); PG8_STAGE(PG8_SA(0, 0), a2, voffA);
            PG8_WAIT_V(8); PG8_WAIT_L(0); PG8_BAR; PG8_MMA(1, 0, At, B0); PG8_MMA(1, 1, At, B1); PG8_BAR; PG8_SCHED;
            PG8_LDB(B0, 1, 0); PG8_LDB(B1, 1, 1); PG8_SCHED; PG8_LDA(At, 1, 0); PG8_STAGE(PG8_SA(0, 1), a2 + hstep, voffA);
            PG8_WAIT_V(8); PG8_WAIT_L(0); PG8_BAR; PG8_MMA(0, 0, At, B0); PG8_MMA(0, 1, At, B1); PG8_BAR; PG8_SCHED;
            PG8_LDA(At, 1, 1); PG8_STAGE(PG8_SB(1, 0), b3, voffB); PG8_STAGE(PG8_SB(1, 1), b3 + hstep, voffB); PG8_STAGE(PG8_SA(1, 0), a3, voffA);
            PG8_WAIT_V(8); PG8_WAIT_L(0); PG8_BAR; PG8_MMA(1, 0, At, B0); PG8_MMA(1, 1, At, B1); PG8_BAR; PG8_SCHED;
            } else {
            PG8_LDB(B0, 0, 0); PG8_SCHED; PG8_LDA(At, 0, 0); PG8_STAGE(PG8_SA(1, 1), a1 + hstep, voffA);
            PG8_WAIT_L(8); PG8_BAR; PG8_WAIT_L(0); PG8_MMA(0, 0, At, B0); PG8_BAR; PG8_SCHED;
            PG8_LDB(B1, 0, 1); PG8_STAGE(PG8_SB(0, 0), b2, voffB);
            PG8_BAR; PG8_WAIT_L(0); PG8_MMA(0, 1, At, B1); PG8_BAR;
            PG8_LDA(At, 0, 1); PG8_STAGE(PG8_SA(0, 0), a2, voffA);
            PG8_BAR; PG8_WAIT_L(0); PG8_MMA(1, 0, At, B0); PG8_BAR; PG8_SCHED;
            PG8_STAGE(PG8_SB(0, 1), b2 + hstep, voffB);
            PG8_WAIT_V(6); PG8_BAR; PG8_MMA(1, 1, At, B1); PG8_BAR;
            PG8_LDB(B0, 1, 0); PG8_SCHED; PG8_LDA(At, 1, 0); PG8_STAGE(PG8_SA(0, 1), a2 + hstep, voffA);
            PG8_WAIT_L(8); PG8_BAR; PG8_WAIT_L(0); PG8_MMA(0, 0, At, B0); PG8_BAR; PG8_SCHED;
            PG8_LDB(B1, 1, 1); PG8_STAGE(PG8_SB(1, 0), b3, voffB);
            PG8_BAR; PG8_WAIT_L(0); PG8_MMA(0, 1, At, B1); PG8_BAR;
            PG8_LDA(At, 1, 1); PG8_STAGE(PG8_SA(1, 0), a3, voffA);
            PG8_BAR; PG8_WAIT_L(0); PG8_MMA(1, 0, At, B0); PG8_BAR; PG8_SCHED;
            PG8_STAGE(PG8_SB(1, 1), b3 + hstep, voffB);
            PG8_WAIT_V(6); PG8_BAR; PG8_MMA(1, 1, At, B1); PG8_BAR;
            }
        }
        if constexpr (ALIGN_EPI) { if (wr == 0) PG8_BAR; }
        if constexpr (!Epi::AFTER_DRAIN) { E(acc, cur, wr, wc, fr, fq); S.done(cur); }
        if (!has_next) break;
#pragma unroll
        for (int a = 0; a < 2; ++a)
#pragma unroll
            for (int b = 0; b < 2; ++b)
#pragma unroll
                for (int m = 0; m < 4; ++m)
#pragma unroll
                    for (int n = 0; n < 2; ++n) acc[a][b][m][n] = (f32x4){0.f, 0.f, 0.f, 0.f};
        cur = nxt; cA = nA; cB = nB; ++ui;
        if constexpr (ALIGN_EPI) { if (wr == 1) PG8_BAR; }
    }
    PG8_WAIT_V(0);
    if constexpr (!ALIGN_EPI) { if (wr == 0) PG8_BAR; }
    PG8_BAR;
    if constexpr (Epi::AFTER_DRAIN) { E.fused(acc, cur, wr, wc, fr, fq, lds, wid, lane); S.done(cur); }
#undef PG8_SA
#undef PG8_SB
#undef PG8_STAGE
#undef PG8_LDA
#undef PG8_LDB
#undef PG8_MMA
#undef PG8_WAIT_V
#undef PG8_WAIT_L
#undef PG8_BAR
#undef PG8_SCHED
}
}
#define LAS __attribute__((address_space(3)))
typedef unsigned short bf16_t;
typedef short bf16x8 __attribute__((ext_vector_type(8)));
typedef float f32x4 __attribute__((ext_vector_type(4)));
typedef unsigned u32x4 __attribute__((ext_vector_type(4)));
typedef unsigned u32x2 __attribute__((ext_vector_type(2)));

constexpr int DM = 2048, NB = 4, SEQ = 2048, DEPTH = 4, DECB = 128, MP = NB * SEQ, MT = MP + DECB;
constexpr int NH = 8, HD = 128, DIN = 8208, DINP = 8224, NZ = 8192, MODLD = DEPTH * 3 * DM;
constexpr float EPS = 1e-6f;
constexpr size_t MiB = 1u << 20;
constexpr size_t WS_WIN = 0, WS_WOUT = 130 * MiB, WS_WADA = 162 * MiB, WS_CA = 258 * MiB, WS_MOD = 259 * MiB, WS_HB = 283 * MiB, WS_Z = 316 * MiB,
                 WS_ZS = 444 * MiB, WS_BA = 449 * MiB, WS_X = 450 * MiB, WS_YCAT = 515 * MiB, WS_TR = 548 * MiB, WS_GL = 652 * MiB, WS_CTL = 653 * MiB, WS_OB = 654 * MiB, WS_END = 686 * MiB;
constexpr size_t TR_W = 0, TR_Q = 16384, TR_A = 32768, TR_K = 40960, TR_G = 57344, TR_U = 73728, TR_SZ = 106496;
constexpr int LDS_BYTES = 147456;
constexpr size_t O_YP = 0, O_YS = O_YP + (size_t)MP * DM, O_CAP = O_YS + (size_t)DECB * DM, O_CQP = O_CAP + (size_t)DEPTH * NB * 2 * 1024,
                 O_SP = O_CQP + (size_t)DEPTH * NB * 3 * 3072, O_CAS = O_SP + (size_t)DEPTH * NB * NH * HD * HD, O_CQS = O_CAS + (size_t)DEPTH * DECB * 2 * 1024,
                 O_SS = O_CQS + (size_t)DEPTH * DECB * 3 * 3072, O_END = O_SS + (size_t)DEPTH * DECB * NH * HD * HD;

__device__ __forceinline__ float bflo(unsigned w) { return __uint_as_float(w << 16); }
__device__ __forceinline__ float bfhi(unsigned w) { return __uint_as_float(w & 0xffff0000u); }
__device__ __forceinline__ float bf2f(bf16_t h) { return __uint_as_float((unsigned)h << 16); }
__device__ __forceinline__ unsigned pk2(float lo, float hi) { return pg8::cvt_pk_bf16(lo, hi); }
__device__ __forceinline__ bf16_t f2bf(float f) { return (bf16_t)(pk2(f, 0.f) & 0xffffu); }
__device__ __forceinline__ float rcp_f(float x) { return __builtin_amdgcn_rcpf(x); }
__device__ __forceinline__ float rsq_f(float x) { return __builtin_amdgcn_rsqf(x); }
__device__ __forceinline__ float exp_f(float x) { return __builtin_amdgcn_exp2f(x * 1.4426950408889634f); }
__device__ __forceinline__ float silu_f(float x) { return x * rcp_f(1.f + exp_f(-x)); }
__device__ __forceinline__ float sigmoid_f(float x) { return rcp_f(1.f + exp_f(-x)); }
__device__ __forceinline__ float softplus_f(float x) { return fmaxf(x, 0.f) + __logf(1.f + exp_f(-fabsf(x))); }
__device__ __forceinline__ float wave_sum(float v) {
#pragma unroll
    for (int o = 1; o < 64; o <<= 1) v += __shfl_xor(v, o);
    return v;
}
__device__ __forceinline__ float wave_sum2(float v, int lane) {
    v += __builtin_bit_cast(float, __builtin_amdgcn_update_dpp(0, __builtin_bit_cast(int, v), 0xB1, 0xF, 0xF, true));
    v += __builtin_bit_cast(float, __builtin_amdgcn_update_dpp(0, __builtin_bit_cast(int, v), 0x4E, 0xF, 0xF, true));
    v += __builtin_bit_cast(float, __builtin_amdgcn_update_dpp(0, __builtin_bit_cast(int, v), 0x141, 0xF, 0xF, true));
    v += __builtin_bit_cast(float, __builtin_amdgcn_update_dpp(0, __builtin_bit_cast(int, v), 0x140, 0xF, 0xF, true));
    v += __builtin_bit_cast(float, __builtin_amdgcn_ds_bpermute((lane ^ 16) << 2, __builtin_bit_cast(int, v)));
    v += __builtin_bit_cast(float, __builtin_amdgcn_ds_bpermute((lane ^ 32) << 2, __builtin_bit_cast(int, v)));
    return v;
}
#define LBAR() do { asm volatile("s_waitcnt lgkmcnt(0)" ::: "memory"); __builtin_amdgcn_s_barrier(); asm volatile("" ::: "memory"); } while (0)
#define LDS_WAIT() asm volatile("s_waitcnt lgkmcnt(0)" ::: "memory")

struct EpiF32Bias {
    static constexpr bool PERM = false, AFTER_DRAIN = false;
    float* out; int ldc; const float* bias;
    __device__ __forceinline__ void operator()(const f32x4 (&acc)[2][2][4][2], const pg8::Unit& u, int wr, int wc, int fr, int fq) const {
        const int row0 = u.pm * 256 + wr * 64 + fr, col0 = u.pn * 256 + wc * 32 + 4 * fq;
#pragma unroll
        for (int ai = 0; ai < 2; ++ai)
#pragma unroll
            for (int m = 0; m < 4; ++m) { const size_t off = (size_t)(row0 + ai * 128 + m * 16) * ldc + col0;
#pragma unroll
                for (int bj = 0; bj < 2; ++bj)
#pragma unroll
                    for (int n = 0; n < 2; ++n) { const f32x4 bv = *(const f32x4*)(bias + col0 + bj * 128 + n * 16); *(f32x4*)(out + off + bj * 128 + n * 16) = acc[ai][bj][m][n] + bv; }
                asm volatile("" ::: "memory"); }
    }
};
struct EpiResGate {
    static constexpr bool PERM = false, AFTER_DRAIN = false;
    const float* base; float* out; const float* gate; int ldc;
    __device__ __forceinline__ void operator()(const f32x4 (&acc)[2][2][4][2], const pg8::Unit& u, int wr, int wc, int fr, int fq) const {
        const int row0 = u.pm * 256 + wr * 64 + fr, col0 = u.pn * 256 + wc * 32 + 4 * fq;
        const float* gp = gate + (size_t)((u.pm * 256) / SEQ) * MODLD + col0;
        f32x4 gv[2][2];
#pragma unroll
        for (int bj = 0; bj < 2; ++bj)
#pragma unroll
            for (int n = 0; n < 2; ++n) gv[bj][n] = *(const f32x4*)(gp + bj * 128 + n * 16);
#pragma unroll
        for (int ai = 0; ai < 2; ++ai)
#pragma unroll
            for (int m = 0; m < 4; ++m) { const size_t off = (size_t)(row0 + ai * 128 + m * 16) * ldc + col0;
#pragma unroll
                for (int bj = 0; bj < 2; ++bj)
#pragma unroll
                    for (int n = 0; n < 2; ++n) { const f32x4 b = *(const f32x4*)(base + off + bj * 128 + n * 16); *(f32x4*)(out + off + bj * 128 + n * 16) = b + gv[bj][n] * acc[ai][bj][m][n]; }
                asm volatile("" ::: "memory"); }
    }
};

__device__ __forceinline__ f32x4 skinny16(const bf16_t* A, int lda, const bf16_t* Bt, int ldb, int K, int lane) {
    const int r = lane & 15, q = lane >> 4;
    const bf16x8* ap = (const bf16x8*)(A + (size_t)r * lda + q * 8);
    const bf16x8* bp = (const bf16x8*)(Bt + (size_t)r * ldb + q * 8);
    f32x4 acc0 = {0.f, 0.f, 0.f, 0.f}, acc1 = {0.f, 0.f, 0.f, 0.f};
#pragma unroll 1
    for (int k = 0; k < K / 32; k += 16) {
        bf16x8 a[16], b[16];
#pragma unroll
        for (int i = 0; i < 16; ++i) { a[i] = ap[(k + i) * 4]; b[i] = bp[(k + i) * 4]; }
#pragma unroll
        for (int i = 0; i < 16; i += 2) { acc0 = __builtin_amdgcn_mfma_f32_16x16x32_bf16(a[i], b[i], acc0, 0, 0, 0); acc1 = __builtin_amdgcn_mfma_f32_16x16x32_bf16(a[i + 1], b[i + 1], acc1, 0, 0, 0); }
    }
    return acc0 + acc1;
}


__device__ __forceinline__ void sample_gemm32(LAS unsigned char* lds, const bf16_t* A, const bf16_t* Bt, float* out, int ldo, int n0, int tid, int lane, int wave) {
    constexpr int CK = 512, BS = CK + 8, BUFB = 32 * BS * 2, NC = DM / CK;
    const int r = lane & 15, q8 = lane >> 4;
    const bf16_t* ap = A + (size_t)(wave * 16 + r) * DM + q8 * 8;
    const bf16_t* bp = Bt + (size_t)(tid >> 6) * DM + (tid & 63) * 8;
    const unsigned bw = (unsigned)((tid >> 6) * BS + (tid & 63) * 8) * 2u;
    f32x4 acc[2] = {{0.f, 0.f, 0.f, 0.f}, {0.f, 0.f, 0.f, 0.f}};
    bf16x8 fa[16], fn[16]; u32x4 sb[4];
#define SG_LA(c, d) do { _Pragma("unroll") for (int ks = 0; ks < 16; ++ks) d[ks] = *(const bf16x8*)(ap + (c) * CK + ks * 32); } while (0)
#define SG_LB(c) do { _Pragma("unroll") for (int i = 0; i < 4; ++i) sb[i] = *(const u32x4*)(bp + (size_t)(8 * i) * DM + (c) * CK); } while (0)
#define SG_SB(bufp) do { _Pragma("unroll") for (int i = 0; i < 4; ++i) *(LAS u32x4*)((bufp) + bw + (unsigned)(8 * i * BS * 2)) = sb[i]; } while (0)
    SG_LB(0); SG_LA(0, fa);
    SG_SB(lds);
    SG_LB(1);
    __syncthreads();
#define SG_MM(f_, c_) do { const LAS bf16_t* Bl = (const LAS bf16_t*)(lds + ((c_) & 1) * BUFB); \
        _Pragma("unroll") for (int ks = 0; ks < 16; ++ks) { \
            const bf16x8 b0 = *(const LAS bf16x8*)(Bl + r * BS + ks * 32 + q8 * 8), b1 = *(const LAS bf16x8*)(Bl + (16 + r) * BS + ks * 32 + q8 * 8); \
            acc[0] = __builtin_amdgcn_mfma_f32_16x16x32_bf16(f_[ks], b0, acc[0], 0, 0, 0); acc[1] = __builtin_amdgcn_mfma_f32_16x16x32_bf16(f_[ks], b1, acc[1], 0, 0, 0); } } while (0)
#pragma unroll 1
    for (int c = 0; c < NC; c += 2) {
        SG_LA(c + 1, fn);
        SG_MM(fa, c);
        SG_SB(lds + ((c + 1) & 1) * BUFB);
        if (c + 2 < NC) SG_LB(c + 2);
        LBAR();
        if (c + 2 < NC) SG_LA(c + 2, fa);
        SG_MM(fn, c + 1);
        if (c + 2 < NC) SG_SB(lds + ((c + 2) & 1) * BUFB);
        if (c + 3 < NC) SG_LB(c + 3);
        LBAR();
    }
#undef SG_MM
#undef SG_LA
#undef SG_LB
#undef SG_SB
#pragma unroll
    for (int nt = 0; nt < 2; ++nt)
#pragma unroll
        for (int j = 0; j < 4; ++j) out[(size_t)(wave * 16 + q8 * 4 + j) * ldo + n0 + nt * 16 + r] = acc[nt][j];
}

__device__ __forceinline__ void transpose_item(const float* W, int K, int N, bf16_t* WT, LAS float* scr, int item, int lane) {
    const int nblk = (N + 31) / 32, kb = item / nblk, nb = item % nblk, k0 = 64 * kb, n0 = 32 * nb;
    const int nn = n0 + (lane & 31); const bool ok = nn < N;
    float v[32];
#pragma unroll
    for (int i = 0; i < 32; ++i) { const int kk = 2 * i + (lane >> 5); v[i] = ok ? W[(size_t)(k0 + kk) * N + nn] : 0.f; }
#pragma unroll
    for (int i = 0; i < 32; ++i) { const int kk = 2 * i + (lane >> 5); scr[kk * 33 + (lane & 31)] = v[i]; }
    LDS_WAIT(); asm volatile("" ::: "memory");
    const int c = lane & 7;
#pragma unroll
    for (int j = 0; j < 4; ++j) { const int n = (lane >> 3) + 8 * j; const LAS float* s = scr + (8 * c) * 33 + n;
        u32x4 o; o.x = pk2(s[0 * 33], s[1 * 33]); o.y = pk2(s[2 * 33], s[3 * 33]); o.z = pk2(s[4 * 33], s[5 * 33]); o.w = pk2(s[6 * 33], s[7 * 33]);
        *(u32x4*)(WT + (size_t)(n0 + n) * K + k0 + 8 * c) = o; }
    LDS_WAIT(); asm volatile("" ::: "memory");
}

#define RLX_AGENT __ATOMIC_RELAXED, __HIP_MEMORY_SCOPE_AGENT
#define XB_TMO      128
#define XB_XCNT(j)  (256  + 64 * (j))
#define XB_XSUB(j)  (1280 + 64 * (j))
#define XB_XGEN(j)  (2304 + 64 * (j))
#define XB_TOP      3328
#define XB_TOPGEN   3392
#define XCD_BAR_WORDS 3456
#define XB_SPIN_CAP (1u << 17)

__device__ __forceinline__ unsigned xb_ld(unsigned* p)              { return __hip_atomic_load(p, __ATOMIC_RELAXED, __HIP_MEMORY_SCOPE_AGENT); }
__device__ __forceinline__ unsigned xb_add(unsigned* p, unsigned v) { return __hip_atomic_fetch_add(p, v, __ATOMIC_RELAXED, __HIP_MEMORY_SCOPE_AGENT); }
__device__ __forceinline__ unsigned xb_xcc_id() { return (unsigned)__builtin_amdgcn_s_getreg((3 << 11) | 20) & 0xFu; }
#define XB_SPIN(cond, bar) do { unsigned _sp = 0; while (cond) { __builtin_amdgcn_s_sleep(6); \
    if ((++_sp & 255u) == 0u) { if (xb_ld(&(bar)[XB_TMO])) break; if (_sp > XB_SPIN_CAP) { atomicAdd(&(bar)[XB_TMO], 1u); break; } } } } while (0)

struct XcdBarrier {
    unsigned* bar; unsigned x;
    volatile LAS unsigned* st;
};

__device__ __forceinline__ XcdBarrier xcd_barrier_post(unsigned* bar, volatile LAS unsigned* st) {
    XcdBarrier b; b.bar = bar; b.x = xb_xcc_id(); b.st = st;
    if (threadIdx.x == 0) (void)xb_add(&bar[XB_XCNT(b.x)], 1u);
    return b;
}
__device__ __forceinline__ void xcd_barrier_complete(unsigned* bar, unsigned x, unsigned& nloc, unsigned& nx) {
    const unsigned G = gridDim.x * gridDim.y * gridDim.z;
    unsigned sum, cnt, mine, sp = 0u;
    for (;;) {
        sum = 0u; cnt = 0u; mine = 0u;
#pragma unroll
        for (unsigned j = 0; j < 16; ++j) { const unsigned c = xb_ld(&bar[XB_XCNT(j)]); sum += c; cnt += (c > 0u) ? 1u : 0u; mine = (j == x) ? c : mine; }
        if (sum == G) break;
        __builtin_amdgcn_s_sleep(6);
        if ((++sp & 255u) == 0u) { if (xb_ld(&bar[XB_TMO])) break; if (sp > XB_SPIN_CAP) { atomicAdd(&bar[XB_TMO], 1u); break; } }
    }
    nloc = mine > 0u ? mine : 1u; nx = cnt > 0u ? cnt : 1u;
}

__device__ __forceinline__ void xcd_barrier(const XcdBarrier& b) {
    asm volatile("s_waitcnt vmcnt(0)" ::: "memory");
    __syncthreads();
    if (threadIdx.x == 0) {
        unsigned* bar = b.bar;
        __builtin_amdgcn_s_waitcnt(0);
        unsigned nloc = b.st[0], nx = b.st[1];
        if (nloc == 0u) { xcd_barrier_complete(bar, b.x, nloc, nx); b.st[0] = nloc; b.st[1] = nx; }
        const unsigned old = xb_add(&bar[XB_XSUB(b.x)], 1u);
        const unsigned gen = old / nloc;
        if (old + 1u == (gen + 1u) * nloc) {
            __builtin_amdgcn_fence(__ATOMIC_RELEASE, "agent");
            asm volatile("s_waitcnt vmcnt(0)" ::: "memory");
            const unsigned og = xb_add(&bar[XB_TOP], 1u);
            const unsigned tg = og / nx;
            if (og + 1u == (tg + 1u) * nx) xb_add(&bar[XB_TOPGEN], 1u);
            else XB_SPIN(xb_ld(&bar[XB_TOPGEN]) == tg, bar);
            __builtin_amdgcn_fence(__ATOMIC_ACQUIRE, "agent");
            xb_add(&bar[XB_XGEN(b.x)], 1u);
            asm volatile("s_waitcnt vmcnt(0)" ::: "memory");
        } else {
            XB_SPIN(xb_ld(&bar[XB_XGEN(b.x)]) == gen, bar);
            __builtin_amdgcn_fence(__ATOMIC_ACQUIRE, "agent");
            asm volatile("s_waitcnt vmcnt(0)" ::: "memory");
        }
    }
    __syncthreads();
}

__device__ __forceinline__ void phase_norm(const float* xp, const float* xs, const float* ng, const float* modl, bf16_t* hb, int gw, int NGW, int lane) {
    {
        const int row0 = gw * 4, mrow = row0 / SEQ;
        const float* sh = modl + (size_t)mrow * MODLD; const float* sc = sh + DM;
        f32x4 gg[8], ss0[8];
#pragma unroll
        for (int j = 0; j < 8; ++j) { const int c4 = lane + 64 * j; gg[j] = ((const f32x4*)ng)[c4] * (1.f + ((const f32x4*)sc)[c4]); ss0[j] = ((const f32x4*)sh)[c4]; }
#pragma unroll
        for (int k = 0; k < 4; ++k) {
            f32x4 v[8]; float ss = 0.f;
#pragma unroll
            for (int j = 0; j < 8; ++j) { v[j] = ((const f32x4*)(xp + (size_t)(row0 + k) * DM))[lane + 64 * j]; ss += (v[j].x * v[j].x + v[j].y * v[j].y) + (v[j].z * v[j].z + v[j].w * v[j].w); }
            const float rstd = rsq_f(wave_sum2(ss, lane) * (1.f / DM) + EPS);
#pragma unroll
            for (int j = 0; j < 8; ++j) { const int c4 = lane + 64 * j; const f32x4 h = v[j] * rstd * gg[j] + ss0[j]; u32x2 o; o.x = pk2(h.x, h.y); o.y = pk2(h.z, h.w); *(u32x2*)(hb + (size_t)(row0 + k) * DM + c4 * 4) = o; }
        }
    }
    for (int rs = gw; rs < DECB; rs += NGW) {
        const int row = MP + rs; const float* xr = xs + (size_t)rs * DM;
        const float* sh = modl + (size_t)(NB + rs) * MODLD; const float* sc = sh + DM;
        f32x4 v[8]; float ss = 0.f;
#pragma unroll
        for (int j = 0; j < 8; ++j) { v[j] = ((const f32x4*)xr)[lane + 64 * j]; ss += (v[j].x * v[j].x + v[j].y * v[j].y) + (v[j].z * v[j].z + v[j].w * v[j].w); }
        const float rstd = rsq_f(wave_sum2(ss, lane) * (1.f / DM) + EPS);
#pragma unroll
        for (int j = 0; j < 8; ++j) { const int c4 = lane + 64 * j; const f32x4 g = ((const f32x4*)ng)[c4], s1 = ((const f32x4*)sc)[c4], s0 = ((const f32x4*)sh)[c4];
            const f32x4 h = v[j] * rstd * g * (1.f + s1) + s0; u32x2 o; o.x = pk2(h.x, h.y); o.y = pk2(h.z, h.w); *(u32x2*)(hb + (size_t)row * DM + c4 * 4) = o; }
    }
}
__device__ __forceinline__ void final_row(const f32x4 (&v)[8], const f32x4 (&g)[8], float* orow, int lane) {
    float ss = 0.f;
#pragma unroll
    for (int j = 0; j < 8; ++j) ss += (v[j].x * v[j].x + v[j].y * v[j].y) + (v[j].z * v[j].z + v[j].w * v[j].w);
    const float rstd = rsq_f(wave_sum(ss) * (1.f / DM) + EPS);
#pragma unroll
    for (int j = 0; j < 8; ++j) ((f32x4*)orow)[lane + 64 * j] = v[j] * rstd * g[j];
}
__device__ __forceinline__ void phase_final(const float* x, const float* g, float* out, int gw, int NGW, int lane) {
    f32x4 gg[8];
#pragma unroll
    for (int j = 0; j < 8; ++j) gg[j] = ((const f32x4*)g)[lane + 64 * j];
    const int row0 = gw * 4;
    f32x4 v[8], w[8];
#pragma unroll
    for (int j = 0; j < 8; ++j) v[j] = ((const f32x4*)(x + (size_t)row0 * DM))[lane + 64 * j];
#pragma unroll
    for (int k = 0; k < 4; ++k) {
        if (k < 3) {
#pragma unroll
            for (int j = 0; j < 8; ++j) w[j] = ((const f32x4*)(x + (size_t)(row0 + k + 1) * DM))[lane + 64 * j];
        }
        final_row(v, gg, out + (size_t)(row0 + k) * DM, lane);
#pragma unroll
        for (int j = 0; j < 8; ++j) v[j] = w[j];
    }
    for (int row = MP + gw; row < MT; row += NGW) {
#pragma unroll
        for (int j = 0; j < 8; ++j) v[j] = ((const f32x4*)(x + (size_t)row * DM))[lane + 64 * j];
        final_row(v, gg, out + (size_t)row * DM, lane);
    }
}

template <int I, int C> __device__ __forceinline__ void s2_load(const LAS float* Ll, f32x4 (&lr)[16]) {
    if constexpr (4 * C < I) { lr[C] = *(const LAS f32x4*)(Ll + I * 64 + 4 * C); s2_load<I, C + 1>(Ll, lr); }
}
template <int I, int C> __device__ __forceinline__ void s2_fma(const f32x4 (&lr)[16], const float (&Xc)[64], float& a0, float& a1, float& a2, float& a3) {
    if constexpr (4 * C < I) {
        a0 += lr[C].x * Xc[4 * C];
        if constexpr (4 * C + 1 < I) a1 += lr[C].y * Xc[4 * C + 1];
        if constexpr (4 * C + 2 < I) a2 += lr[C].z * Xc[4 * C + 2];
        if constexpr (4 * C + 3 < I) a3 += lr[C].w * Xc[4 * C + 3];
        s2_fma<I, C + 1>(lr, Xc, a0, a1, a2, a3);
    }
}
template <int I> __device__ __forceinline__ void s2_row(const LAS float* Ll, float (&Xc)[64], int lane) {
    if constexpr (I < 64) {
        float a0 = Ll[I * 64 + lane], a1 = 0.f, a2 = 0.f, a3 = 0.f;
        f32x4 lr[16];
        s2_load<I, 0>(Ll, lr);
        s2_fma<I, 0>(lr, Xc, a0, a1, a2, a3);
        Xc[I] = -((a0 + a1) + (a2 + a3));
        asm volatile("" ::: "memory");
        s2_row<I + 1>(Ll, Xc, lane);
    }
}
struct PrepP { const bf16_t* z; const float* ba; const float* cw; const float* alog; const float* dtb; unsigned char* tr; float* gl; };
constexpr int PS = 136, TS = 72;
__device__ __forceinline__ void conv8(const u32x4 (&x)[4], const LAS float* w, float (&o)[8]) {
    f32x4 wa[4], wb[4];
#pragma unroll
    for (int j = 0; j < 4; ++j) { wa[j] = *(const LAS f32x4*)(w + j * 384); wb[j] = *(const LAS f32x4*)(w + j * 384 + 4); }
#pragma unroll
    for (int i = 0; i < 8; ++i) o[i] = 0.f;
#pragma unroll
    for (int j = 0; j < 4; ++j) {
        o[0] += wa[j].x * bflo(x[j].x); o[1] += wa[j].y * bfhi(x[j].x); o[2] += wa[j].z * bflo(x[j].y); o[3] += wa[j].w * bfhi(x[j].y);
        o[4] += wb[j].x * bflo(x[j].z); o[5] += wb[j].y * bfhi(x[j].z); o[6] += wb[j].z * bflo(x[j].w); o[7] += wb[j].w * bfhi(x[j].w); }
#pragma unroll
    for (int i = 0; i < 8; ++i) o[i] = silu_f(o[i]);
}
__device__ __forceinline__ u32x4 pack8(const float* v) { u32x4 o; o.x = pk2(v[0], v[1]); o.y = pk2(v[2], v[3]); o.z = pk2(v[4], v[5]); o.w = pk2(v[6], v[7]); return o; }
__device__ __forceinline__ void prep_weights(LAS unsigned char* lds, const float* cqw, int h, int tid) {
    LAS float* wl = (LAS float*)(lds + 114688);
#pragma unroll
    for (int i = 0; i < 3; ++i) { const int idx = tid + 512 * i, j = idx / 384, rem = idx - j * 384, m = rem >> 7, c = rem & 127; wl[idx] = cqw[j * 3072 + m * 1024 + h * 128 + c]; }
}
__device__ __forceinline__ void prep_task(LAS unsigned char* lds, const PrepP& P, int task, int tid, int lane, int wave) {
    asm volatile("" : "+v"(tid));
    lane = tid & 63;
    unsigned lb = 0; asm volatile("" : "+v"(lb)); lds += (lb & ~15u);
    const int h = task & 7, n = (task >> 3) & 31, b = task >> 8;
    const int row0 = b * SEQ + n * 64;
    unsigned char* trp = P.tr + (size_t)task * TR_SZ;
    LAS bf16_t* Kl = (LAS bf16_t*)lds; LAS bf16_t* Ql = Kl + 64 * PS; LAS bf16_t* Vl = Ql + 64 * PS; LAS bf16_t* KBl = Vl + 64 * PS; LAS bf16_t* KTl = KBl + 64 * PS;
    LAS float* Ll = (LAS float*)(lds + 5 * 64 * PS * 2);
    LAS bf16_t* Tl = (LAS bf16_t*)(lds + 5 * 64 * PS * 2 + 16384);
    LAS float* gcl = (LAS float*)(lds + 5 * 64 * PS * 2 + 16384 + 64 * TS * 2);
    const int r = lane & 15, q8 = lane >> 4;
    if (wave == 0) {
        const float* bar = P.ba + (size_t)(row0 + lane) * 16;
        float g = -exp_f(P.alog[h]) * softplus_f(bar[8 + h] + P.dtb[h]);
#pragma unroll
        for (int o = 1; o < 64; o <<= 1) { const float v = __shfl_up(g, o); if (lane >= o) g += v; }
        gcl[lane] = g; gcl[64 + lane] = sigmoid_f(bar[h]);
        if (lane == 63) P.gl[task] = exp_f(g);
    }
    __syncthreads();
    {
        const int t = tid >> 3, seg = tid & 7;
        const float beta = gcl[64 + t], gc = gcl[t], glc = gcl[63];
        const float eg = exp_f(gc), et = exp_f(glc - gc);
        const int tt = n * 64 + t;
        const bf16_t* zr = P.z + (size_t)(row0 + t) * NZ + 4096 + h * 128 + seg * 16;
        const LAS float* cw = (const LAS float*)(lds + 114688) + seg * 16;
        u32x4 xz[3][2][4];
#pragma unroll
        for (int m = 0; m < 3; ++m)
#pragma unroll
            for (int hf = 0; hf < 2; ++hf)
#pragma unroll
                for (int j = 0; j < 4; ++j) { const bool ok = tt - 3 + j >= 0; xz[m][hf][j] = *(const u32x4*)(zr + m * 1024 + hf * 8 + (ptrdiff_t)(ok ? j - 3 : 0) * NZ); if (!ok) xz[m][hf][j] = (u32x4){0u, 0u, 0u, 0u}; }
        const int lo = t * PS + seg * 16;
        float x[16], y[16];
        { float o[8]; conv8(xz[2][0], cw + 256, o);
#pragma unroll
          for (int i = 0; i < 8; ++i) x[i] = o[i] * beta;
          conv8(xz[2][1], cw + 256 + 8, o);
#pragma unroll
          for (int i = 0; i < 8; ++i) x[8 + i] = o[i] * beta; }
        *(LAS u32x4*)(Vl + lo) = pack8(x); *(LAS u32x4*)(Vl + lo + 8) = pack8(x + 8);
        asm volatile("" ::: "memory");
        { float o[8]; conv8(xz[1][0], cw + 128, o);
#pragma unroll
          for (int i = 0; i < 8; ++i) x[i] = o[i];
          conv8(xz[1][1], cw + 128 + 8, o);
#pragma unroll
          for (int i = 0; i < 8; ++i) x[8 + i] = o[i]; }
        { float sk = 0.f;
#pragma unroll
          for (int i = 0; i < 16; ++i) sk += x[i] * x[i];
          sk += __shfl_xor(sk, 1); sk += __shfl_xor(sk, 2); sk += __shfl_xor(sk, 4);
          const float rk = rsq_f(sk + EPS);
#pragma unroll
          for (int i = 0; i < 16; ++i) x[i] *= rk; }
        *(LAS u32x4*)(Kl + lo) = pack8(x); *(LAS u32x4*)(Kl + lo + 8) = pack8(x + 8);
#pragma unroll
        for (int i = 0; i < 16; ++i) y[i] = x[i] * (beta * eg);
        *(LAS u32x4*)(KBl + lo) = pack8(y); *(LAS u32x4*)(KBl + lo + 8) = pack8(y + 8);
#pragma unroll
        for (int i = 0; i < 16; ++i) y[i] = x[i] * et;
        *(LAS u32x4*)(KTl + lo) = pack8(y); *(LAS u32x4*)(KTl + lo + 8) = pack8(y + 8);
        asm volatile("" ::: "memory");
        { float o[8]; conv8(xz[0][0], cw, o);
#pragma unroll
          for (int i = 0; i < 8; ++i) x[i] = o[i];
          conv8(xz[0][1], cw + 8, o);
#pragma unroll
          for (int i = 0; i < 8; ++i) x[8 + i] = o[i]; }
        { float sq = 0.f;
#pragma unroll
          for (int i = 0; i < 16; ++i) sq += x[i] * x[i];
          sq += __shfl_xor(sq, 1); sq += __shfl_xor(sq, 2); sq += __shfl_xor(sq, 4);
          const float rq = rsq_f(sq + EPS) * 0.08838834764831845f;
#pragma unroll
          for (int i = 0; i < 16; ++i) x[i] *= rq; }
        *(LAS u32x4*)(Ql + lo) = pack8(x); *(LAS u32x4*)(Ql + lo + 8) = pack8(x + 8);
#pragma unroll
        for (int i = 0; i < 16; ++i) y[i] = x[i] * eg;
        bf16_t* qo = (bf16_t*)(trp + TR_Q) + t * 128 + seg * 16;
        *(u32x4*)qo = pack8(y); *(u32x4*)(qo + 8) = pack8(y + 8);
    }
    __syncthreads();
    {
        const int it = wave >> 1, jt0 = (wave & 1) * 2;
        bf16x8 aK[4], aQ[4];
#pragma unroll
        for (int ks = 0; ks < 4; ++ks) { aK[ks] = *(const LAS bf16x8*)(Kl + (it * 16 + r) * PS + ks * 32 + q8 * 8); aQ[ks] = *(const LAS bf16x8*)(Ql + (it * 16 + r) * PS + ks * 32 + q8 * 8); }
#pragma unroll
        for (int jj = 0; jj < 2; ++jj) {
            const int jt = jt0 + jj;
            bf16_t* ap = (bf16_t*)(trp + TR_A) + (it * 16 + r) * 64 + jt * 16 + q8 * 4;
            if (jt > it) { *(u32x2*)ap = (u32x2){lb, lb};
#pragma unroll
                for (int j = 0; j < 4; ++j) Ll[(it * 16 + q8 * 4 + j) * 64 + jt * 16 + r] = 0.f;
                continue; }
            f32x4 accL = {0.f, 0.f, 0.f, 0.f}, accA = {0.f, 0.f, 0.f, 0.f};
#pragma unroll
            for (int ks = 0; ks < 4; ++ks) { const bf16x8 bK = *(const LAS bf16x8*)(Kl + (jt * 16 + r) * PS + ks * 32 + q8 * 8);
                accL = __builtin_amdgcn_mfma_f32_16x16x32_bf16(aK[ks], bK, accL, 0, 0, 0);
                accA = __builtin_amdgcn_mfma_f32_16x16x32_bf16(bK, aQ[ks], accA, 0, 0, 0); }
            float av[4];
#pragma unroll
            for (int j = 0; j < 4; ++j) {
                { const int i = it * 16 + q8 * 4 + j, jx = jt * 16 + r; const float e = exp_f(gcl[i] - gcl[jx]) * gcl[64 + i] * accL[j]; Ll[i * 64 + jx] = (i > jx) ? e : 0.f; }
                { const int i = it * 16 + r, jx = jt * 16 + q8 * 4 + j; const float e = exp_f(gcl[i] - gcl[jx]) * accA[j]; av[j] = (i >= jx) ? e : 0.f; } }
            u32x2 o; o.x = pk2(av[0], av[1]); o.y = pk2(av[2], av[3]); *(u32x2*)ap = o;
        }
    }
    __syncthreads();
    if (wave == 0) {
        float Xc[64];
        s2_row<0>(Ll, Xc, lane);
#pragma unroll
        for (int i = 0; i < 64; ++i) Tl[i * TS + lane] = f2bf(Xc[i]);
        asm volatile("s_waitcnt lgkmcnt(0)" ::: "memory");
        Tl[lane * TS + lane] = (bf16_t)0x3F80u;
    }
    __syncthreads();
    {
        const int c0 = wave * 16;
        bf16x8 bv[2], bk[2];
#pragma unroll
        for (int ks = 0; ks < 2; ++ks)
#pragma unroll
            for (int j = 0; j < 8; ++j) { const int tok = ks * 32 + q8 * 8 + j; bv[ks][j] = (short)Vl[tok * PS + c0 + r]; bk[ks][j] = (short)KBl[tok * PS + c0 + r]; }
#pragma unroll
        for (int mt = 0; mt < 4; ++mt) {
            f32x4 aU = {0.f, 0.f, 0.f, 0.f}, aW = {0.f, 0.f, 0.f, 0.f};
#pragma unroll
            for (int ks = 0; ks < 2; ++ks) { if (ks == 1 && mt < 2) continue;
                const bf16x8 aT = *(const LAS bf16x8*)(Tl + (mt * 16 + r) * TS + ks * 32 + q8 * 8);
                aU = __builtin_amdgcn_mfma_f32_16x16x32_bf16(aT, bv[ks], aU, 0, 0, 0);
                aW = __builtin_amdgcn_mfma_f32_16x16x32_bf16(bk[ks], aT, aW, 0, 0, 0); }
            *(f32x4*)((float*)(trp + TR_U) + ((wave * 4 + mt) * 64 + lane) * 4) = aU;
            u32x2 o; o.x = pk2(-aW[0], -aW[1]); o.y = pk2(-aW[2], -aW[3]);
            *(u32x2*)((bf16_t*)(trp + TR_W) + (mt * 16 + r) * 128 + c0 + q8 * 4) = o;
        }
#pragma unroll
        for (int ii = 0; ii < 2; ++ii) { const int item = tid + 512 * ii, dk = item & 127, oct = item >> 7; float kv[8];
#pragma unroll
            for (int j = 0; j < 8; ++j) kv[j] = bf2f(KTl[(oct * 8 + j) * PS + dk]);
            *(u32x4*)((bf16_t*)(trp + TR_K) + dk * 64 + oct * 8) = pack8(kv); }
    }
    __syncthreads();
}
__device__ __forceinline__ void conva_prompt(const bf16_t* z, const float* caw, bf16_t* ycat, int gt, int GT) {
#pragma unroll 2
    for (int idx = gt; idx < MP * 128; idx += GT) {
        const int row = idx >> 7, c8 = (idx & 127) * 8, t = row & (SEQ - 1);
        const bf16_t* zr = z + (size_t)row * NZ + c8;
        float conv[8];
#pragma unroll
        for (int i = 0; i < 8; ++i) conv[i] = 0.f;
#pragma unroll
        for (int j = 0; j < 3; ++j) {
            const bool ok = t - 2 + j >= 0; const ptrdiff_t ro = (ptrdiff_t)(ok ? j - 2 : 0) * NZ;
            u32x4 c = *(const u32x4*)(zr + ro + 1024); const u32x4 hh = *(const u32x4*)(zr + ro + 2048);
            if (!ok) c = (u32x4){0u, 0u, 0u, 0u};
            const f32x4 w0 = *(const f32x4*)(caw + j * 1024 + c8), w1 = *(const f32x4*)(caw + j * 1024 + c8 + 4);
            conv[0] += w0.x * (bflo(c.x) * bflo(hh.x)); conv[1] += w0.y * (bfhi(c.x) * bfhi(hh.x)); conv[2] += w0.z * (bflo(c.y) * bflo(hh.y)); conv[3] += w0.w * (bfhi(c.y) * bfhi(hh.y));
            conv[4] += w1.x * (bflo(c.z) * bflo(hh.z)); conv[5] += w1.y * (bfhi(c.z) * bfhi(hh.z)); conv[6] += w1.z * (bflo(c.w) * bflo(hh.w)); conv[7] += w1.w * (bfhi(c.w) * bfhi(hh.w));
        }
        const u32x4 bb = *(const u32x4*)zr, gg = *(const u32x4*)(zr + 3072);
        float y[8];
        y[0] = bflo(bb.x) * conv[0] * silu_f(bflo(gg.x)); y[1] = bfhi(bb.x) * conv[1] * silu_f(bfhi(gg.x)); y[2] = bflo(bb.y) * conv[2] * silu_f(bflo(gg.y)); y[3] = bfhi(bb.y) * conv[3] * silu_f(bfhi(gg.y));
        y[4] = bflo(bb.z) * conv[4] * silu_f(bflo(gg.z)); y[5] = bfhi(bb.z) * conv[5] * silu_f(bfhi(gg.z)); y[6] = bflo(bb.w) * conv[6] * silu_f(bflo(gg.w)); y[7] = bfhi(bb.w) * conv[7] * silu_f(bfhi(gg.w));
        *(u32x4*)(ycat + (size_t)row * DM + c8) = pack8(y);
    }
}
__device__ __forceinline__ void conv_states_prompt(const bf16_t* z, float* oca, float* ocq, int gt, int GT) {
    for (int idx = gt; idx < NB * 2 * 1024; idx += GT) { const int c = idx & 1023, j = (idx >> 10) & 1, b = idx >> 11;
        const bf16_t* zr = z + (size_t)(b * SEQ + SEQ - 2 + j) * NZ; oca[idx] = bf2f(zr[1024 + c]) * bf2f(zr[2048 + c]); }
    for (int idx = gt; idx < NB * 3 * 3072; idx += GT) { const int c = (int)((unsigned)idx % 3072u), j = (int)((unsigned)idx / 3072u) % 3, b = (int)((unsigned)idx / 9216u);
        ocq[idx] = bf2f(z[(size_t)(b * SEQ + SEQ - 3 + j) * NZ + 4096 + c]); }
}

struct ScanP { const unsigned char* tr; const float* gl; float* obuf; float* sout; };
constexpr int SB_W = 0, SB_Q = 64 * PS * 2, SB_A = 2 * 64 * PS * 2, SB_K = SB_A + 64 * TS * 2, SB_SZ = SB_K + 128 * TS * 2;
static_assert(2 * SB_SZ <= 131072, "scan LDS");
__device__ __forceinline__ bf16x8 frag1(const LAS bf16_t* p) { return *(const LAS bf16x8*)p; }
__device__ __forceinline__ bf16x8 packB(const f32x4& a, const f32x4& b) { u32x4 v = {pk2(a[0], a[1]), pk2(a[2], a[3]), pk2(b[0], b[1]), pk2(b[2], b[3])}; return __builtin_bit_cast(bf16x8, v); }
__device__ __forceinline__ void scan_bh(LAS unsigned char* lds, const ScanP& P, int b, int h, int half, int tid, int lane, int wave) {
    const bool cw = wave < 4;
    const int r = lane & 15, q8 = lane >> 4, ct = half * 4 + (wave & 3), c0 = ct * 16;
    if (!cw) {
        const int lt = tid - 256, wrow = lt >> 4, wc16 = lt & 15, arow = lt >> 3, ac16 = lt & 7;
        const int wperm = (wc16 >> 2) * 32 + ((((wc16 & 3) * 8) & 15) >> 2) * 8 + (((wc16 & 3) * 8) >> 4) * 4, aperm = (ac16 >> 2) * 32 + ((((ac16 & 3) * 8) & 15) >> 2) * 8 + (((ac16 & 3) * 8) >> 4) * 4;
        const unsigned oW = (unsigned)TR_W + (unsigned)(wrow * 128 + wc16 * 8) * 2u, oQ = oW + (unsigned)(TR_Q - TR_W), oA = (unsigned)TR_A + (unsigned)(arow * 64 + ac16 * 8) * 2u, oK = oA + (unsigned)(TR_K - TR_A);
        const unsigned lW = (unsigned)(wrow * PS + wperm) * 2u, lA = (unsigned)(arow * TS + aperm) * 2u;
        u32x4 sa[14], sb[14];
#define L_LOAD(nn, d) do { const unsigned char* tr_ = P.tr + (size_t)((b << 8) | ((nn) << 3) | h) * TR_SZ; \
            _Pragma("unroll") for (int i = 0; i < 4; ++i) { d[i] = *(const u32x4*)(tr_ + (oW + 4096u * i)); d[4 + i] = *(const u32x4*)(tr_ + (oQ + 4096u * i)); d[10 + i] = *(const u32x4*)(tr_ + (oK + 4096u * i)); } \
            d[8] = *(const u32x4*)(tr_ + oA); d[9] = *(const u32x4*)(tr_ + (oA + 4096u)); } while (0)
#define ST2(base, boff, v) do { *(LAS u32x2*)((base) + (boff)) = (u32x2){(v).x, (v).y}; *(LAS u32x2*)((base) + (boff) + 16u) = (u32x2){(v).z, (v).w}; } while (0)
#define L_STORE(bufp, s_) do { LAS unsigned char* bp_ = (bufp); \
            _Pragma("unroll") for (int i = 0; i < 4; ++i) { ST2(bp_ + SB_W, lW + (unsigned)(16 * PS * 2 * i), s_[i]); ST2(bp_ + SB_Q, lW + (unsigned)(16 * PS * 2 * i), s_[4 + i]); ST2(bp_ + SB_K, lA + (unsigned)(32 * TS * 2 * i), s_[10 + i]); } \
            ST2(bp_ + SB_A, lA, s_[8]); ST2(bp_ + SB_A, lA + (unsigned)(32 * TS * 2), s_[9]); } while (0)
        L_LOAD(0, sa); L_STORE(lds, sa); L_LOAD(1, sa);
        __syncthreads();
#pragma unroll 1
        for (int n = 0; n < 32; n += 2) {
            if (n + 2 < 32) L_LOAD(n + 2, sb);
            L_STORE(lds + ((n + 1) & 1) * SB_SZ, sa);
            LBAR();
            if (n + 3 < 32) L_LOAD(n + 3, sa);
            if (n + 2 < 32) L_STORE(lds + ((n + 2) & 1) * SB_SZ, sb);
            LBAR();
        }
#undef L_LOAD
#undef L_STORE
#undef ST2
    } else {
        f32x4 S[8];
#pragma unroll
        for (int i = 0; i < 8; ++i) S[i] = (f32x4){0.f, 0.f, 0.f, 0.f};
        const float glv = (lane < 32) ? P.gl[(b << 8) | (lane << 3) | h] : 0.f;
        f32x4 ubn[4];
        const unsigned oU = (unsigned)TR_U + (unsigned)(ct * 256 + lane) * 16u;
#define U_LOAD(nn) do { const unsigned char* tr_ = P.tr + (size_t)((b << 8) | ((nn) << 3) | h) * TR_SZ; \
            _Pragma("unroll") for (int mt_ = 0; mt_ < 4; ++mt_) ubn[mt_] = *(const f32x4*)(tr_ + (oU + (unsigned)mt_ * 1024u)); } while (0)
        U_LOAD(0);
        __syncthreads();
#pragma unroll 1
        for (int n = 0; n < 32; ++n) {
            LAS unsigned char* buf = lds + (n & 1) * SB_SZ;
            const LAS bf16_t* Wl = (const LAS bf16_t*)(buf + SB_W); const LAS bf16_t* Ql = (const LAS bf16_t*)(buf + SB_Q);
            const LAS bf16_t* Al = (const LAS bf16_t*)(buf + SB_A); const LAS bf16_t* Kl = (const LAS bf16_t*)(buf + SB_K);
            f32x4 u[4], o[4];
#pragma unroll
            for (int mt = 0; mt < 4; ++mt) { u[mt] = ubn[mt]; o[mt] = (f32x4){0.f, 0.f, 0.f, 0.f}; }
            if (n + 1 < 32) U_LOAD(n + 1);
        bf16x8 Sb[4];
#pragma unroll
        for (int ks = 0; ks < 4; ++ks) Sb[ks] = packB(S[2 * ks], S[2 * ks + 1]);
#define SBAR() __builtin_amdgcn_sched_barrier(0)
#define LD4(d, base, mt, stride) do { _Pragma("unroll") for (int ks = 0; ks < 4; ++ks) d[ks] = frag1((base) + ((mt) * 16 + r) * (stride) + ks * 32 + q8 * 8); } while (0)
#define MM4(acc, s_) do { _Pragma("unroll") for (int ks = 0; ks < 4; ++ks) acc = __builtin_amdgcn_mfma_f32_16x16x32_bf16(s_[ks], Sb[ks], acc, 0, 0, 0); } while (0)
        {
            bf16x8 fA[4], fB[4];
            LD4(fA, Wl, 0, PS); SBAR(); LD4(fB, Ql, 0, PS); SBAR();
            MM4(u[0], fA); SBAR(); LD4(fA, Wl, 1, PS); SBAR(); MM4(o[0], fB); SBAR(); LD4(fB, Ql, 1, PS); SBAR();
            MM4(u[1], fA); SBAR(); LD4(fA, Wl, 2, PS); SBAR(); MM4(o[1], fB); SBAR(); LD4(fB, Ql, 2, PS); SBAR();
            MM4(u[2], fA); SBAR(); LD4(fA, Wl, 3, PS); SBAR(); MM4(o[2], fB); SBAR(); LD4(fB, Ql, 3, PS); SBAR();
            MM4(u[3], fA); SBAR(); MM4(o[3], fB); SBAR();
        }
        bf16x8 Ub[2];
        Ub[0] = packB(u[0], u[1]); Ub[1] = packB(u[2], u[3]);
        const float gl = __shfl(glv, n);
#define LDK(d, dt0) do { d[0] = frag1(Kl + ((dt0) * 16 + r) * TS + q8 * 8); d[1] = frag1(Kl + ((dt0) * 16 + r) * TS + 32 + q8 * 8); d[2] = frag1(Kl + (((dt0) + 1) * 16 + r) * TS + q8 * 8); d[3] = frag1(Kl + (((dt0) + 1) * 16 + r) * TS + 32 + q8 * 8); } while (0)
#define MMK(s_, dt0) do { S[dt0] = S[dt0] * gl; S[(dt0) + 1] = S[(dt0) + 1] * gl; \
            S[dt0] = __builtin_amdgcn_mfma_f32_16x16x32_bf16(s_[0], Ub[0], S[dt0], 0, 0, 0); S[(dt0) + 1] = __builtin_amdgcn_mfma_f32_16x16x32_bf16(s_[2], Ub[0], S[(dt0) + 1], 0, 0, 0); \
            S[dt0] = __builtin_amdgcn_mfma_f32_16x16x32_bf16(s_[1], Ub[1], S[dt0], 0, 0, 0); S[(dt0) + 1] = __builtin_amdgcn_mfma_f32_16x16x32_bf16(s_[3], Ub[1], S[(dt0) + 1], 0, 0, 0); } while (0)
        {
            bf16x8 aA[6], kA[4], kB[4];
            aA[0] = frag1(Al + (0 * 16 + r) * TS + q8 * 8); aA[1] = frag1(Al + (1 * 16 + r) * TS + q8 * 8);
            aA[2] = frag1(Al + (2 * 16 + r) * TS + q8 * 8); aA[3] = frag1(Al + (2 * 16 + r) * TS + 32 + q8 * 8);
            aA[4] = frag1(Al + (3 * 16 + r) * TS + q8 * 8); aA[5] = frag1(Al + (3 * 16 + r) * TS + 32 + q8 * 8);
            SBAR(); LDK(kA, 0); SBAR();
            o[0] = __builtin_amdgcn_mfma_f32_16x16x32_bf16(aA[0], Ub[0], o[0], 0, 0, 0); o[1] = __builtin_amdgcn_mfma_f32_16x16x32_bf16(aA[1], Ub[0], o[1], 0, 0, 0);
            o[2] = __builtin_amdgcn_mfma_f32_16x16x32_bf16(aA[2], Ub[0], o[2], 0, 0, 0); o[3] = __builtin_amdgcn_mfma_f32_16x16x32_bf16(aA[4], Ub[0], o[3], 0, 0, 0);
            o[2] = __builtin_amdgcn_mfma_f32_16x16x32_bf16(aA[3], Ub[1], o[2], 0, 0, 0); o[3] = __builtin_amdgcn_mfma_f32_16x16x32_bf16(aA[5], Ub[1], o[3], 0, 0, 0);
            SBAR(); LDK(kB, 2); SBAR(); MMK(kA, 0); SBAR(); LDK(kA, 4); SBAR(); MMK(kB, 2); SBAR(); LDK(kB, 6); SBAR(); MMK(kA, 4); SBAR(); MMK(kB, 6); SBAR();
        }
#undef LD4
#undef MM4
#undef LDK
#undef MMK
#undef SBAR
        { unsigned oO = (unsigned)((q8 * 4) * 1024 + c0 + r) * 4u; asm volatile("" : "+v"(oO));
          unsigned char* ob = (unsigned char*)(P.obuf + (size_t)(b * SEQ + n * 64) * 1024 + h * 128);
#pragma unroll
          for (int mt = 0; mt < 4; ++mt)
#pragma unroll
              for (int j = 0; j < 4; ++j) *(float*)(ob + (oO + (unsigned)(mt * 16 + j) * 4096u)) = o[mt][j]; }
            LBAR();
        }
#undef U_LOAD
#pragma unroll
        for (int dt = 0; dt < 8; ++dt)
#pragma unroll
            for (int j = 0; j < 4; ++j) P.sout[(size_t)(dt * 16 + q8 * 4 + j) * HD + c0 + r] = S[dt][j];
    }
    __syncthreads();
}
__device__ __forceinline__ void onorm_pass(const float* obuf, const bf16_t* z, const float* ong, bf16_t* ycat, int gw, int NGW, int lane) {
    const int cl = (lane & 7) * 16;
    f32x4 g[4];
#pragma unroll
    for (int i = 0; i < 4; ++i) g[i] = *(const f32x4*)(ong + cl + 4 * i);
#pragma unroll 2
    for (int row = gw; row < MP; row += NGW) {
        const float* op = obuf + (size_t)row * 1024 + lane * 16; const bf16_t* zp = z + (size_t)row * NZ + 7168 + lane * 16;
        f32x4 v[4]; float ss = 0.f;
#pragma unroll
        for (int i = 0; i < 4; ++i) { v[i] = *(const f32x4*)(op + 4 * i); ss += (v[i].x * v[i].x + v[i].y * v[i].y) + (v[i].z * v[i].z + v[i].w * v[i].w); }
        const u32x4 g0 = *(const u32x4*)zp, g1 = *(const u32x4*)(zp + 8);
        ss += __builtin_bit_cast(float, __builtin_amdgcn_update_dpp(0, __builtin_bit_cast(int, ss), 0xB1, 0xF, 0xF, true));
        ss += __builtin_bit_cast(float, __builtin_amdgcn_update_dpp(0, __builtin_bit_cast(int, ss), 0x4E, 0xF, 0xF, true));
        ss += __builtin_bit_cast(float, __builtin_amdgcn_update_dpp(0, __builtin_bit_cast(int, ss), 0x141, 0xF, 0xF, true));
        const float rstd = rsq_f(ss * (1.f / HD) + EPS);
        float y[16];
        y[0] = v[0].x * rstd * g[0].x * silu_f(bflo(g0.x)); y[1] = v[0].y * rstd * g[0].y * silu_f(bfhi(g0.x)); y[2] = v[0].z * rstd * g[0].z * silu_f(bflo(g0.y)); y[3] = v[0].w * rstd * g[0].w * silu_f(bfhi(g0.y));
        y[4] = v[1].x * rstd * g[1].x * silu_f(bflo(g0.z)); y[5] = v[1].y * rstd * g[1].y * silu_f(bfhi(g0.z)); y[6] = v[1].z * rstd * g[1].z * silu_f(bflo(g0.w)); y[7] = v[1].w * rstd * g[1].w * silu_f(bfhi(g0.w));
        y[8] = v[2].x * rstd * g[2].x * silu_f(bflo(g1.x)); y[9] = v[2].y * rstd * g[2].y * silu_f(bfhi(g1.x)); y[10] = v[2].z * rstd * g[2].z * silu_f(bflo(g1.y)); y[11] = v[2].w * rstd * g[2].w * silu_f(bfhi(g1.y));
        y[12] = v[3].x * rstd * g[3].x * silu_f(bflo(g1.z)); y[13] = v[3].y * rstd * g[3].y * silu_f(bfhi(g1.z)); y[14] = v[3].z * rstd * g[3].z * silu_f(bflo(g1.w)); y[15] = v[3].w * rstd * g[3].w * silu_f(bfhi(g1.w));
        bf16_t* yp = ycat + (size_t)row * DM + 1024 + lane * 16;
        *(u32x4*)yp = pack8(y); *(u32x4*)(yp + 8) = pack8(y + 8);
    }
}
struct SampP { const float* zs; const float* sca; const float* scq; const float* s0; const float* caw; const float* cqw; const float* alog; const float* dtb; const float* ong;
               bf16_t* ycat; float* oca; float* ocq; float* oss; };
__device__ __forceinline__ void sample_task(LAS unsigned char* lds, const SampP& P, int task, int tid, int lane, int wave) {
    const int h = task & 7, bs = task >> 3;
    LAS float* qv = (LAS float*)lds; LAS float* kv = qv + 128; LAS float* vv = kv + 128; LAS float* part = vv + 128; LAS float* pks = part + 16; LAS float* pqs = pks + 1024;
    const float* s0 = P.s0 + (size_t)(bs * 8 + h) * 16384; float* so = P.oss + (size_t)(bs * 8 + h) * 16384;
    const int half = lane >> 5, c4 = (lane & 31) * 4;
    f32x4 sr[8];
#pragma unroll
    for (int i = 0; i < 8; ++i) sr[i] = *(const f32x4*)(s0 + (size_t)(wave * 16 + 2 * i + half) * 128 + c4);
    const float* zr = P.zs + (size_t)bs * DINP;
    const float zbeta = zr[8192 + h], zalpha = zr[8200 + h], alg = P.alog[h], dtbv = P.dtb[h];
    f32x4 ongv = {0.f, 0.f, 0.f, 0.f}, gbv = {0.f, 0.f, 0.f, 0.f};
    if (wave == 0 && lane < 32) { ongv = *(const f32x4*)(P.ong + c4); gbv = *(const f32x4*)(zr + 7168 + h * 128 + c4); }
    float qkv[3] = {0.f, 0.f, 0.f};
    if (tid < 128) {
        const int cc = h * 128 + tid;
        { const float ch = zr[1024 + cc] * zr[2048 + cc]; const float s0a = P.sca[(bs * 2 + 0) * 1024 + cc], s1a = P.sca[(bs * 2 + 1) * 1024 + cc];
          const float conv = P.caw[cc] * s0a + P.caw[1024 + cc] * s1a + P.caw[2048 + cc] * ch;
          P.ycat[(size_t)(MP + bs) * DM + cc] = f2bf(zr[cc] * conv * silu_f(zr[3072 + cc]));
          P.oca[(bs * 2 + 0) * 1024 + cc] = s1a; P.oca[(bs * 2 + 1) * 1024 + cc] = ch; }
#pragma unroll
        for (int m = 0; m < 3; ++m) { const int c3 = m * 1024 + cc; const float pre = zr[4096 + c3];
            const float a0 = P.scq[(bs * 3 + 0) * 3072 + c3], a1 = P.scq[(bs * 3 + 1) * 3072 + c3], a2 = P.scq[(bs * 3 + 2) * 3072 + c3];
            qkv[m] = silu_f(P.cqw[c3] * a0 + P.cqw[3072 + c3] * a1 + P.cqw[2 * 3072 + c3] * a2 + P.cqw[3 * 3072 + c3] * pre);
            P.ocq[(bs * 3 + 0) * 3072 + c3] = a1; P.ocq[(bs * 3 + 1) * 3072 + c3] = a2; P.ocq[(bs * 3 + 2) * 3072 + c3] = pre; }
        const float sq = wave_sum(qkv[0] * qkv[0]), sk = wave_sum(qkv[1] * qkv[1]);
        if (lane == 0) { part[wave * 2] = sq; part[wave * 2 + 1] = sk; }
    }
    __syncthreads();
    if (tid < 128) { const float sq = part[0] + part[2], sk = part[1] + part[3];
        qv[tid] = qkv[0] * rsq_f(sq + EPS) * 0.08838834764831845f; kv[tid] = qkv[1] * rsq_f(sk + EPS); vv[tid] = qkv[2]; }
    __syncthreads();
    f32x4 pk = {0.f, 0.f, 0.f, 0.f}, pq = {0.f, 0.f, 0.f, 0.f};
#pragma unroll
    for (int i = 0; i < 8; ++i) { const int row = wave * 16 + 2 * i + half; pk += kv[row] * sr[i]; pq += qv[row] * sr[i]; }
#pragma unroll
    for (int e = 0; e < 4; ++e) { pk[e] += __shfl_xor(pk[e], 32); pq[e] += __shfl_xor(pq[e], 32); }
    if (lane < 32) { *(LAS f32x4*)(pks + wave * 128 + c4) = pk; *(LAS f32x4*)(pqs + wave * 128 + c4) = pq; }
    const float qk = wave_sum(qv[lane] * kv[lane] + qv[lane + 64] * kv[lane + 64]);
    __syncthreads();
    f32x4 ks = {0.f, 0.f, 0.f, 0.f}, qs = {0.f, 0.f, 0.f, 0.f};
#pragma unroll
    for (int w = 0; w < 8; ++w) { ks += *(const LAS f32x4*)(pks + w * 128 + c4); qs += *(const LAS f32x4*)(pqs + w * 128 + c4); }
    const float beta = sigmoid_f(zbeta);
    const float eg = exp_f(-exp_f(alg) * softplus_f(zalpha + dtbv));
    const f32x4 v4 = *(const LAS f32x4*)(vv + c4);
    const f32x4 u = beta * (v4 - eg * ks);
    const f32x4 o = eg * qs + qk * u;
#pragma unroll
    for (int i = 0; i < 8; ++i) { const int row = wave * 16 + 2 * i + half; *(f32x4*)(so + (size_t)row * 128 + c4) = eg * sr[i] + kv[row] * u; }
    if (wave == 0) {
        float ss = (lane < 32) ? (o.x * o.x + o.y * o.y) + (o.z * o.z + o.w * o.w) : 0.f;
        const float rstd = rsq_f(wave_sum(ss) * (1.f / HD) + EPS);
        if (lane < 32) { const f32x4 g = ongv, gb = gbv;
            u32x2 w; w.x = pk2(o.x * rstd * g.x * silu_f(gb.x), o.y * rstd * g.y * silu_f(gb.y)); w.y = pk2(o.z * rstd * g.z * silu_f(gb.z), o.w * rstd * g.w * silu_f(gb.w));
            *(u32x2*)(P.ycat + (size_t)(MP + bs) * DM + 1024 + h * 128 + c4) = w; }
    }
    __syncthreads();
}

struct Args { const float* in[18]; float* out; unsigned char* ws; };
__global__ void __launch_bounds__(512, 2) mega(Args a) {
    extern __shared__ __attribute__((aligned(16))) unsigned char lds_raw[];
    cg::grid_group grid = cg::this_grid();
    LAS unsigned char* lds = (LAS unsigned char*)lds_raw;
    constexpr int G = 256, NGW = G * 8, GT = G * 512;
    const int bx0 = blockIdx.x, wave0 = __builtin_amdgcn_readfirstlane(threadIdx.x >> 6);
    const Args* ap0 = (const Args*)__builtin_amdgcn_kernarg_segment_ptr();
#define FRESH() unsigned m_ = ~0u; asm volatile("" : "+s"(m_)); int tid = (wave0 << 6) | (int)__builtin_amdgcn_mbcnt_hi(m_, __builtin_amdgcn_mbcnt_lo(m_, 0u)); asm volatile("" : "+v"(tid)); FRESH_S(); const int lane = tid & 63, wave = __builtin_amdgcn_readfirstlane(tid >> 6), gw = bx * 8 + wave, gt = bx * 512 + tid; (void)lane; (void)gw; (void)gt
#define FRESH_S() int bx = bx0; const Args* ap = ap0; asm volatile("" : "+s"(bx), "+s"(ap)); unsigned char* ws = ap->ws
#define GBAR() do { FRESH_S(); XcdBarrier xb_; xb_.bar = (unsigned*)(ws + WS_CTL); xb_.x = xb_xcc_id(); xb_.st = (volatile LAS unsigned*)(lds + 131072 + 32); xcd_barrier(xb_); } while (0)
#define WSP(T, off) ((T*)(ws + (off)))
    { volatile LAS unsigned* misc = (volatile LAS unsigned*)(lds + 131072); if (threadIdx.x < 32) misc[threadIdx.x] = 0u; __syncthreads();
      (void)xcd_barrier_post((unsigned*)(ap0->ws + WS_CTL), misc + 8); }
    constexpr int I_IN = 32 * 257, I_OUT = 32 * 64, I_ADA = 32 * 192;
    {
        FRESH();
        LAS float* scr = (LAS float*)(lds + wave * 16384);
#pragma unroll 1
        for (int it = gw; it < 4 * I_ADA; it += NGW) { const int l = it / I_ADA, r = it - l * I_ADA;
            transpose_item(ap->in[8] + (size_t)l * DM * 3 * DM, DM, 3 * DM, WSP(bf16_t, WS_WADA) + (size_t)l * 3 * DM * DM, scr, r, lane); }
        const float* c_prompt = ap->in[5]; const float* c_sample = ap->in[6]; bf16_t* ca = WSP(bf16_t, WS_CA);
        for (int idx = gt; idx < (NB + DECB) * DM; idx += GT) { const int row = idx >> 11, c = idx & 2047;
            const float v = row < NB ? c_prompt[row * DM + c] : c_sample[(row - NB) * DM + c]; ca[idx] = f2bf(silu_f(v)); }
    }
    if (ap0->out == nullptr) grid.sync();
    GBAR();
    {
        FRESH();
        constexpr int NGEMM = MODLD / 256, NIT2 = 4 * (I_IN + I_OUT), N1 = 35000;
        if (bx < NGEMM) {
            pg8::Gemm g{WSP(bf16_t, WS_CA), WSP(bf16_t, WS_WADA), 256, MODLD, DM}; pg8::StaticOrder S; S.init(256, MODLD, G, bx);
            EpiF32Bias E{WSP(float, WS_MOD), MODLD, ap->in[9]};
            pg8::gemm_phase<EpiF32Bias, pg8::StaticOrder, true, true>(lds, g, S, E, tid);
        }
        LAS float* scr = (LAS float*)(lds + wave * 16384);
        const int it0 = bx < NGEMM ? N1 + bx * 8 + wave : (bx - NGEMM) * 8 + wave, itN = bx < NGEMM ? NIT2 : N1, its = bx < NGEMM ? NGEMM * 8 : (G - NGEMM) * 8;
#pragma unroll 1
        for (int it = it0; it < itN; it += its) {
            int r = it;
            if (r < 4 * I_IN) { const int l = r / I_IN; r -= l * I_IN; transpose_item(ap->in[10] + (size_t)l * DM * DIN, DM, DIN, WSP(bf16_t, WS_WIN) + (size_t)l * DINP * DM, scr, r, lane); }
            else { r -= 4 * I_IN; const int l = r / I_OUT; r -= l * I_OUT; transpose_item(ap->in[16] + (size_t)l * DM * DM, DM, DM, WSP(bf16_t, WS_WOUT) + (size_t)l * DM * DM, scr, r, lane); }
        }
    }
    GBAR();
#pragma unroll 1
    for (int l = 0; l < DEPTH; ++l) {
        {
            FRESH();
            float* xcur = WSP(float, WS_X);
            phase_norm(l == 0 ? ap->in[0] : xcur, l == 0 ? ap->in[1] : xcur + (size_t)MP * DM, ap->in[7] + l * DM, WSP(float, WS_MOD) + (size_t)l * 3 * DM, WSP(bf16_t, WS_HB), gw, NGW, lane);
        }
        GBAR();
        {
            FRESH();
            const bf16_t* Wi = WSP(bf16_t, WS_WIN) + (size_t)l * DINP * DM; const bf16_t* hb = WSP(bf16_t, WS_HB);
            {
                pg8::Gemm g{hb, Wi, MP, NZ, DM}; pg8::StaticOrder S; S.init(MP, NZ, G, bx);
                pg8::EpiBf16<0> E{WSP(bf16_t, WS_Z), NZ, nullptr, 0, 0, 1.f};
                pg8::gemm_phase<pg8::EpiBf16<0>, pg8::StaticOrder, true, true>(lds, g, S, E, tid);
            }
            float* zs = WSP(float, WS_ZS); float* ba = WSP(float, WS_BA);
            const int r = lane & 15, q8 = lane >> 4;
#pragma unroll 1
            for (int task = bx; task < NZ / 32; task += G) sample_gemm32(lds, hb + (size_t)MP * DM, Wi + (size_t)task * 32 * DM, zs, DINP, task * 32, tid, lane, wave);
            for (int task = wave * G + bx; task < 8 + MP / 16; task += NGW) {
                if (task < 8) { const int mt = task;
                    const f32x4 acc = skinny16(hb + (size_t)(MP + mt * 16) * DM, DM, Wi + (size_t)NZ * DM, DM, DM, lane);
#pragma unroll
                    for (int j = 0; j < 4; ++j) zs[(size_t)(mt * 16 + q8 * 4 + j) * DINP + NZ + r] = acc[j];
                } else { const int pt = task - 8;
                    const f32x4 acc = skinny16(hb + (size_t)pt * 16 * DM, DM, Wi + (size_t)NZ * DM, DM, DM, lane);
#pragma unroll
                    for (int j = 0; j < 4; ++j) ba[(size_t)(pt * 16 + q8 * 4 + j) * 16 + r] = acc[j];
                }
            }
        }
        GBAR();
        {
            FRESH();
            const bf16_t* z = WSP(bf16_t, WS_Z);
            PrepP P{z, WSP(float, WS_BA), ap->in[12] + (size_t)l * 4 * 3072, ap->in[13] + l * NH, ap->in[14] + l * NH, WSP(unsigned char, WS_TR), WSP(float, WS_GL)};
            prep_weights(lds, P.cw, bx & 7, tid);
#pragma unroll 1
            for (int task = bx; task < NB * 32 * NH; task += G) prep_task(lds, P, task, tid, lane, wave);
        }
        GBAR();
        if (bx0 < 2 * NB * NH) {
            FRESH();
            const int b = bx >> 4, h = (bx >> 1) & 7, half = bx & 1;
            ScanP P{WSP(unsigned char, WS_TR), WSP(float, WS_GL), WSP(float, WS_OB), ap->out + O_SP + ((size_t)(l * NB + b) * NH + h) * HD * HD};
            scan_bh(lds, P, b, h, half, tid, lane, wave);
        } else {
            FRESH();
            SampP P{WSP(float, WS_ZS), ap->in[2] + (size_t)l * DECB * 2 * 1024, ap->in[3] + (size_t)l * DECB * 3 * 3072, ap->in[4] + (size_t)l * DECB * NH * HD * HD, ap->in[11] + (size_t)l * 3 * 1024,
                    ap->in[12] + (size_t)l * 4 * 3072, ap->in[13] + l * NH, ap->in[14] + l * NH, ap->in[15] + l * HD, WSP(bf16_t, WS_YCAT), ap->out + O_CAS + (size_t)l * DECB * 2 * 1024,
                    ap->out + O_CQS + (size_t)l * DECB * 3 * 3072, ap->out + O_SS + (size_t)l * DECB * NH * HD * HD};
#pragma unroll 1
            for (int task = bx - 2 * NB * NH; task < DECB * NH; task += G - 2 * NB * NH) sample_task(lds, P, task, tid, lane, wave);
            { constexpr int GT2 = (G - 2 * NB * NH) * 512; const int gt2 = (bx - 2 * NB * NH) * 512 + tid; const bf16_t* z = WSP(bf16_t, WS_Z);
              conva_prompt(z, ap->in[11] + (size_t)l * 3 * 1024, WSP(bf16_t, WS_YCAT), gt2, GT2);
              conv_states_prompt(z, ap->out + O_CAP + (size_t)l * NB * 2 * 1024, ap->out + O_CQP + (size_t)l * NB * 3 * 3072, gt2, GT2); }
        }
        GBAR();
        {
            FRESH();
            if (wave >= 4) onorm_pass(WSP(float, WS_OB), WSP(bf16_t, WS_Z), ap->in[15] + l * HD, WSP(bf16_t, WS_YCAT), bx * 4 + (wave - 4), G * 4, lane);
            else {
                const bf16_t* Wo = WSP(bf16_t, WS_WOUT) + (size_t)l * DM * DM; const bf16_t* ycat = WSP(bf16_t, WS_YCAT); float* xcur = WSP(float, WS_X);
                const float* modg = WSP(float, WS_MOD) + (size_t)l * 3 * DM + 2 * DM;
                const int r = lane & 15, q8 = lane >> 4;
                const float* xb = l == 0 ? ap->in[1] : xcur + (size_t)MP * DM;
                const int task = wave * G + bx, mt = task & 7, nt = task >> 3;
                const f32x4 acc = skinny16(ycat + (size_t)(MP + mt * 16) * DM, DM, Wo + (size_t)nt * 16 * DM, DM, DM, lane);
#pragma unroll
                for (int j = 0; j < 4; ++j) { const int row = mt * 16 + q8 * 4 + j, col = nt * 16 + r;
                    xcur[(size_t)(MP + row) * DM + col] = xb[(size_t)row * DM + col] + modg[(size_t)(NB + row) * MODLD + col] * acc[j]; }
            }
        }
        GBAR();
        {
            FRESH();
            const bf16_t* Wo = WSP(bf16_t, WS_WOUT) + (size_t)l * DM * DM; const bf16_t* ycat = WSP(bf16_t, WS_YCAT); float* xcur = WSP(float, WS_X);
            const float* modg = WSP(float, WS_MOD) + (size_t)l * 3 * DM + 2 * DM;
            {
                pg8::Gemm g{ycat, Wo, MP, DM, DM}; pg8::StaticOrder S; S.init(MP, DM, G, bx);
                EpiResGate E{l == 0 ? ap->in[0] : xcur, xcur, modg, DM};
                pg8::gemm_phase<EpiResGate, pg8::StaticOrder, true, true>(lds, g, S, E, tid);
            }
        }
        GBAR();
    }
    { FRESH(); phase_final(WSP(float, WS_X), ap->in[17], ap->out, gw, NGW, lane); }
#undef FRESH
#undef GBAR
#undef WSP
}

extern "C" void kernel_launch(void* const* d_in, const int* in_sizes, int n_in, void* d_out, int out_size, void* d_ws, size_t ws_size, hipStream_t stream) {
    static int grid = 0;
    if (!grid) {
        if (n_in != 18 || (size_t)out_size != O_END || ws_size < WS_END) { fprintf(stderr, "kernel_launch: unexpected shapes (n_in %d out %d ws %zu)\n", n_in, out_size, ws_size); grid = -1; return; }
        int dev = 0, cus = 0, per_cu = 0;
        (void)hipGetDevice(&dev);
        (void)hipDeviceGetAttribute(&cus, hipDeviceAttributeMultiprocessorCount, dev);
        (void)hipFuncSetAttribute((const void*)mega, hipFuncAttributeMaxDynamicSharedMemorySize, LDS_BYTES);
        (void)hipOccupancyMaxActiveBlocksPerMultiprocessor(&per_cu, (const void*)mega, 512, LDS_BYTES);
        if (per_cu < 1) per_cu = 1;
        grid = cus * per_cu;
        if (grid != 256) { fprintf(stderr, "kernel_launch: this kernel is built for a 256-workgroup grid (256 CUs x 1), got %d\n", grid); grid = -1; return; }
        fprintf(stderr, "kernel_launch: grid %d (cus %d per_cu %d)\n", grid, cus, per_cu);
    }
    if (grid < 0) return;
    if (hipMemsetAsync((char*)d_ws + WS_CTL, 0, 16384, stream) != hipSuccess) { fprintf(stderr, "kernel_launch: memset of the barrier words failed\n"); return; }
    Args a{};
    for (int i = 0; i < 18; ++i) a.in[i] = (const float*)d_in[i];
    a.out = (float*)d_out; a.ws = (unsigned char*)d_ws;
    void* args[] = {&a};
    hipError_t e = hipLaunchCooperativeKernel((void*)mega, dim3(grid), dim3(512), args, LDS_BYTES, stream);
    if (e != hipSuccess) fprintf(stderr, "cooperative launch failed: %s (grid %d)\n", hipGetErrorString(e), grid);
}
```

```cpp
#include <hip/hip_runtime.h>
#include <hip/hip_cooperative_groups.h>
#include <cstdio>
#include <cstdint>
namespace cg = cooperative_groups;
namespace pg8 {
#define PG8_LAS __attribute__((address_space(3)))
typedef unsigned short bf16_t;
typedef short bf16x8 __attribute__((ext_vector_type(8)));
typedef float f32x4 __attribute__((ext_vector_type(4)));
typedef unsigned u32x4 __attribute__((ext_vector_type(4)));
constexpr int BM = 256, BK = 64, HALF = 128, HTB = HALF * BK * 2  , STAGE_BYTES = 8 * HTB, NXCD = 8, WGM = 8;

__host__ __device__ __forceinline__ int lds_byte(int r, int c) { const int st = (r >> 4) * 2 + (c >> 5), rr = r & 15, cc = c & 31, ob = rr * 64 + cc * 2; return st * 1024 + (ob ^ (((ob >> 9) & 1) << 5)); }
__host__ __device__ __forceinline__ void stage_rc(int b, int& R, int& C) { const int st = b / 1024, sb = b % 1024, swz = sb ^ (((sb >> 9) & 1) << 5); R = (st >> 1) * 16 + swz / 64; C = (st & 1) * 32 + (swz % 64) / 2; }
__host__ __device__ __forceinline__ int perm32(int rho) { const int n = rho >> 4, i = rho & 15; return 8 * (i >> 2) + 4 * n + (i & 3); }

struct Unit { int pm, pn; };
struct Gemm { const bf16_t* A; const bf16_t* Bt; int M, N, K; };

struct StaticOrder {
    int nM, nN, nwg, G, c;
    __host__ __device__ void init(int M, int N, int G_, int c_) { nM = M / BM; nN = N / BM; nwg = nM * nN; G = G_; c = c_; }
    __host__ __device__ bool next(int i, Unit& u) const {
        const long L = (long)i * G + c; if (L >= nwg) return false;
        int wgid = (int)L; { const int q = nwg / NXCD, r = nwg % NXCD, xcd = wgid % NXCD, off = wgid / NXCD; wgid = (xcd < r ? xcd * (q + 1) : r * (q + 1) + (xcd - r) * q) + off; }
        const int nig = WGM * nN, gid = wgid / nig, fm = gid * WGM, gsz = (nM - fm) < WGM ? (nM - fm) : WGM;
        u.pm = fm + ((wgid % nig) % gsz); u.pn = (wgid % nig) / gsz; return true;
    }
    __device__ __forceinline__ void a_ready(const Unit&) const {}
    __device__ __forceinline__ void done(const Unit&) const {}
};

__device__ __forceinline__ unsigned cvt_pk_bf16(float lo, float hi) { unsigned r; asm("v_cvt_pk_bf16_f32 %0, %1, %2" : "=v"(r) : "v"(lo), "v"(hi)); return r; }
typedef float f32x2 __attribute__((ext_vector_type(2)));
__device__ __forceinline__ f32x2 gelu_pk(f32x2 v) {
    const f32x2 av = __builtin_elementwise_abs(v), d = av * 0.2316418882f + 1.0f;
    f32x2 t; t.x = __builtin_amdgcn_rcpf(d.x); t.y = __builtin_amdgcn_rcpf(d.y);
    f32x2 q = t * 0.5307027145f + (-0.7265760135f); q = q * t + 0.7107068705f; q = q * t + (-0.142248368f); q = q * t + 0.127414796f; q = q * t;
    const f32x2 s = (v * v) * (-0.72134752044f);
    f32x2 e; e.x = __builtin_amdgcn_exp2f(s.x); e.y = __builtin_amdgcn_exp2f(s.y);
    const f32x2 m = v * (q * e), r = v - m;
    f32x2 o; o.x = v.x < 0.f ? m.x : r.x; o.y = v.y < 0.f ? m.y : r.y; return o;
}

template <int ACT  > struct EpiBf16 {
    static constexpr bool PERM = true, AFTER_DRAIN = false; static_assert(ACT == 0 || ACT == 1, "EpiBf16: ACT is 0 (none) or 1 (gelu_pk)");
    bf16_t* O; int ldc; const float* bias; int split_cols; size_t split_stride; float scale0;
    __device__ __forceinline__ void operator()(const f32x4 (&acc)[2][2][4][2], const Unit& u, int wr, int wc, int fr, int fq) const {
        const int row0 = u.pm * BM + wr * 64 + fr; int colt = u.pn * BM; bf16_t* base = O;
        float sc = 1.f; if (split_cols) { const int t = colt / split_cols; base += (size_t)t * split_stride; colt -= t * split_cols; if (t == 0) sc = scale0; }
        const int col0 = colt + wc * 32 + 8 * fq, bcol0 = u.pn * BM + wc * 32 + 8 * fq;
        f32x4 bv[2][2];
#pragma unroll
        for (int bj = 0; bj < 2; ++bj)
#pragma unroll
            for (int n = 0; n < 2; ++n) bv[bj][n] = bias ? *(const f32x4*)(bias + bcol0 + bj * HALF + 4 * n) : (f32x4){0.f, 0.f, 0.f, 0.f};
#pragma unroll
        for (int ai = 0; ai < 2; ++ai)
#pragma unroll
            for (int m = 0; m < 4; ++m) { bf16_t* rowp = base + (size_t)(row0 + ai * HALF + m * 16) * ldc + col0;
#pragma unroll
                for (int bj = 0; bj < 2; ++bj) { f32x4 v0 = acc[ai][bj][m][0] + bv[bj][0], v1 = acc[ai][bj][m][1] + bv[bj][1];
                    if (ACT == 1) { f32x2 a = gelu_pk((f32x2){v0[0], v0[1]}), b = gelu_pk((f32x2){v0[2], v0[3]}), c = gelu_pk((f32x2){v1[0], v1[1]}), d = gelu_pk((f32x2){v1[2], v1[3]});
                        v0 = (f32x4){a.x, a.y, b.x, b.y}; v1 = (f32x4){c.x, c.y, d.x, d.y}; }
                    v0 = v0 * sc; v1 = v1 * sc; u32x4 w; w.x = cvt_pk_bf16(v0[0], v0[1]); w.y = cvt_pk_bf16(v0[2], v0[3]); w.z = cvt_pk_bf16(v1[0], v1[1]); w.w = cvt_pk_bf16(v1[2], v1[3]);
                    *(u32x4*)(rowp + bj * HALF) = w; } }
    }
};
template <class Epi, class Sched, bool ALIGN_EPI = false, bool SP2 = false>
__device__ __forceinline__ void gemm_phase(PG8_LAS unsigned char* lds, const Gemm g, const Sched& S, const Epi& E, int tid_in) {
    int tid_ = tid_in; asm volatile("" : "+v"(tid_));
    const int tid = tid_, wid = __builtin_amdgcn_readfirstlane(tid >> 6), lane = tid & 63, wr = wid >> 2, wc = wid & 3, fr = lane & 15, fq = lane >> 4;
    const int K = g.K, nt = K / BK;
    unsigned voffA[2], voffB[2];
#pragma unroll
    for (int i = 0; i < 2; ++i) { int R, C; stage_rc(tid * 16 + i * 8192, R, C); const int Rb = Epi::PERM ? ((R & ~31) + perm32(R & 31)) : R;
        voffA[i] = (unsigned)(R * K + C) * 2u; voffB[i] = (unsigned)(Rb * K + C) * 2u; }
    const size_t kstep = (size_t)(BK * 2);
    const size_t hstep = (size_t)HALF * K * 2;
    const size_t tstep = 2 * hstep;
    const unsigned ldsw = (unsigned)wid * 1024u;
    const int aoff = lds_byte(wr * 64 + fr, fq * 8), boff = lds_byte(wc * 32 + fr, fq * 8);
#define PG8_SA(b, h) (((b) * 2 + (h)) * HTB)
#define PG8_SB(b, h) ((4 + (b) * 2 + (h)) * HTB)
#define PG8_STAGE(bufoff, gbase, voff) do { _Pragma("unroll") for (int _i = 0; _i < 2; ++_i) \
        __builtin_amdgcn_global_load_lds((const unsigned*)((const char*)(gbase) + (voff)[_i]), (PG8_LAS unsigned*)(lds + (bufoff) + ldsw + _i * 8192), 16, 0, 0); } while (0)
#define PG8_LDA(dst, b, h) do { _Pragma("unroll") for (int m = 0; m < 4; ++m) _Pragma("unroll") for (int k = 0; k < 2; ++k) dst[m][k] = *(const PG8_LAS bf16x8*)(lds + PG8_SA(b, h) + aoff + m * 2048 + k * 1024); } while (0)
#define PG8_LDB(dst, b, h) do { _Pragma("unroll") for (int n = 0; n < 2; ++n) _Pragma("unroll") for (int k = 0; k < 2; ++k) dst[n][k] = *(const PG8_LAS bf16x8*)(lds + PG8_SB(b, h) + boff + n * 2048 + k * 1024); } while (0)
#define PG8_MMA(ai, bj, At, Bt) do { __builtin_amdgcn_s_setprio(1); _Pragma("unroll") for (int m = 0; m < 4; ++m) _Pragma("unroll") for (int n = 0; n < 2; ++n) _Pragma("unroll") for (int k = 0; k < 2; ++k) \
        acc[ai][bj][m][n] = __builtin_amdgcn_mfma_f32_16x16x32_bf16(Bt[n][k], At[m][k], acc[ai][bj][m][n], 0, 0, 0); __builtin_amdgcn_s_setprio(0); } while (0)
#define PG8_WAIT_V(n) asm volatile("s_waitcnt vmcnt(" #n ")" ::: "memory")
#define PG8_WAIT_L(n) asm volatile("s_waitcnt lgkmcnt(" #n ")" ::: "memory")
#define PG8_BAR __builtin_amdgcn_s_barrier()
#define PG8_SCHED __builtin_amdgcn_sched_barrier(0)
    Unit cur, nxt; int ui = 0;
    if (!S.next(0, cur)) return;
    f32x4 acc[2][2][4][2];
#pragma unroll
    for (int a = 0; a < 2; ++a)
#pragma unroll
        for (int b = 0; b < 2; ++b)
#pragma unroll
            for (int m = 0; m < 4; ++m)
#pragma unroll
                for (int n = 0; n < 2; ++n) acc[a][b][m][n] = (f32x4){0.f, 0.f, 0.f, 0.f};
    bf16x8 At[4][2], B0[2][2], B1[2][2];
    const char* cA = (const char*)g.A + (size_t)cur.pm * tstep; const char* cB = (const char*)g.Bt + (size_t)cur.pn * tstep;
    S.a_ready(cur);
    if constexpr (SP2) {
        PG8_STAGE(PG8_SB(0, 0), cB, voffB); PG8_STAGE(PG8_SB(0, 1), cB + hstep, voffB); PG8_STAGE(PG8_SA(0, 0), cA, voffA); PG8_STAGE(PG8_SA(0, 1), cA + hstep, voffA);
        if (wr == 1) PG8_BAR;
        PG8_WAIT_V(2); PG8_BAR;
        PG8_STAGE(PG8_SB(1, 0), cB + kstep, voffB); PG8_STAGE(PG8_SA(1, 0), cA + kstep, voffA); PG8_STAGE(PG8_SB(1, 1), cB + hstep + kstep, voffB);
        PG8_WAIT_V(6); PG8_BAR;
    } else {
        PG8_STAGE(PG8_SB(0, 0), cB, voffB); PG8_STAGE(PG8_SA(0, 0), cA, voffA); PG8_STAGE(PG8_SB(0, 1), cB + hstep, voffB); PG8_STAGE(PG8_SA(0, 1), cA + hstep, voffA);
        if (wr == 1) PG8_BAR;
        PG8_WAIT_V(4); PG8_BAR;
        PG8_STAGE(PG8_SB(1, 0), cB + kstep, voffB); PG8_STAGE(PG8_SA(1, 0), cA + kstep, voffA); PG8_STAGE(PG8_SB(1, 1), cB + hstep + kstep, voffB);
        PG8_WAIT_V(6); PG8_BAR;
    }
    for (;;) {
        const bool has_next = S.next(ui + 1, nxt);
        const char* nA = has_next ? (const char*)g.A + (size_t)nxt.pm * tstep : cA; const char* nB = has_next ? (const char*)g.Bt + (size_t)nxt.pn * tstep : cB;
        for (int t = 0; t < nt; t += 2) {
            const bool last = (t == nt - 2);
            const char* a1 = cA + (size_t)(t + 1) * kstep;
            const char* a2 = last ? nA : cA + (size_t)(t + 2) * kstep; const char* b2 = last ? nB : cB + (size_t)(t + 2) * kstep;
            const char* a3 = a2 + kstep; const char* b3 = b2 + kstep;
            if (last && has_next) S.a_ready(nxt);
            if constexpr (SP2) {
            PG8_LDB(B0, 0, 0); PG8_LDB(B1, 0, 1); PG8_SCHED; PG8_LDA(At, 0, 0); PG8_STAGE(PG8_SA(1, 1), a1 + hstep, voffA);
            PG8_WAIT_V(8); PG8_WAIT_L(0); PG8_BAR; PG8_MMA(0, 0, At, B0); PG8_MMA(0, 1, At, B1); PG8_BAR; PG8_SCHED;
            PG8_LDA(At, 0, 1); PG8_STAGE(PG8_SB(0, 0), b2, voffB); PG8_STAGE(PG8_SB(0, 1), b2 + hstep, voffB); PG8_STAGE(PG8_SA(0, 0), a2, voffA);
            PG8_WAIT_V(8); PG8_WAIT_L(0); PG8_BAR; PG8_MMA(1, 0, At, B0); PG8_MMA(1, 1, At, B1); PG8_BAR; PG8_SCHED;
            PG8_LDB(B0, 1, 0); PG8_LDB(B1, 1, 1); PG8_SCHED; PG8_LDA(At, 1, 0); PG8_STAGE(PG8_SA(0, 1), a2 + hstep, voffA);
            PG8_WAIT_V(8); PG8_WAIT_L(0); PG8_BAR; PG8_MMA(0, 0, At, B0); PG8_MMA(0, 1, At, B1); PG8_BAR; PG8_SCHED;
            PG8_LDA(At, 1, 1); PG8_STAGE(PG8_SB(1, 0), b3, voffB); PG8_STAGE(PG8_SB(1, 1), b3 + hstep, voffB); PG8_STAGE(PG8_SA(1, 0), a3, voffA);
            PG8_WAIT_V(8); PG8_WAIT_L(0); PG8_BAR; PG8_MMA(1, 0, At, B0); PG8_MMA(1, 1, At, B1); PG8_BAR; PG8_SCHED;
            } else {
            PG8_LDB(B0, 0, 0); PG8_SCHED; PG8_LDA(At, 0, 0); PG8_STAGE(PG8_SA(1, 1), a1 + hstep, voffA);
            PG8_WAIT_L(8); PG8_BAR; PG8_WAIT_L(0); PG8_MMA(0, 0, At, B0); PG8_BAR; PG8_SCHED;
            PG8_LDB(B1, 0, 1); PG8_STAGE(PG8_SB(0, 0), b2, voffB);
            PG8_BAR; PG8_WAIT_L(0); PG8_MMA(0, 1, At, B1); PG8_BAR;
            PG8_LDA(At, 0, 1); PG8_STAGE(PG8_SA(0, 0), a2, voffA);
            PG8_BAR; PG8_WAIT_L(0); PG8_MMA(1, 0, At, B0); PG8_BAR; PG8_SCHED;
            PG8_STAGE(PG8_SB(0, 1), b2 + hstep, voffB);
            PG8_WAIT_V(6); PG8_BAR; PG8_MMA(1, 1, At, B1); PG8_BAR;
            PG8_LDB(B0, 1, 0); PG8_SCHED; PG8_LDA(At, 1, 0); PG8_STAGE(PG8_SA(0, 1), a2 + hstep, voffA);
            PG8_WAIT_L(8); PG8_BAR; PG8_WAIT_L(0); PG8_MMA(0, 0, At, B0); PG8_BAR; PG8_SCHED;
            PG8_LDB(B1, 1, 1); PG8_STAGE(PG8_SB(1, 0), b3, voffB);
            PG8_BAR; PG8_WAIT_L(0); PG8_MMA(0, 1, At, B1); PG8_BAR;
            PG8_LDA(At, 1, 1); PG8_STAGE(PG8_SA(1, 0), a3, voffA);
            PG8_BAR; PG8_WAIT_L(0); PG8_MMA(1, 0, At, B0); PG8_BAR; PG8_SCHED;
            PG8_STAGE(PG8_SB(1, 1), b3 + hstep, voffB);
            PG8_WAIT_V(6); PG8_BAR; PG8_MMA(1, 1, At, B1); PG8_BAR;
            }
        }
        if constexpr (ALIGN_EPI) { if (wr == 0) PG8_BAR; }
        if constexpr (!Epi::AFTER_DRAIN) { E(acc, cur, wr, wc, fr, fq); S.done(cur); }
        if (!has_next) break;
#pragma unroll
        for (int a = 0; a < 2; ++a)
#pragma unroll
            for (int b = 0; b < 2; ++b)
#pragma unroll
                for (int m = 0; m < 4; ++m)
#pragma unroll
                    for (int n = 0; n < 2; ++n) acc[a][b][m][n] = (f32x4){0.f, 0.f, 0.f, 0.f};
        cur = nxt; cA = nA; cB = nB; ++ui;
        if constexpr (ALIGN_EPI) { if (wr == 1) PG8_BAR; }
    }
    PG8_WAIT_V(0);
    if constexpr (!ALIGN_EPI) { if (wr == 0) PG8_BAR; }
    PG8_BAR;
    if constexpr (Epi::AFTER_DRAIN) { E.fused(acc, cur, wr, wc, fr, fq, lds, wid, lane); S.done(cur); }
#undef PG8_SA
#undef PG8_SB
#undef PG8_STAGE
#undef PG8_LDA
#undef PG8_LDB
#undef PG8_MMA
#undef PG8_WAIT_V
#undef PG8_WAIT_L
#undef PG8_BAR
#undef PG8_SCHED
}
}
#define LAS __attribute__((address_space(3)))
typedef unsigned short bf16_t;
typedef short bf16x8 __attribute__((ext_vector_type(8)));
typedef float f32x4 __attribute__((ext_vector_type(4)));
typedef unsigned u32x4 __attribute__((ext_vector_type(4)));
typedef unsigned u32x2 __attribute__((ext_vector_type(2)));

constexpr int DM = 2048, NB = 4, SEQ = 2048, DEPTH = 4, DECB = 128, MP = NB * SEQ, MT = MP + DECB;
constexpr int NH = 8, HD = 128, DIN = 8208, DINP = 8224, NZ = 8192, MODLD = DEPTH * 3 * DM;
constexpr float EPS = 1e-6f;
constexpr size_t MiB = 1u << 20;
constexpr size_t WS_WIN = 0, WS_WOUT = 130 * MiB, WS_WADA = 162 * MiB, WS_CA = 258 * MiB, WS_MOD = 259 * MiB, WS_HB = 283 * MiB, WS_Z = 316 * MiB,
                 WS_ZS = 444 * MiB, WS_BA = 449 * MiB, WS_X = 450 * MiB, WS_YCAT = 515 * MiB, WS_TR = 548 * MiB, WS_GL = 652 * MiB, WS_CTL = 653 * MiB, WS_OB = 654 * MiB, WS_END = 686 * MiB;
constexpr size_t TR_W = 0, TR_Q = 16384, TR_A = 32768, TR_K = 40960, TR_G = 57344, TR_U = 73728, TR_SZ = 106496;
constexpr int LDS_BYTES = 147456;
constexpr size_t O_YP = 0, O_YS = O_YP + (size_t)MP * DM, O_CAP = O_YS + (size_t)DECB * DM, O_CQP = O_CAP + (size_t)DEPTH * NB * 2 * 1024,
                 O_SP = O_CQP + (size_t)DEPTH * NB * 3 * 3072, O_CAS = O_SP + (size_t)DEPTH * NB * NH * HD * HD, O_CQS = O_CAS + (size_t)DEPTH * DECB * 2 * 1024,
                 O_SS = O_CQS + (size_t)DEPTH * DECB * 3 * 3072, O_END = O_SS + (size_t)DEPTH * DECB * NH * HD * HD;

__device__ __forceinline__ float bflo(unsigned w) { return __uint_as_float(w << 16); }
__device__ __forceinline__ float bfhi(unsigned w) { return __uint_as_float(w & 0xffff0000u); }
__device__ __forceinline__ float bf2f(bf16_t h) { return __uint_as_float((unsigned)h << 16); }
__device__ __forceinline__ unsigned pk2(float lo, float hi) { return pg8::cvt_pk_bf16(lo, hi); }
__device__ __forceinline__ bf16_t f2bf(float f) { return (bf16_t)(pk2(f, 0.f) & 0xffffu); }
__device__ __forceinline__ float rcp_f(float x) { return __builtin_amdgcn_rcpf(x); }
__device__ __forceinline__ float rsq_f(float x) { return __builtin_amdgcn_rsqf(x); }
__device__ __forceinline__ float exp_f(float x) { return __builtin_amdgcn_exp2f(x * 1.4426950408889634f); }
__device__ __forceinline__ float silu_f(float x) { return x * rcp_f(1.f + exp_f(-x)); }
__device__ __forceinline__ float sigmoid_f(float x) { return rcp_f(1.f + exp_f(-x)); }
__device__ __forceinline__ float softplus_f(float x) { return fmaxf(x, 0.f) + __logf(1.f + exp_f(-fabsf(x))); }
__device__ __forceinline__ float wave_sum(float v) {
#pragma unroll
    for (int o = 1; o < 64; o <<= 1) v += __shfl_xor(v, o);
    return v;
}
__device__ __forceinline__ float wave_sum2(float v, int lane) {
    v += __builtin_bit_cast(float, __builtin_amdgcn_update_dpp(0, __builtin_bit_cast(int, v), 0xB1, 0xF, 0xF, true));
    v += __builtin_bit_cast(float, __builtin_amdgcn_update_dpp(0, __builtin_bit_cast(int, v), 0x4E, 0xF, 0xF, true));
    v += __builtin_bit_cast(float, __builtin_amdgcn_update_dpp(0, __builtin_bit_cast(int, v), 0x141, 0xF, 0xF, true));
    v += __builtin_bit_cast(float, __builtin_amdgcn_update_dpp(0, __builtin_bit_cast(int, v), 0x140, 0xF, 0xF, true));
    v += __builtin_bit_cast(float, __builtin_amdgcn_ds_bpermute((lane ^ 16) << 2, __builtin_bit_cast(int, v)));
    v += __builtin_bit_cast(float, __builtin_amdgcn_ds_bpermute((lane ^ 32) << 2, __builtin_bit_cast(int, v)));
    return v;
}
#define LDS_WAIT() asm volatile("s_waitcnt lgkmcnt(0)" ::: "memory")

struct EpiF32Bias {
    static constexpr bool PERM = false, AFTER_DRAIN = false;
    float* out; int ldc; const float* bias;
    __device__ __forceinline__ void operator()(const f32x4 (&acc)[2][2][4][2], const pg8::Unit& u, int wr, int wc, int fr, int fq) const {
        const int row0 = u.pm * 256 + wr * 64 + fr, col0 = u.pn * 256 + wc * 32 + 4 * fq;
#pragma unroll
        for (int ai = 0; ai < 2; ++ai)
#pragma unroll
            for (int m = 0; m < 4; ++m) { const size_t off = (size_t)(row0 + ai * 128 + m * 16) * ldc + col0;
#pragma unroll
                for (int bj = 0; bj < 2; ++bj)
#pragma unroll
                    for (int n = 0; n < 2; ++n) { const f32x4 bv = *(const f32x4*)(bias + col0 + bj * 128 + n * 16); *(f32x4*)(out + off + bj * 128 + n * 16) = acc[ai][bj][m][n] + bv; }
                asm volatile("" ::: "memory"); }
    }
};
struct EpiResGate {
    static constexpr bool PERM = false, AFTER_DRAIN = false;
    const float* base; float* out; const float* gate; int ldc;
    __device__ __forceinline__ void operator()(const f32x4 (&acc)[2][2][4][2], const pg8::Unit& u, int wr, int wc, int fr, int fq) const {
        const int row0 = u.pm * 256 + wr * 64 + fr, col0 = u.pn * 256 + wc * 32 + 4 * fq;
        const float* gp = gate + (size_t)((u.pm * 256) / SEQ) * MODLD + col0;
        f32x4 gv[2][2];
#pragma unroll
        for (int bj = 0; bj < 2; ++bj)
#pragma unroll
            for (int n = 0; n < 2; ++n) gv[bj][n] = *(const f32x4*)(gp + bj * 128 + n * 16);
#pragma unroll
        for (int ai = 0; ai < 2; ++ai)
#pragma unroll
            for (int m = 0; m < 4; ++m) { const size_t off = (size_t)(row0 + ai * 128 + m * 16) * ldc + col0;
#pragma unroll
                for (int bj = 0; bj < 2; ++bj)
#pragma unroll
                    for (int n = 0; n < 2; ++n) { const f32x4 b = *(const f32x4*)(base + off + bj * 128 + n * 16); *(f32x4*)(out + off + bj * 128 + n * 16) = b + gv[bj][n] * acc[ai][bj][m][n]; }
                asm volatile("" ::: "memory"); }
    }
};

__device__ __forceinline__ f32x4 skinny16(const bf16_t* A, int lda, const bf16_t* Bt, int ldb, int K, int lane) {
    const int r = lane & 15, q = lane >> 4;
    const bf16x8* ap = (const bf16x8*)(A + (size_t)r * lda + q * 8);
    const bf16x8* bp = (const bf16x8*)(Bt + (size_t)r * ldb + q * 8);
    f32x4 acc0 = {0.f, 0.f, 0.f, 0.f}, acc1 = {0.f, 0.f, 0.f, 0.f};
#pragma unroll 1
    for (int k = 0; k < K / 32; k += 16) {
        bf16x8 a[16], b[16];
#pragma unroll
        for (int i = 0; i < 16; ++i) { a[i] = ap[(k + i) * 4]; b[i] = bp[(k + i) * 4]; }
#pragma unroll
        for (int i = 0; i < 16; i += 2) { acc0 = __builtin_amdgcn_mfma_f32_16x16x32_bf16(a[i], b[i], acc0, 0, 0, 0); acc1 = __builtin_amdgcn_mfma_f32_16x16x32_bf16(a[i + 1], b[i + 1], acc1, 0, 0, 0); }
    }
    return acc0 + acc1;
}


__device__ __forceinline__ void sample_gemm32(LAS unsigned char* lds, const bf16_t* A, const bf16_t* Bt, float* out, int ldo, int n0, int tid, int lane, int wave) {
    constexpr int CK = 512, BS = CK + 8, BUFB = 32 * BS * 2, NC = DM / CK;
    const int r = lane & 15, q8 = lane >> 4;
    const bf16_t* ap = A + (size_t)(wave * 16 + r) * DM + q8 * 8;
    const bf16_t* bp = Bt + (size_t)(tid >> 6) * DM + (tid & 63) * 8;
    const unsigned bw = (unsigned)((tid >> 6) * BS + (tid & 63) * 8) * 2u;
    f32x4 acc[2] = {{0.f, 0.f, 0.f, 0.f}, {0.f, 0.f, 0.f, 0.f}};
    bf16x8 fa[16], fn[16]; u32x4 sb[4];
#define SG_LA(c, d) do { _Pragma("unroll") for (int ks = 0; ks < 16; ++ks) d[ks] = *(const bf16x8*)(ap + (c) * CK + ks * 32); } while (0)
#define SG_LB(c) do { _Pragma("unroll") for (int i = 0; i < 4; ++i) sb[i] = *(const u32x4*)(bp + (size_t)(8 * i) * DM + (c) * CK); } while (0)
#define SG_SB(bufp) do { _Pragma("unroll") for (int i = 0; i < 4; ++i) *(LAS u32x4*)((bufp) + bw + (unsigned)(8 * i * BS * 2)) = sb[i]; } while (0)
    SG_LB(0); SG_LA(0, fa);
    SG_SB(lds);
    SG_LB(1);
    __syncthreads();
#pragma unroll 1
    for (int c = 0; c < NC; ++c) {
        if (c + 1 < NC) SG_LA(c + 1, fn);
        const LAS bf16_t* Bl = (const LAS bf16_t*)(lds + (c & 1) * BUFB);
#pragma unroll
        for (int ks = 0; ks < 16; ++ks) {
            const bf16x8 b0 = *(const LAS bf16x8*)(Bl + r * BS + ks * 32 + q8 * 8), b1 = *(const LAS bf16x8*)(Bl + (16 + r) * BS + ks * 32 + q8 * 8);
            acc[0] = __builtin_amdgcn_mfma_f32_16x16x32_bf16(fa[ks], b0, acc[0], 0, 0, 0); acc[1] = __builtin_amdgcn_mfma_f32_16x16x32_bf16(fa[ks], b1, acc[1], 0, 0, 0); }
        if (c + 1 < NC) SG_SB(lds + ((c + 1) & 1) * BUFB);
        if (c + 2 < NC) SG_LB(c + 2);
#pragma unroll
        for (int ks = 0; ks < 16; ++ks) fa[ks] = fn[ks];
        __syncthreads();
    }
#undef SG_LA
#undef SG_LB
#undef SG_SB
#pragma unroll
    for (int nt = 0; nt < 2; ++nt)
#pragma unroll
        for (int j = 0; j < 4; ++j) out[(size_t)(wave * 16 + q8 * 4 + j) * ldo + n0 + nt * 16 + r] = acc[nt][j];
}

__device__ __forceinline__ void transpose_item(const float* W, int K, int N, bf16_t* WT, LAS float* scr, int item, int lane) {
    const int nblk = (N + 31) / 32, kb = item / nblk, nb = item % nblk, k0 = 64 * kb, n0 = 32 * nb;
    const int nn = n0 + (lane & 31); const bool ok = nn < N;
    float v[32];
#pragma unroll
    for (int i = 0; i < 32; ++i) { const int kk = 2 * i + (lane >> 5); v[i] = ok ? W[(size_t)(k0 + kk) * N + nn] : 0.f; }
#pragma unroll
    for (int i = 0; i < 32; ++i) { const int kk = 2 * i + (lane >> 5); scr[kk * 33 + (lane & 31)] = v[i]; }
    LDS_WAIT(); asm volatile("" ::: "memory");
    const int c = lane & 7;
#pragma unroll
    for (int j = 0; j < 4; ++j) { const int n = (lane >> 3) + 8 * j; const LAS float* s = scr + (8 * c) * 33 + n;
        u32x4 o; o.x = pk2(s[0 * 33], s[1 * 33]); o.y = pk2(s[2 * 33], s[3 * 33]); o.z = pk2(s[4 * 33], s[5 * 33]); o.w = pk2(s[6 * 33], s[7 * 33]);
        *(u32x4*)(WT + (size_t)(n0 + n) * K + k0 + 8 * c) = o; }
    LDS_WAIT(); asm volatile("" ::: "memory");
}

#define RLX_AGENT __ATOMIC_RELAXED, __HIP_MEMORY_SCOPE_AGENT
#define XB_TMO      128
#define XB_XCNT(j)  (256  + 64 * (j))
#define XB_XSUB(j)  (1280 + 64 * (j))
#define XB_XGEN(j)  (2304 + 64 * (j))
#define XB_TOP      3328
#define XB_TOPGEN   3392
#define XCD_BAR_WORDS 3456
#define XB_SPIN_CAP (1u << 17)

__device__ __forceinline__ unsigned xb_ld(unsigned* p)              { return __hip_atomic_load(p, __ATOMIC_RELAXED, __HIP_MEMORY_SCOPE_AGENT); }
__device__ __forceinline__ unsigned xb_add(unsigned* p, unsigned v) { return __hip_atomic_fetch_add(p, v, __ATOMIC_RELAXED, __HIP_MEMORY_SCOPE_AGENT); }
__device__ __forceinline__ unsigned xb_xcc_id() { return (unsigned)__builtin_amdgcn_s_getreg((3 << 11) | 20) & 0xFu; }
#define XB_SPIN(cond, bar) do { unsigned _sp = 0; while (cond) { __builtin_amdgcn_s_sleep(6); \
    if ((++_sp & 255u) == 0u) { if (xb_ld(&(bar)[XB_TMO])) break; if (_sp > XB_SPIN_CAP) { atomicAdd(&(bar)[XB_TMO], 1u); break; } } } } while (0)

struct XcdBarrier {
    unsigned* bar; unsigned x;
    volatile LAS unsigned* st;
};

__device__ __forceinline__ XcdBarrier xcd_barrier_post(unsigned* bar, volatile LAS unsigned* st) {
    XcdBarrier b; b.bar = bar; b.x = xb_xcc_id(); b.st = st;
    if (threadIdx.x == 0) (void)xb_add(&bar[XB_XCNT(b.x)], 1u);
    return b;
}
__device__ __forceinline__ void xcd_barrier_complete(unsigned* bar, unsigned x, unsigned& nloc, unsigned& nx) {
    const unsigned G = gridDim.x * gridDim.y * gridDim.z;
    unsigned sum, cnt, mine, sp = 0u;
    for (;;) {
        sum = 0u; cnt = 0u; mine = 0u;
#pragma unroll
        for (unsigned j = 0; j < 16; ++j) { const unsigned c = xb_ld(&bar[XB_XCNT(j)]); sum += c; cnt += (c > 0u) ? 1u : 0u; mine = (j == x) ? c : mine; }
        if (sum == G) break;
        __builtin_amdgcn_s_sleep(6);
        if ((++sp & 255u) == 0u) { if (xb_ld(&bar[XB_TMO])) break; if (sp > XB_SPIN_CAP) { atomicAdd(&bar[XB_TMO], 1u); break; } }
    }
    nloc = mine > 0u ? mine : 1u; nx = cnt > 0u ? cnt : 1u;
}

__device__ __forceinline__ void xcd_barrier(const XcdBarrier& b) {
    asm volatile("s_waitcnt vmcnt(0)" ::: "memory");
    __syncthreads();
    if (threadIdx.x == 0) {
        unsigned* bar = b.bar;
        __builtin_amdgcn_s_waitcnt(0);
        unsigned nloc = b.st[0], nx = b.st[1];
        if (nloc == 0u) { xcd_barrier_complete(bar, b.x, nloc, nx); b.st[0] = nloc; b.st[1] = nx; }
        const unsigned old = xb_add(&bar[XB_XSUB(b.x)], 1u);
        const unsigned gen = old / nloc;
        if (old + 1u == (gen + 1u) * nloc) {
            __builtin_amdgcn_fence(__ATOMIC_RELEASE, "agent");
            asm volatile("s_waitcnt vmcnt(0)" ::: "memory");
            const unsigned og = xb_add(&bar[XB_TOP], 1u);
            const unsigned tg = og / nx;
            if (og + 1u == (tg + 1u) * nx) xb_add(&bar[XB_TOPGEN], 1u);
            else XB_SPIN(xb_ld(&bar[XB_TOPGEN]) == tg, bar);
            __builtin_amdgcn_fence(__ATOMIC_ACQUIRE, "agent");
            xb_add(&bar[XB_XGEN(b.x)], 1u);
            asm volatile("s_waitcnt vmcnt(0)" ::: "memory");
        } else {
            XB_SPIN(xb_ld(&bar[XB_XGEN(b.x)]) == gen, bar);
            __builtin_amdgcn_fence(__ATOMIC_ACQUIRE, "agent");
            asm volatile("s_waitcnt vmcnt(0)" ::: "memory");
        }
    }
    __syncthreads();
}

__device__ __forceinline__ void phase_norm(const float* xp, const float* xs, const float* ng, const float* modl, bf16_t* hb, int gw, int NGW, int lane) {
    {
        const int row0 = gw * 4, mrow = row0 / SEQ;
        const float* sh = modl + (size_t)mrow * MODLD; const float* sc = sh + DM;
        f32x4 gg[8], ss0[8];
#pragma unroll
        for (int j = 0; j < 8; ++j) { const int c4 = lane + 64 * j; gg[j] = ((const f32x4*)ng)[c4] * (1.f + ((const f32x4*)sc)[c4]); ss0[j] = ((const f32x4*)sh)[c4]; }
#pragma unroll
        for (int k = 0; k < 4; ++k) {
            f32x4 v[8]; float ss = 0.f;
#pragma unroll
            for (int j = 0; j < 8; ++j) { v[j] = ((const f32x4*)(xp + (size_t)(row0 + k) * DM))[lane + 64 * j]; ss += (v[j].x * v[j].x + v[j].y * v[j].y) + (v[j].z * v[j].z + v[j].w * v[j].w); }
            const float rstd = rsq_f(wave_sum2(ss, lane) * (1.f / DM) + EPS);
#pragma unroll
            for (int j = 0; j < 8; ++j) { const int c4 = lane + 64 * j; const f32x4 h = v[j] * rstd * gg[j] + ss0[j]; u32x2 o; o.x = pk2(h.x, h.y); o.y = pk2(h.z, h.w); *(u32x2*)(hb + (size_t)(row0 + k) * DM + c4 * 4) = o; }
        }
    }
    for (int rs = gw; rs < DECB; rs += NGW) {
        const int row = MP + rs; const float* xr = xs + (size_t)rs * DM;
        const float* sh = modl + (size_t)(NB + rs) * MODLD; const float* sc = sh + DM;
        f32x4 v[8]; float ss = 0.f;
#pragma unroll
        for (int j = 0; j < 8; ++j) { v[j] = ((const f32x4*)xr)[lane + 64 * j]; ss += (v[j].x * v[j].x + v[j].y * v[j].y) + (v[j].z * v[j].z + v[j].w * v[j].w); }
        const float rstd = rsq_f(wave_sum2(ss, lane) * (1.f / DM) + EPS);
#pragma unroll
        for (int j = 0; j < 8; ++j) { const int c4 = lane + 64 * j; const f32x4 g = ((const f32x4*)ng)[c4], s1 = ((const f32x4*)sc)[c4], s0 = ((const f32x4*)sh)[c4];
            const f32x4 h = v[j] * rstd * g * (1.f + s1) + s0; u32x2 o; o.x = pk2(h.x, h.y); o.y = pk2(h.z, h.w); *(u32x2*)(hb + (size_t)row * DM + c4 * 4) = o; }
    }
}
__device__ __forceinline__ void final_row(const f32x4 (&v)[8], const f32x4 (&g)[8], float* orow, int lane) {
    float ss = 0.f;
#pragma unroll
    for (int j = 0; j < 8; ++j) ss += (v[j].x * v[j].x + v[j].y * v[j].y) + (v[j].z * v[j].z + v[j].w * v[j].w);
    const float rstd = rsq_f(wave_sum(ss) * (1.f / DM) + EPS);
#pragma unroll
    for (int j = 0; j < 8; ++j) ((f32x4*)orow)[lane + 64 * j] = v[j] * rstd * g[j];
}
__device__ __forceinline__ void phase_final(const float* x, const float* g, float* out, int gw, int NGW, int lane) {
    f32x4 gg[8];
#pragma unroll
    for (int j = 0; j < 8; ++j) gg[j] = ((const f32x4*)g)[lane + 64 * j];
    const int row0 = gw * 4;
    f32x4 v[8], w[8];
#pragma unroll
    for (int j = 0; j < 8; ++j) v[j] = ((const f32x4*)(x + (size_t)row0 * DM))[lane + 64 * j];
#pragma unroll
    for (int k = 0; k < 4; ++k) {
        if (k < 3) {
#pragma unroll
            for (int j = 0; j < 8; ++j) w[j] = ((const f32x4*)(x + (size_t)(row0 + k + 1) * DM))[lane + 64 * j];
        }
        final_row(v, gg, out + (size_t)(row0 + k) * DM, lane);
#pragma unroll
        for (int j = 0; j < 8; ++j) v[j] = w[j];
    }
    for (int row = MP + gw; row < MT; row += NGW) {
#pragma unroll
        for (int j = 0; j < 8; ++j) v[j] = ((const f32x4*)(x + (size_t)row * DM))[lane + 64 * j];
        final_row(v, gg, out + (size_t)row * DM, lane);
    }
}

template <int I, int C> __device__ __forceinline__ void s2_load(const LAS float* Ll, f32x4 (&lr)[16]) {
    if constexpr (4 * C < I) { lr[C] = *(const LAS f32x4*)(Ll + I * 64 + 4 * C); s2_load<I, C + 1>(Ll, lr); }
}
template <int I, int C> __device__ __forceinline__ void s2_fma(const f32x4 (&lr)[16], const float (&Xc)[64], float& a0, float& a1, float& a2, float& a3) {
    if constexpr (4 * C < I) {
        a0 += lr[C].x * Xc[4 * C];
        if constexpr (4 * C + 1 < I) a1 += lr[C].y * Xc[4 * C + 1];
        if constexpr (4 * C + 2 < I) a2 += lr[C].z * Xc[4 * C + 2];
        if constexpr (4 * C + 3 < I) a3 += lr[C].w * Xc[4 * C + 3];
        s2_fma<I, C + 1>(lr, Xc, a0, a1, a2, a3);
    }
}
template <int I> __device__ __forceinline__ void s2_row(const LAS float* Ll, float (&Xc)[64], int lane) {
    if constexpr (I < 64) {
        float a0 = Ll[I * 64 + lane], a1 = 0.f, a2 = 0.f, a3 = 0.f;
        f32x4 lr[16];
        s2_load<I, 0>(Ll, lr);
        s2_fma<I, 0>(lr, Xc, a0, a1, a2, a3);
        Xc[I] = -((a0 + a1) + (a2 + a3));
        asm volatile("" ::: "memory");
        s2_row<I + 1>(Ll, Xc, lane);
    }
}
struct PrepP { const bf16_t* z; const float* ba; const float* cw; const float* alog; const float* dtb; unsigned char* tr; float* gl; };
constexpr int PS = 136, TS = 72;
__device__ __forceinline__ void conv8(const u32x4 (&x)[4], const LAS float* w, float (&o)[8]) {
    f32x4 wa[4], wb[4];
#pragma unroll
    for (int j = 0; j < 4; ++j) { wa[j] = *(const LAS f32x4*)(w + j * 384); wb[j] = *(const LAS f32x4*)(w + j * 384 + 4); }
#pragma unroll
    for (int i = 0; i < 8; ++i) o[i] = 0.f;
#pragma unroll
    for (int j = 0; j < 4; ++j) {
        o[0] += wa[j].x * bflo(x[j].x); o[1] += wa[j].y * bfhi(x[j].x); o[2] += wa[j].z * bflo(x[j].y); o[3] += wa[j].w * bfhi(x[j].y);
        o[4] += wb[j].x * bflo(x[j].z); o[5] += wb[j].y * bfhi(x[j].z); o[6] += wb[j].z * bflo(x[j].w); o[7] += wb[j].w * bfhi(x[j].w); }
#pragma unroll
    for (int i = 0; i < 8; ++i) o[i] = silu_f(o[i]);
}
__device__ __forceinline__ u32x4 pack8(const float* v) { u32x4 o; o.x = pk2(v[0], v[1]); o.y = pk2(v[2], v[3]); o.z = pk2(v[4], v[5]); o.w = pk2(v[6], v[7]); return o; }
__device__ __forceinline__ void prep_weights(LAS unsigned char* lds, const float* cqw, int h, int tid) {
    LAS float* wl = (LAS float*)(lds + 114688);
#pragma unroll
    for (int i = 0; i < 3; ++i) { const int idx = tid + 512 * i, j = idx / 384, rem = idx - j * 384, m = rem >> 7, c = rem & 127; wl[idx] = cqw[j * 3072 + m * 1024 + h * 128 + c]; }
}
__device__ __forceinline__ void prep_task(LAS unsigned char* lds, const PrepP& P, int task, int tid, int lane, int wave) {
    asm volatile("" : "+v"(tid));
    lane = tid & 63;
    unsigned lb = 0; asm volatile("" : "+v"(lb)); lds += (lb & ~15u);
    const int h = task & 7, n = (task >> 3) & 31, b = task >> 8;
    const int row0 = b * SEQ + n * 64;
    unsigned char* trp = P.tr + (size_t)task * TR_SZ;
    LAS bf16_t* Kl = (LAS bf16_t*)lds; LAS bf16_t* Ql = Kl + 64 * PS; LAS bf16_t* Vl = Ql + 64 * PS; LAS bf16_t* KBl = Vl + 64 * PS; LAS bf16_t* KTl = KBl + 64 * PS;
    LAS float* Ll = (LAS float*)(lds + 5 * 64 * PS * 2);
    LAS bf16_t* Tl = (LAS bf16_t*)(lds + 5 * 64 * PS * 2 + 16384);
    LAS float* gcl = (LAS float*)(lds + 5 * 64 * PS * 2 + 16384 + 64 * TS * 2);
    const int r = lane & 15, q8 = lane >> 4;
    if (wave == 0) {
        const float* bar = P.ba + (size_t)(row0 + lane) * 16;
        float g = -exp_f(P.alog[h]) * softplus_f(bar[8 + h] + P.dtb[h]);
#pragma unroll
        for (int o = 1; o < 64; o <<= 1) { const float v = __shfl_up(g, o); if (lane >= o) g += v; }
        gcl[lane] = g; gcl[64 + lane] = sigmoid_f(bar[h]);
        if (lane == 63) P.gl[task] = exp_f(g);
    }
    __syncthreads();
    {
        const int t = tid >> 3, seg = tid & 7;
        const float beta = gcl[64 + t], gc = gcl[t], glc = gcl[63];
        const float eg = exp_f(gc), et = exp_f(glc - gc);
        const int tt = n * 64 + t;
        const bf16_t* zr = P.z + (size_t)(row0 + t) * NZ + 4096 + h * 128 + seg * 16;
        const LAS float* cw = (const LAS float*)(lds + 114688) + seg * 16;
        u32x4 xz[3][2][4];
#pragma unroll
        for (int m = 0; m < 3; ++m)
#pragma unroll
            for (int hf = 0; hf < 2; ++hf)
#pragma unroll
                for (int j = 0; j < 4; ++j) { const bool ok = tt - 3 + j >= 0; xz[m][hf][j] = *(const u32x4*)(zr + m * 1024 + hf * 8 + (ptrdiff_t)(ok ? j - 3 : 0) * NZ); if (!ok) xz[m][hf][j] = (u32x4){0u, 0u, 0u, 0u}; }
        const int lo = t * PS + seg * 16;
        float x[16], y[16];
        { float o[8]; conv8(xz[2][0], cw + 256, o);
#pragma unroll
          for (int i = 0; i < 8; ++i) x[i] = o[i] * beta;
          conv8(xz[2][1], cw + 256 + 8, o);
#pragma unroll
          for (int i = 0; i < 8; ++i) x[8 + i] = o[i] * beta; }
        *(LAS u32x4*)(Vl + lo) = pack8(x); *(LAS u32x4*)(Vl + lo + 8) = pack8(x + 8);
        asm volatile("" ::: "memory");
        { float o[8]; conv8(xz[1][0], cw + 128, o);
#pragma unroll
          for (int i = 0; i < 8; ++i) x[i] = o[i];
          conv8(xz[1][1], cw + 128 + 8, o);
#pragma unroll
          for (int i = 0; i < 8; ++i) x[8 + i] = o[i]; }
        { float sk = 0.f;
#pragma unroll
          for (int i = 0; i < 16; ++i) sk += x[i] * x[i];
          sk += __shfl_xor(sk, 1); sk += __shfl_xor(sk, 2); sk += __shfl_xor(sk, 4);
          const float rk = rsq_f(sk + EPS);
#pragma unroll
          for (int i = 0; i < 16; ++i) x[i] *= rk; }
        *(LAS u32x4*)(Kl + lo) = pack8(x); *(LAS u32x4*)(Kl + lo + 8) = pack8(x + 8);
#pragma unroll
        for (int i = 0; i < 16; ++i) y[i] = x[i] * (beta * eg);
        *(LAS u32x4*)(KBl + lo) = pack8(y); *(LAS u32x4*)(KBl + lo + 8) = pack8(y + 8);
#pragma unroll
        for (int i = 0; i < 16; ++i) y[i] = x[i] * et;
        *(LAS u32x4*)(KTl + lo) = pack8(y); *(LAS u32x4*)(KTl + lo + 8) = pack8(y + 8);
        asm volatile("" ::: "memory");
        { float o[8]; conv8(xz[0][0], cw, o);
#pragma unroll
          for (int i = 0; i < 8; ++i) x[i] = o[i];
          conv8(xz[0][1], cw + 8, o);
#pragma unroll
          for (int i = 0; i < 8; ++i) x[8 + i] = o[i]; }
        { float sq = 0.f;
#pragma unroll
          for (int i = 0; i < 16; ++i) sq += x[i] * x[i];
          sq += __shfl_xor(sq, 1); sq += __shfl_xor(sq, 2); sq += __shfl_xor(sq, 4);
          const float rq = rsq_f(sq + EPS) * 0.08838834764831845f;
#pragma unroll
          for (int i = 0; i < 16; ++i) x[i] *= rq; }
        *(LAS u32x4*)(Ql + lo) = pack8(x); *(LAS u32x4*)(Ql + lo + 8) = pack8(x + 8);
#pragma unroll
        for (int i = 0; i < 16; ++i) y[i] = x[i] * eg;
        bf16_t* qo = (bf16_t*)(trp + TR_Q) + t * 128 + seg * 16;
        *(u32x4*)qo = pack8(y); *(u32x4*)(qo + 8) = pack8(y + 8);
    }
    __syncthreads();
    {
        const int it = wave >> 1, jt0 = (wave & 1) * 2;
        bf16x8 aK[4], aQ[4];
#pragma unroll
        for (int ks = 0; ks < 4; ++ks) { aK[ks] = *(const LAS bf16x8*)(Kl + (it * 16 + r) * PS + ks * 32 + q8 * 8); aQ[ks] = *(const LAS bf16x8*)(Ql + (it * 16 + r) * PS + ks * 32 + q8 * 8); }
#pragma unroll
        for (int jj = 0; jj < 2; ++jj) {
            const int jt = jt0 + jj;
            bf16_t* ap = (bf16_t*)(trp + TR_A) + (it * 16 + r) * 64 + jt * 16 + q8 * 4;
            if (jt > it) { *(u32x2*)ap = (u32x2){lb, lb};
#pragma unroll
                for (int j = 0; j < 4; ++j) Ll[(it * 16 + q8 * 4 + j) * 64 + jt * 16 + r] = 0.f;
                continue; }
            f32x4 accL = {0.f, 0.f, 0.f, 0.f}, accA = {0.f, 0.f, 0.f, 0.f};
#pragma unroll
            for (int ks = 0; ks < 4; ++ks) { const bf16x8 bK = *(const LAS bf16x8*)(Kl + (jt * 16 + r) * PS + ks * 32 + q8 * 8);
                accL = __builtin_amdgcn_mfma_f32_16x16x32_bf16(aK[ks], bK, accL, 0, 0, 0);
                accA = __builtin_amdgcn_mfma_f32_16x16x32_bf16(bK, aQ[ks], accA, 0, 0, 0); }
            float av[4];
#pragma unroll
            for (int j = 0; j < 4; ++j) {
                { const int i = it * 16 + q8 * 4 + j, jx = jt * 16 + r; const float e = exp_f(gcl[i] - gcl[jx]) * gcl[64 + i] * accL[j]; Ll[i * 64 + jx] = (i > jx) ? e : 0.f; }
                { const int i = it * 16 + r, jx = jt * 16 + q8 * 4 + j; const float e = exp_f(gcl[i] - gcl[jx]) * accA[j]; av[j] = (i >= jx) ? e : 0.f; } }
            u32x2 o; o.x = pk2(av[0], av[1]); o.y = pk2(av[2], av[3]); *(u32x2*)ap = o;
        }
    }
    __syncthreads();
    if (wave == 0) {
        float Xc[64];
        s2_row<0>(Ll, Xc, lane);
#pragma unroll
        for (int i = 0; i < 64; ++i) Tl[i * TS + lane] = f2bf(Xc[i]);
        asm volatile("s_waitcnt lgkmcnt(0)" ::: "memory");
        Tl[lane * TS + lane] = (bf16_t)0x3F80u;
    }
    __syncthreads();
    {
        const int c0 = wave * 16;
        bf16x8 bv[2], bk[2];
#pragma unroll
        for (int ks = 0; ks < 2; ++ks)
#pragma unroll
            for (int j = 0; j < 8; ++j) { const int tok = ks * 32 + q8 * 8 + j; bv[ks][j] = (short)Vl[tok * PS + c0 + r]; bk[ks][j] = (short)KBl[tok * PS + c0 + r]; }
#pragma unroll
        for (int mt = 0; mt < 4; ++mt) {
            f32x4 aU = {0.f, 0.f, 0.f, 0.f}, aW = {0.f, 0.f, 0.f, 0.f};
#pragma unroll
            for (int ks = 0; ks < 2; ++ks) { if (ks == 1 && mt < 2) continue;
                const bf16x8 aT = *(const LAS bf16x8*)(Tl + (mt * 16 + r) * TS + ks * 32 + q8 * 8);
                aU = __builtin_amdgcn_mfma_f32_16x16x32_bf16(aT, bv[ks], aU, 0, 0, 0);
                aW = __builtin_amdgcn_mfma_f32_16x16x32_bf16(bk[ks], aT, aW, 0, 0, 0); }
            *(f32x4*)((float*)(trp + TR_U) + ((wave * 4 + mt) * 64 + lane) * 4) = aU;
            u32x2 o; o.x = pk2(-aW[0], -aW[1]); o.y = pk2(-aW[2], -aW[3]);
            *(u32x2*)((bf16_t*)(trp + TR_W) + (mt * 16 + r) * 128 + c0 + q8 * 4) = o;
        }
#pragma unroll
        for (int ii = 0; ii < 2; ++ii) { const int item = tid + 512 * ii, dk = item & 127, oct = item >> 7; float kv[8];
#pragma unroll
            for (int j = 0; j < 8; ++j) kv[j] = bf2f(KTl[(oct * 8 + j) * PS + dk]);
            *(u32x4*)((bf16_t*)(trp + TR_K) + dk * 64 + oct * 8) = pack8(kv); }
    }
    __syncthreads();
}
__device__ __forceinline__ void conva_prompt(const bf16_t* z, const float* caw, bf16_t* ycat, int gt, int GT) {
#pragma unroll 2
    for (int idx = gt; idx < MP * 128; idx += GT) {
        const int row = idx >> 7, c8 = (idx & 127) * 8, t = row & (SEQ - 1);
        const bf16_t* zr = z + (size_t)row * NZ + c8;
        float conv[8];
#pragma unroll
        for (int i = 0; i < 8; ++i) conv[i] = 0.f;
#pragma unroll
        for (int j = 0; j < 3; ++j) {
            const bool ok = t - 2 + j >= 0; const ptrdiff_t ro = (ptrdiff_t)(ok ? j - 2 : 0) * NZ;
            u32x4 c = *(const u32x4*)(zr + ro + 1024); const u32x4 hh = *(const u32x4*)(zr + ro + 2048);
            if (!ok) c = (u32x4){0u, 0u, 0u, 0u};
            const f32x4 w0 = *(const f32x4*)(caw + j * 1024 + c8), w1 = *(const f32x4*)(caw + j * 1024 + c8 + 4);
            conv[0] += w0.x * (bflo(c.x) * bflo(hh.x)); conv[1] += w0.y * (bfhi(c.x) * bfhi(hh.x)); conv[2] += w0.z * (bflo(c.y) * bflo(hh.y)); conv[3] += w0.w * (bfhi(c.y) * bfhi(hh.y));
            conv[4] += w1.x * (bflo(c.z) * bflo(hh.z)); conv[5] += w1.y * (bfhi(c.z) * bfhi(hh.z)); conv[6] += w1.z * (bflo(c.w) * bflo(hh.w)); conv[7] += w1.w * (bfhi(c.w) * bfhi(hh.w));
        }
        const u32x4 bb = *(const u32x4*)zr, gg = *(const u32x4*)(zr + 3072);
        float y[8];
        y[0] = bflo(bb.x) * conv[0] * silu_f(bflo(gg.x)); y[1] = bfhi(bb.x) * conv[1] * silu_f(bfhi(gg.x)); y[2] = bflo(bb.y) * conv[2] * silu_f(bflo(gg.y)); y[3] = bfhi(bb.y) * conv[3] * silu_f(bfhi(gg.y));
        y[4] = bflo(bb.z) * conv[4] * silu_f(bflo(gg.z)); y[5] = bfhi(bb.z) * conv[5] * silu_f(bfhi(gg.z)); y[6] = bflo(bb.w) * conv[6] * silu_f(bflo(gg.w)); y[7] = bfhi(bb.w) * conv[7] * silu_f(bfhi(gg.w));
        *(u32x4*)(ycat + (size_t)row * DM + c8) = pack8(y);
    }
}
__device__ __forceinline__ void conv_states_prompt(const bf16_t* z, float* oca, float* ocq, int gt, int GT) {
    for (int idx = gt; idx < NB * 2 * 1024; idx += GT) { const int c = idx & 1023, j = (idx >> 10) & 1, b = idx >> 11;
        const bf16_t* zr = z + (size_t)(b * SEQ + SEQ - 2 + j) * NZ; oca[idx] = bf2f(zr[1024 + c]) * bf2f(zr[2048 + c]); }
    for (int idx = gt; idx < NB * 3 * 3072; idx += GT) { const int c = (int)((unsigned)idx % 3072u), j = (int)((unsigned)idx / 3072u) % 3, b = (int)((unsigned)idx / 9216u);
        ocq[idx] = bf2f(z[(size_t)(b * SEQ + SEQ - 3 + j) * NZ + 4096 + c]); }
}

struct ScanP { const unsigned char* tr; const float* gl; float* obuf; float* sout; };
constexpr int SB_W = 0, SB_Q = 64 * PS * 2, SB_A = 2 * 64 * PS * 2, SB_K = SB_A + 64 * TS * 2, SB_SZ = SB_K + 128 * TS * 2;
static_assert(2 * SB_SZ <= 131072, "scan LDS");
__device__ __forceinline__ bf16x8 frag1(const LAS bf16_t* p) { return *(const LAS bf16x8*)p; }
__device__ __forceinline__ bf16x8 packB(const f32x4& a, const f32x4& b) { u32x4 v = {pk2(a[0], a[1]), pk2(a[2], a[3]), pk2(b[0], b[1]), pk2(b[2], b[3])}; return __builtin_bit_cast(bf16x8, v); }
__device__ __forceinline__ void scan_bh(LAS unsigned char* lds, const ScanP& P, int b, int h, int half, int tid, int lane, int wave) {
    const bool cw = wave < 4;
    const int r = lane & 15, q8 = lane >> 4, ct = half * 4 + (wave & 3), c0 = ct * 16;
    if (!cw) {
        const int lt = tid - 256, wrow = lt >> 4, wc16 = lt & 15, arow = lt >> 3, ac16 = lt & 7;
        const int wperm = (wc16 >> 2) * 32 + ((((wc16 & 3) * 8) & 15) >> 2) * 8 + (((wc16 & 3) * 8) >> 4) * 4, aperm = (ac16 >> 2) * 32 + ((((ac16 & 3) * 8) & 15) >> 2) * 8 + (((ac16 & 3) * 8) >> 4) * 4;
        const unsigned oW = (unsigned)TR_W + (unsigned)(wrow * 128 + wc16 * 8) * 2u, oQ = oW + (unsigned)(TR_Q - TR_W), oA = (unsigned)TR_A + (unsigned)(arow * 64 + ac16 * 8) * 2u, oK = oA + (unsigned)(TR_K - TR_A);
        const unsigned lW = (unsigned)(wrow * PS + wperm) * 2u, lA = (unsigned)(arow * TS + aperm) * 2u;
        u32x4 sa[14], sb[14];
#define L_LOAD(nn, d) do { const unsigned char* tr_ = P.tr + (size_t)((b << 8) | ((nn) << 3) | h) * TR_SZ; \
            _Pragma("unroll") for (int i = 0; i < 4; ++i) { d[i] = *(const u32x4*)(tr_ + (oW + 4096u * i)); d[4 + i] = *(const u32x4*)(tr_ + (oQ + 4096u * i)); d[10 + i] = *(const u32x4*)(tr_ + (oK + 4096u * i)); } \
            d[8] = *(const u32x4*)(tr_ + oA); d[9] = *(const u32x4*)(tr_ + (oA + 4096u)); } while (0)
#define ST2(base, boff, v) do { *(LAS u32x2*)((base) + (boff)) = (u32x2){(v).x, (v).y}; *(LAS u32x2*)((base) + (boff) + 16u) = (u32x2){(v).z, (v).w}; } while (0)
#define L_STORE(bufp, s_) do { LAS unsigned char* bp_ = (bufp); \
            _Pragma("unroll") for (int i = 0; i < 4; ++i) { ST2(bp_ + SB_W, lW + (unsigned)(16 * PS * 2 * i), s_[i]); ST2(bp_ + SB_Q, lW + (unsigned)(16 * PS * 2 * i), s_[4 + i]); ST2(bp_ + SB_K, lA + (unsigned)(32 * TS * 2 * i), s_[10 + i]); } \
            ST2(bp_ + SB_A, lA, s_[8]); ST2(bp_ + SB_A, lA + (unsigned)(32 * TS * 2), s_[9]); } while (0)
        L_LOAD(0, sa); L_STORE(lds, sa); L_LOAD(1, sa);
        __syncthreads();
#pragma unroll 1
        for (int n = 0; n < 32; ++n) {
            if (n + 2 < 32) L_LOAD(n + 2, sb);
            if (n + 1 < 32) L_STORE(lds + ((n + 1) & 1) * SB_SZ, sa);
            __syncthreads();
#pragma unroll
            for (int i = 0; i < 14; ++i) sa[i] = sb[i];
        }
#undef L_LOAD
#undef L_STORE
#undef ST2
    } else {
        f32x4 S[8];
#pragma unroll
        for (int i = 0; i < 8; ++i) S[i] = (f32x4){0.f, 0.f, 0.f, 0.f};
        const float glv = (lane < 32) ? P.gl[(b << 8) | (lane << 3) | h] : 0.f;
        f32x4 ubn[4];
        const unsigned oU = (unsigned)TR_U + (unsigned)(ct * 256 + lane) * 16u;
#define U_LOAD(nn) do { const unsigned char* tr_ = P.tr + (size_t)((b << 8) | ((nn) << 3) | h) * TR_SZ; \
            _Pragma("unroll") for (int mt_ = 0; mt_ < 4; ++mt_) ubn[mt_] = *(const f32x4*)(tr_ + (oU + (unsigned)mt_ * 1024u)); } while (0)
        U_LOAD(0);
        __syncthreads();
#pragma unroll 1
        for (int n = 0; n < 32; ++n) {
            LAS unsigned char* buf = lds + (n & 1) * SB_SZ;
            const LAS bf16_t* Wl = (const LAS bf16_t*)(buf + SB_W); const LAS bf16_t* Ql = (const LAS bf16_t*)(buf + SB_Q);
            const LAS bf16_t* Al = (const LAS bf16_t*)(buf + SB_A); const LAS bf16_t* Kl = (const LAS bf16_t*)(buf + SB_K);
            f32x4 u[4], o[4];
#pragma unroll
            for (int mt = 0; mt < 4; ++mt) { u[mt] = ubn[mt]; o[mt] = (f32x4){0.f, 0.f, 0.f, 0.f}; }
            if (n + 1 < 32) U_LOAD(n + 1);
        bf16x8 Sb[4];
#pragma unroll
        for (int ks = 0; ks < 4; ++ks) Sb[ks] = packB(S[2 * ks], S[2 * ks + 1]);
#define SBAR() __builtin_amdgcn_sched_barrier(0)
#define LD4(d, base, mt, stride) do { _Pragma("unroll") for (int ks = 0; ks < 4; ++ks) d[ks] = frag1((base) + ((mt) * 16 + r) * (stride) + ks * 32 + q8 * 8); } while (0)
#define MM4(acc, s_) do { _Pragma("unroll") for (int ks = 0; ks < 4; ++ks) acc = __builtin_amdgcn_mfma_f32_16x16x32_bf16(s_[ks], Sb[ks], acc, 0, 0, 0); } while (0)
        {
            bf16x8 fA[4], fB[4];
            LD4(fA, Wl, 0, PS); SBAR(); LD4(fB, Ql, 0, PS); SBAR();
            MM4(u[0], fA); SBAR(); LD4(fA, Wl, 1, PS); SBAR(); MM4(o[0], fB); SBAR(); LD4(fB, Ql, 1, PS); SBAR();
            MM4(u[1], fA); SBAR(); LD4(fA, Wl, 2, PS); SBAR(); MM4(o[1], fB); SBAR(); LD4(fB, Ql, 2, PS); SBAR();
            MM4(u[2], fA); SBAR(); LD4(fA, Wl, 3, PS); SBAR(); MM4(o[2], fB); SBAR(); LD4(fB, Ql, 3, PS); SBAR();
            MM4(u[3], fA); SBAR(); MM4(o[3], fB); SBAR();
        }
        bf16x8 Ub[2];
        Ub[0] = packB(u[0], u[1]); Ub[1] = packB(u[2], u[3]);
        const float gl = __shfl(glv, n);
#define LDK(d, dt0) do { d[0] = frag1(Kl + ((dt0) * 16 + r) * TS + q8 * 8); d[1] = frag1(Kl + ((dt0) * 16 + r) * TS + 32 + q8 * 8); d[2] = frag1(Kl + (((dt0) + 1) * 16 + r) * TS + q8 * 8); d[3] = frag1(Kl + (((dt0) + 1) * 16 + r) * TS + 32 + q8 * 8); } while (0)
#define MMK(s_, dt0) do { S[dt0] = S[dt0] * gl; S[(dt0) + 1] = S[(dt0) + 1] * gl; \
            S[dt0] = __builtin_amdgcn_mfma_f32_16x16x32_bf16(s_[0], Ub[0], S[dt0], 0, 0, 0); S[(dt0) + 1] = __builtin_amdgcn_mfma_f32_16x16x32_bf16(s_[2], Ub[0], S[(dt0) + 1], 0, 0, 0); \
            S[dt0] = __builtin_amdgcn_mfma_f32_16x16x32_bf16(s_[1], Ub[1], S[dt0], 0, 0, 0); S[(dt0) + 1] = __builtin_amdgcn_mfma_f32_16x16x32_bf16(s_[3], Ub[1], S[(dt0) + 1], 0, 0, 0); } while (0)
        {
            bf16x8 aA[6], kA[4], kB[4];
            aA[0] = frag1(Al + (0 * 16 + r) * TS + q8 * 8); aA[1] = frag1(Al + (1 * 16 + r) * TS + q8 * 8);
            aA[2] = frag1(Al + (2 * 16 + r) * TS + q8 * 8); aA[3] = frag1(Al + (2 * 16 + r) * TS + 32 + q8 * 8);
            aA[4] = frag1(Al + (3 * 16 + r) * TS + q8 * 8); aA[5] = frag1(Al + (3 * 16 + r) * TS + 32 + q8 * 8);
            SBAR(); LDK(kA, 0); SBAR();
            o[0] = __builtin_amdgcn_mfma_f32_16x16x32_bf16(aA[0], Ub[0], o[0], 0, 0, 0); o[1] = __builtin_amdgcn_mfma_f32_16x16x32_bf16(aA[1], Ub[0], o[1], 0, 0, 0);
            o[2] = __builtin_amdgcn_mfma_f32_16x16x32_bf16(aA[2], Ub[0], o[2], 0, 0, 0); o[3] = __builtin_amdgcn_mfma_f32_16x16x32_bf16(aA[4], Ub[0], o[3], 0, 0, 0);
            o[2] = __builtin_amdgcn_mfma_f32_16x16x32_bf16(aA[3], Ub[1], o[2], 0, 0, 0); o[3] = __builtin_amdgcn_mfma_f32_16x16x32_bf16(aA[5], Ub[1], o[3], 0, 0, 0);
            SBAR(); LDK(kB, 2); SBAR(); MMK(kA, 0); SBAR(); LDK(kA, 4); SBAR(); MMK(kB, 2); SBAR(); LDK(kB, 6); SBAR(); MMK(kA, 4); SBAR(); MMK(kB, 6); SBAR();
        }
#undef LD4
#undef MM4
#undef LDK
#undef MMK
#undef SBAR
        { unsigned oO = (unsigned)((q8 * 4) * 1024 + c0 + r) * 4u; asm volatile("" : "+v"(oO));
          unsigned char* ob = (unsigned char*)(P.obuf + (size_t)(b * SEQ + n * 64) * 1024 + h * 128);
#pragma unroll
          for (int mt = 0; mt < 4; ++mt)
#pragma unroll
              for (int j = 0; j < 4; ++j) *(float*)(ob + (oO + (unsigned)(mt * 16 + j) * 4096u)) = o[mt][j]; }
            __syncthreads();
        }
#undef U_LOAD
#pragma unroll
        for (int dt = 0; dt < 8; ++dt)
#pragma unroll
            for (int j = 0; j < 4; ++j) P.sout[(size_t)(dt * 16 + q8 * 4 + j) * HD + c0 + r] = S[dt][j];
    }
    __syncthreads();
}
__device__ __forceinline__ void onorm_pass(const float* obuf, const bf16_t* z, const float* ong, bf16_t* ycat, int gw, int NGW, int lane) {
    const int cl = (lane & 7) * 16;
    f32x4 g[4];
#pragma unroll
    for (int i = 0; i < 4; ++i) g[i] = *(const f32x4*)(ong + cl + 4 * i);
#pragma unroll 2
    for (int row = gw; row < MP; row += NGW) {
        const float* op = obuf + (size_t)row * 1024 + lane * 16; const bf16_t* zp = z + (size_t)row * NZ + 7168 + lane * 16;
        f32x4 v[4]; float ss = 0.f;
#pragma unroll
        for (int i = 0; i < 4; ++i) { v[i] = *(const f32x4*)(op + 4 * i); ss += (v[i].x * v[i].x + v[i].y * v[i].y) + (v[i].z * v[i].z + v[i].w * v[i].w); }
        const u32x4 g0 = *(const u32x4*)zp, g1 = *(const u32x4*)(zp + 8);
        ss += __builtin_bit_cast(float, __builtin_amdgcn_update_dpp(0, __builtin_bit_cast(int, ss), 0xB1, 0xF, 0xF, true));
        ss += __builtin_bit_cast(float, __builtin_amdgcn_update_dpp(0, __builtin_bit_cast(int, ss), 0x4E, 0xF, 0xF, true));
        ss += __builtin_bit_cast(float, __builtin_amdgcn_update_dpp(0, __builtin_bit_cast(int, ss), 0x141, 0xF, 0xF, true));
        const float rstd = rsq_f(ss * (1.f / HD) + EPS);
        float y[16];
        y[0] = v[0].x * rstd * g[0].x * silu_f(bflo(g0.x)); y[1] = v[0].y * rstd * g[0].y * silu_f(bfhi(g0.x)); y[2] = v[0].z * rstd * g[0].z * silu_f(bflo(g0.y)); y[3] = v[0].w * rstd * g[0].w * silu_f(bfhi(g0.y));
        y[4] = v[1].x * rstd * g[1].x * silu_f(bflo(g0.z)); y[5] = v[1].y * rstd * g[1].y * silu_f(bfhi(g0.z)); y[6] = v[1].z * rstd * g[1].z * silu_f(bflo(g0.w)); y[7] = v[1].w * rstd * g[1].w * silu_f(bfhi(g0.w));
        y[8] = v[2].x * rstd * g[2].x * silu_f(bflo(g1.x)); y[9] = v[2].y * rstd * g[2].y * silu_f(bfhi(g1.x)); y[10] = v[2].z * rstd * g[2].z * silu_f(bflo(g1.y)); y[11] = v[2].w * rstd * g[2].w * silu_f(bfhi(g1.y));
        y[12] = v[3].x * rstd * g[3].x * silu_f(bflo(g1.z)); y[13] = v[3].y * rstd * g[3].y * silu_f(bfhi(g1.z)); y[14] = v[3].z * rstd * g[3].z * silu_f(bflo(g1.w)); y[15] = v[3].w * rstd * g[3].w * silu_f(bfhi(g1.w));
        bf16_t* yp = ycat + (size_t)row * DM + 1024 + lane * 16;
        *(u32x4*)yp = pack8(y); *(u32x4*)(yp + 8) = pack8(y + 8);
    }
}
struct SampP { const float* zs; const float* sca; const float* scq; const float* s0; const float* caw; const float* cqw; const float* alog; const float* dtb; const float* ong;
               bf16_t* ycat; float* oca; float* ocq; float* oss; };
__device__ __forceinline__ void sample_task(LAS unsigned char* lds, const SampP& P, int task, int tid, int lane, int wave) {
    const int h = task & 7, bs = task >> 3;
    LAS float* qv = (LAS float*)lds; LAS float* kv = qv + 128; LAS float* vv = kv + 128; LAS float* part = vv + 128; LAS float* pks = part + 16; LAS float* pqs = pks + 1024;
    const float* s0 = P.s0 + (size_t)(bs * 8 + h) * 16384; float* so = P.oss + (size_t)(bs * 8 + h) * 16384;
    const int half = lane >> 5, c4 = (lane & 31) * 4;
    f32x4 sr[8];
#pragma unroll
    for (int i = 0; i < 8; ++i) sr[i] = *(const f32x4*)(s0 + (size_t)(wave * 16 + 2 * i + half) * 128 + c4);
    const float* zr = P.zs + (size_t)bs * DINP;
    const float zbeta = zr[8192 + h], zalpha = zr[8200 + h], alg = P.alog[h], dtbv = P.dtb[h];
    f32x4 ongv = {0.f, 0.f, 0.f, 0.f}, gbv = {0.f, 0.f, 0.f, 0.f};
    if (wave == 0 && lane < 32) { ongv = *(const f32x4*)(P.ong + c4); gbv = *(const f32x4*)(zr + 7168 + h * 128 + c4); }
    float qkv[3] = {0.f, 0.f, 0.f};
    if (tid < 128) {
        const int cc = h * 128 + tid;
        { const float ch = zr[1024 + cc] * zr[2048 + cc]; const float s0a = P.sca[(bs * 2 + 0) * 1024 + cc], s1a = P.sca[(bs * 2 + 1) * 1024 + cc];
          const float conv = P.caw[cc] * s0a + P.caw[1024 + cc] * s1a + P.caw[2048 + cc] * ch;
          P.ycat[(size_t)(MP + bs) * DM + cc] = f2bf(zr[cc] * conv * silu_f(zr[3072 + cc]));
          P.oca[(bs * 2 + 0) * 1024 + cc] = s1a; P.oca[(bs * 2 + 1) * 1024 + cc] = ch; }
#pragma unroll
        for (int m = 0; m < 3; ++m) { const int c3 = m * 1024 + cc; const float pre = zr[4096 + c3];
            const float a0 = P.scq[(bs * 3 + 0) * 3072 + c3], a1 = P.scq[(bs * 3 + 1) * 3072 + c3], a2 = P.scq[(bs * 3 + 2) * 3072 + c3];
            qkv[m] = silu_f(P.cqw[c3] * a0 + P.cqw[3072 + c3] * a1 + P.cqw[2 * 3072 + c3] * a2 + P.cqw[3 * 3072 + c3] * pre);
            P.ocq[(bs * 3 + 0) * 3072 + c3] = a1; P.ocq[(bs * 3 + 1) * 3072 + c3] = a2; P.ocq[(bs * 3 + 2) * 3072 + c3] = pre; }
        const float sq = wave_sum(qkv[0] * qkv[0]), sk = wave_sum(qkv[1] * qkv[1]);
        if (lane == 0) { part[wave * 2] = sq; part[wave * 2 + 1] = sk; }
    }
    __syncthreads();
    if (tid < 128) { const float sq = part[0] + part[2], sk = part[1] + part[3];
        qv[tid] = qkv[0] * rsq_f(sq + EPS) * 0.08838834764831845f; kv[tid] = qkv[1] * rsq_f(sk + EPS); vv[tid] = qkv[2]; }
    __syncthreads();
    f32x4 pk = {0.f, 0.f, 0.f, 0.f}, pq = {0.f, 0.f, 0.f, 0.f};
#pragma unroll
    for (int i = 0; i < 8; ++i) { const int row = wave * 16 + 2 * i + half; pk += kv[row] * sr[i]; pq += qv[row] * sr[i]; }
#pragma unroll
    for (int e = 0; e < 4; ++e) { pk[e] += __shfl_xor(pk[e], 32); pq[e] += __shfl_xor(pq[e], 32); }
    if (lane < 32) { *(LAS f32x4*)(pks + wave * 128 + c4) = pk; *(LAS f32x4*)(pqs + wave * 128 + c4) = pq; }
    const float qk = wave_sum(qv[lane] * kv[lane] + qv[lane + 64] * kv[lane + 64]);
    __syncthreads();
    f32x4 ks = {0.f, 0.f, 0.f, 0.f}, qs = {0.f, 0.f, 0.f, 0.f};
#pragma unroll
    for (int w = 0; w < 8; ++w) { ks += *(const LAS f32x4*)(pks + w * 128 + c4); qs += *(const LAS f32x4*)(pqs + w * 128 + c4); }
    const float beta = sigmoid_f(zbeta);
    const float eg = exp_f(-exp_f(alg) * softplus_f(zalpha + dtbv));
    const f32x4 v4 = *(const LAS f32x4*)(vv + c4);
    const f32x4 u = beta * (v4 - eg * ks);
    const f32x4 o = eg * qs + qk * u;
#pragma unroll
    for (int i = 0; i < 8; ++i) { const int row = wave * 16 + 2 * i + half; *(f32x4*)(so + (size_t)row * 128 + c4) = eg * sr[i] + kv[row] * u; }
    if (wave == 0) {
        float ss = (lane < 32) ? (o.x * o.x + o.y * o.y) + (o.z * o.z + o.w * o.w) : 0.f;
        const float rstd = rsq_f(wave_sum(ss) * (1.f / HD) + EPS);
        if (lane < 32) { const f32x4 g = ongv, gb = gbv;
            u32x2 w; w.x = pk2(o.x * rstd * g.x * silu_f(gb.x), o.y * rstd * g.y * silu_f(gb.y)); w.y = pk2(o.z * rstd * g.z * silu_f(gb.z), o.w * rstd * g.w * silu_f(gb.w));
            *(u32x2*)(P.ycat + (size_t)(MP + bs) * DM + 1024 + h * 128 + c4) = w; }
    }
    __syncthreads();
}

struct Args { const float* in[18]; float* out; unsigned char* ws; };
#define GAS __attribute__((address_space(1)))
struct ArgsG { const GAS float* in[18]; GAS float* out; GAS unsigned char* ws; };
__global__ void __launch_bounds__(512, 2) mega(Args a) {
    extern __shared__ __attribute__((aligned(16))) unsigned char lds_raw[];
    cg::grid_group grid = cg::this_grid();
    LAS unsigned char* lds = (LAS unsigned char*)lds_raw;
    constexpr int G = 256, NGW = G * 8, GT = G * 512;
    const int bx0 = blockIdx.x, wave0 = __builtin_amdgcn_readfirstlane(threadIdx.x >> 6);
    const ArgsG* ap0 = (const ArgsG*)__builtin_amdgcn_kernarg_segment_ptr();
#define FRESH() unsigned m_ = ~0u; asm volatile("" : "+s"(m_)); int tid = (wave0 << 6) | (int)__builtin_amdgcn_mbcnt_hi(m_, __builtin_amdgcn_mbcnt_lo(m_, 0u)); asm volatile("" : "+v"(tid)); FRESH_S(); const int lane = tid & 63, wave = __builtin_amdgcn_readfirstlane(tid >> 6), gw = bx * 8 + wave, gt = bx * 512 + tid; (void)lane; (void)gw; (void)gt
#define FRESH_S() int bx = bx0; const ArgsG* ap = ap0; asm volatile("" : "+s"(bx), "+s"(ap)); unsigned char* ws = (unsigned char*)ap->ws
#define GBAR() do { FRESH_S(); XcdBarrier xb_; xb_.bar = (unsigned*)(ws + WS_CTL); xb_.x = xb_xcc_id(); xb_.st = (volatile LAS unsigned*)(lds + 131072 + 32); xcd_barrier(xb_); } while (0)
#define WSP(T, off) ((T*)(ws + (off)))
    { volatile LAS unsigned* misc = (volatile LAS unsigned*)(lds + 131072); if (threadIdx.x < 32) misc[threadIdx.x] = 0u; __syncthreads();
      (void)xcd_barrier_post((unsigned*)((unsigned char*)ap0->ws + WS_CTL), misc + 8); }
    constexpr int I_IN = 32 * 257, I_OUT = 32 * 64, I_ADA = 32 * 192;
    {
        FRESH();
        LAS float* scr = (LAS float*)(lds + wave * 16384);
#pragma unroll 1
        for (int it = gw; it < 4 * I_ADA; it += NGW) { const int l = it / I_ADA, r = it - l * I_ADA;
            transpose_item(((const float*)ap->in[8]) + (size_t)l * DM * 3 * DM, DM, 3 * DM, WSP(bf16_t, WS_WADA) + (size_t)l * 3 * DM * DM, scr, r, lane); }
        const float* c_prompt = ((const float*)ap->in[5]); const float* c_sample = ((const float*)ap->in[6]); bf16_t* ca = WSP(bf16_t, WS_CA);
        for (int idx = gt; idx < (NB + DECB) * DM; idx += GT) { const int row = idx >> 11, c = idx & 2047;
            const float v = row < NB ? c_prompt[row * DM + c] : c_sample[(row - NB) * DM + c]; ca[idx] = f2bf(silu_f(v)); }
    }
    if (ap0->out == nullptr) grid.sync();
    GBAR();
    {
        FRESH();
        constexpr int NGEMM = MODLD / 256, NIT2 = 4 * (I_IN + I_OUT), N1 = 35000;
        if (bx < NGEMM) {
            pg8::Gemm g{WSP(bf16_t, WS_CA), WSP(bf16_t, WS_WADA), 256, MODLD, DM}; pg8::StaticOrder S; S.init(256, MODLD, G, bx);
            EpiF32Bias E{WSP(float, WS_MOD), MODLD, ((const float*)ap->in[9])};
            pg8::gemm_phase<EpiF32Bias, pg8::StaticOrder, true, true>(lds, g, S, E, tid);
        }
        LAS float* scr = (LAS float*)(lds + wave * 16384);
        const int it0 = bx < NGEMM ? N1 + bx * 8 + wave : (bx - NGEMM) * 8 + wave, itN = bx < NGEMM ? NIT2 : N1, its = bx < NGEMM ? NGEMM * 8 : (G - NGEMM) * 8;
#pragma unroll 1
        for (int it = it0; it < itN; it += its) {
            int r = it;
            if (r < 4 * I_IN) { const int l = r / I_IN; r -= l * I_IN; transpose_item(((const float*)ap->in[10]) + (size_t)l * DM * DIN, DM, DIN, WSP(bf16_t, WS_WIN) + (size_t)l * DINP * DM, scr, r, lane); }
            else { r -= 4 * I_IN; const int l = r / I_OUT; r -= l * I_OUT; transpose_item(((const float*)ap->in[16]) + (size_t)l * DM * DM, DM, DM, WSP(bf16_t, WS_WOUT) + (size_t)l * DM * DM, scr, r, lane); }
        }
    }
    GBAR();
#pragma unroll 1
    for (int l = 0; l < DEPTH; ++l) {
        {
            FRESH();
            float* xcur = WSP(float, WS_X);
            phase_norm(l == 0 ? ((const float*)ap->in[0]) : xcur, l == 0 ? ((const float*)ap->in[1]) : xcur + (size_t)MP * DM, ((const float*)ap->in[7]) + l * DM, WSP(float, WS_MOD) + (size_t)l * 3 * DM, WSP(bf16_t, WS_HB), gw, NGW, lane);
        }
        GBAR();
        {
            FRESH();
            const bf16_t* Wi = WSP(bf16_t, WS_WIN) + (size_t)l * DINP * DM; const bf16_t* hb = WSP(bf16_t, WS_HB);
            {
                pg8::Gemm g{hb, Wi, MP, NZ, DM}; pg8::StaticOrder S; S.init(MP, NZ, G, bx);
                pg8::EpiBf16<0> E{WSP(bf16_t, WS_Z), NZ, nullptr, 0, 0, 1.f};
                pg8::gemm_phase<pg8::EpiBf16<0>, pg8::StaticOrder, true, true>(lds, g, S, E, tid);
            }
            float* zs = WSP(float, WS_ZS); float* ba = WSP(float, WS_BA);
            const int r = lane & 15, q8 = lane >> 4;
#pragma unroll 1
            for (int task = bx; task < NZ / 32; task += G) sample_gemm32(lds, hb + (size_t)MP * DM, Wi + (size_t)task * 32 * DM, zs, DINP, task * 32, tid, lane, wave);
            for (int task = wave * G + bx; task < 8 + MP / 16; task += NGW) {
                if (task < 8) { const int mt = task;
                    const f32x4 acc = skinny16(hb + (size_t)(MP + mt * 16) * DM, DM, Wi + (size_t)NZ * DM, DM, DM, lane);
#pragma unroll
                    for (int j = 0; j < 4; ++j) zs[(size_t)(mt * 16 + q8 * 4 + j) * DINP + NZ + r] = acc[j];
                } else { const int pt = task - 8;
                    const f32x4 acc = skinny16(hb + (size_t)pt * 16 * DM, DM, Wi + (size_t)NZ * DM, DM, DM, lane);
#pragma unroll
                    for (int j = 0; j < 4; ++j) ba[(size_t)(pt * 16 + q8 * 4 + j) * 16 + r] = acc[j];
                }
            }
        }
        GBAR();
        {
            FRESH();
            const bf16_t* z = WSP(bf16_t, WS_Z);
            PrepP P{z, WSP(float, WS_BA), ((const float*)ap->in[12]) + (size_t)l * 4 * 3072, ((const float*)ap->in[13]) + l * NH, ((const float*)ap->in[14]) + l * NH, WSP(unsigned char, WS_TR), WSP(float, WS_GL)};
            prep_weights(lds, P.cw, bx & 7, tid);
#pragma unroll 1
            for (int task = bx; task < NB * 32 * NH; task += G) prep_task(lds, P, task, tid, lane, wave);
        }
        GBAR();
        if (bx0 < 2 * NB * NH) {
            FRESH();
            const int b = bx >> 4, h = (bx >> 1) & 7, half = bx & 1;
            ScanP P{WSP(unsigned char, WS_TR), WSP(float, WS_GL), WSP(float, WS_OB), ((float*)ap->out) + O_SP + ((size_t)(l * NB + b) * NH + h) * HD * HD};
            scan_bh(lds, P, b, h, half, tid, lane, wave);
        } else {
            FRESH();
            SampP P{WSP(float, WS_ZS), ((const float*)ap->in[2]) + (size_t)l * DECB * 2 * 1024, ((const float*)ap->in[3]) + (size_t)l * DECB * 3 * 3072, ((const float*)ap->in[4]) + (size_t)l * DECB * NH * HD * HD, ((const float*)ap->in[11]) + (size_t)l * 3 * 1024,
                    ((const float*)ap->in[12]) + (size_t)l * 4 * 3072, ((const float*)ap->in[13]) + l * NH, ((const float*)ap->in[14]) + l * NH, ((const float*)ap->in[15]) + l * HD, WSP(bf16_t, WS_YCAT), ((float*)ap->out) + O_CAS + (size_t)l * DECB * 2 * 1024,
                    ((float*)ap->out) + O_CQS + (size_t)l * DECB * 3 * 3072, ((float*)ap->out) + O_SS + (size_t)l * DECB * NH * HD * HD};
#pragma unroll 1
            for (int task = bx - 2 * NB * NH; task < DECB * NH; task += G - 2 * NB * NH) sample_task(lds, P, task, tid, lane, wave);
            { constexpr int GT2 = (G - 2 * NB * NH) * 512; const int gt2 = (bx - 2 * NB * NH) * 512 + tid; const bf16_t* z = WSP(bf16_t, WS_Z);
              conva_prompt(z, ((const float*)ap->in[11]) + (size_t)l * 3 * 1024, WSP(bf16_t, WS_YCAT), gt2, GT2);
              conv_states_prompt(z, ((float*)ap->out) + O_CAP + (size_t)l * NB * 2 * 1024, ((float*)ap->out) + O_CQP + (size_t)l * NB * 3 * 3072, gt2, GT2); }
        }
        GBAR();
        {
            FRESH();
            if (wave >= 4) onorm_pass(WSP(float, WS_OB), WSP(bf16_t, WS_Z), ((const float*)ap->in[15]) + l * HD, WSP(bf16_t, WS_YCAT), bx * 4 + (wave - 4), G * 4, lane);
            else {
                const bf16_t* Wo = WSP(bf16_t, WS_WOUT) + (size_t)l * DM * DM; const bf16_t* ycat = WSP(bf16_t, WS_YCAT); float* xcur = WSP(float, WS_X);
                const float* modg = WSP(float, WS_MOD) + (size_t)l * 3 * DM + 2 * DM;
                const int r = lane & 15, q8 = lane >> 4;
                const float* xb = l == 0 ? ((const float*)ap->in[1]) : xcur + (size_t)MP * DM;
                const int task = wave * G + bx, mt = task & 7, nt = task >> 3;
                const f32x4 acc = skinny16(ycat + (size_t)(MP + mt * 16) * DM, DM, Wo + (size_t)nt * 16 * DM, DM, DM, lane);
#pragma unroll
                for (int j = 0; j < 4; ++j) { const int row = mt * 16 + q8 * 4 + j, col = nt * 16 + r;
                    xcur[(size_t)(MP + row) * DM + col] = xb[(size_t)row * DM + col] + modg[(size_t)(NB + row) * MODLD + col] * acc[j]; }
            }
        }
        GBAR();
        {
            FRESH();
            const bf16_t* Wo = WSP(bf16_t, WS_WOUT) + (size_t)l * DM * DM; const bf16_t* ycat = WSP(bf16_t, WS_YCAT); float* xcur = WSP(float, WS_X);
            const float* modg = WSP(float, WS_MOD) + (size_t)l * 3 * DM + 2 * DM;
            {
                pg8::Gemm g{ycat, Wo, MP, DM, DM}; pg8::StaticOrder S; S.init(MP, DM, G, bx);
                EpiResGate E{l == 0 ? ((const float*)ap->in[0]) : xcur, xcur, modg, DM};
                pg8::gemm_phase<EpiResGate, pg8::StaticOrder, true, true>(lds, g, S, E, tid);
            }
        }
        GBAR();
    }
    { FRESH(); phase_final(WSP(float, WS_X), ((const float*)ap->in[17]), ((float*)ap->out), gw, NGW, lane); }
#undef FRESH
#undef GBAR
#undef WSP
}

extern "C" void kernel_launch(void* const* d_in, const int* in_sizes, int n_in, void* d_out, int out_size, void* d_ws, size_t ws_size, hipStream_t stream) {
    static int grid = 0;
    if (!grid) {
        if (n_in != 18 || (size_t)out_size != O_END || ws_size < WS_END) { fprintf(stderr, "kernel_launch: unexpected shapes (n_in %d out %d ws %zu)\n", n_in, out_size, ws_size); grid = -1; return; }
        int dev = 0, cus = 0, per_cu = 0;
        (void)hipGetDevice(&dev);
        (void)hipDeviceGetAttribute(&cus, hipDeviceAttributeMultiprocessorCount, dev);
        (void)hipFuncSetAttribute((const void*)mega, hipFuncAttributeMaxDynamicSharedMemorySize, LDS_BYTES);
        (void)hipOccupancyMaxActiveBlocksPerMultiprocessor(&per_cu, (const void*)mega, 512, LDS_BYTES);
        if (per_cu < 1) per_cu = 1;
        grid = cus * per_cu;
        if (grid != 256) { fprintf(stderr, "kernel_launch: this kernel is built for a 256-workgroup grid (256 CUs x 1), got %d\n", grid); grid = -1; return; }
        fprintf(stderr, "kernel_launch: grid %d (cus %d per_cu %d)\n", grid, cus, per_cu);
    }
    if (grid < 0) return;
    if (hipMemsetAsync((char*)d_ws + WS_CTL, 0, 16384, stream) != hipSuccess) { fprintf(stderr, "kernel_launch: memset of the barrier words failed\n"); return; }
    Args a{};
    for (int i = 0; i < 18; ++i) a.in[i] = (const float*)d_in[i];
    a.out = (float*)d_out; a.ws = (unsigned char*)d_ws;
    void* args[] = {&a};
    hipError_t e = hipLaunchCooperativeKernel((void*)mega, dim3(grid), dim3(512), args, LDS_BYTES, stream);
    if (e != hipSuccess) fprintf(stderr, "cooperative launch failed: %s (grid %d)\n", hipGetErrorString(e), grid);
}
```

```cpp
#include <hip/hip_runtime.h>
#include <hip/hip_cooperative_groups.h>
#include <cstdio>
#include <cstdint>
namespace cg = cooperative_groups;
namespace pg8 {
#define PG8_LAS __attribute__((address_space(3)))
typedef unsigned short bf16_t;
typedef short bf16x8 __attribute__((ext_vector_type(8)));
typedef float f32x4 __attribute__((ext_vector_type(4)));
typedef unsigned u32x4 __attribute__((ext_vector_type(4)));
constexpr int BM = 256, BK = 64, HALF = 128, HTB = HALF * BK * 2  , STAGE_BYTES = 8 * HTB, NXCD = 8, WGM = 8;

__host__ __device__ __forceinline__ int lds_byte(int r, int c) { const int st = (r >> 4) * 2 + (c >> 5), rr = r & 15, cc = c & 31, ob = rr * 64 + cc * 2; return st * 1024 + (ob ^ (((ob >> 9) & 1) << 5)); }
__host__ __device__ __forceinline__ void stage_rc(int b, int& R, int& C) { const int st = b / 1024, sb = b % 1024, swz = sb ^ (((sb >> 9) & 1) << 5); R = (st >> 1) * 16 + swz / 64; C = (st & 1) * 32 + (swz % 64) / 2; }
__host__ __device__ __forceinline__ int perm32(int rho) { const int n = rho >> 4, i = rho & 15; return 8 * (i >> 2) + 4 * n + (i & 3); }

struct Unit { int pm, pn; };
struct Gemm { const bf16_t* A; const bf16_t* Bt; int M, N, K; };

struct StaticOrder {
    int nM, nN, nwg, G, c;
    __host__ __device__ void init(int M, int N, int G_, int c_) { nM = M / BM; nN = N / BM; nwg = nM * nN; G = G_; c = c_; }
    __host__ __device__ bool next(int i, Unit& u) const {
        const long L = (long)i * G + c; if (L >= nwg) return false;
        int wgid = (int)L; { const int q = nwg / NXCD, r = nwg % NXCD, xcd = wgid % NXCD, off = wgid / NXCD; wgid = (xcd < r ? xcd * (q + 1) : r * (q + 1) + (xcd - r) * q) + off; }
        const int nig = WGM * nN, gid = wgid / nig, fm = gid * WGM, gsz = (nM - fm) < WGM ? (nM - fm) : WGM;
        u.pm = fm + ((wgid % nig) % gsz); u.pn = (wgid % nig) / gsz; return true;
    }
    __device__ __forceinline__ void a_ready(const Unit&) const {}
    __device__ __forceinline__ void done(const Unit&) const {}
};

__device__ __forceinline__ unsigned cvt_pk_bf16(float lo, float hi) { unsigned r; asm("v_cvt_pk_bf16_f32 %0, %1, %2" : "=v"(r) : "v"(lo), "v"(hi)); return r; }
typedef float f32x2 __attribute__((ext_vector_type(2)));
__device__ __forceinline__ f32x2 gelu_pk(f32x2 v) {
    const f32x2 av = __builtin_elementwise_abs(v), d = av * 0.2316418882f + 1.0f;
    f32x2 t; t.x = __builtin_amdgcn_rcpf(d.x); t.y = __builtin_amdgcn_rcpf(d.y);
    f32x2 q = t * 0.5307027145f + (-0.7265760135f); q = q * t + 0.7107068705f; q = q * t + (-0.142248368f); q = q * t + 0.127414796f; q = q * t;
    const f32x2 s = (v * v) * (-0.72134752044f);
    f32x2 e; e.x = __builtin_amdgcn_exp2f(s.x); e.y = __builtin_amdgcn_exp2f(s.y);
    const f32x2 m = v * (q * e), r = v - m;
    f32x2 o; o.x = v.x < 0.f ? m.x : r.x; o.y = v.y < 0.f ? m.y : r.y; return o;
}

template <int ACT  > struct EpiBf16 {
    static constexpr bool PERM = true, AFTER_DRAIN = false; static_assert(ACT == 0 || ACT == 1, "EpiBf16: ACT is 0 (none) or 1 (gelu_pk)");
    bf16_t* O; int ldc; const float* bias; int split_cols; size_t split_stride; float scale0;
    __device__ __forceinline__ void operator()(const f32x4 (&acc)[2][2][4][2], const Unit& u, int wr, int wc, int fr, int fq) const {
        const int row0 = u.pm * BM + wr * 64 + fr; int colt = u.pn * BM; bf16_t* base = O;
        float sc = 1.f; if (split_cols) { const int t = colt / split_cols; base += (size_t)t * split_stride; colt -= t * split_cols; if (t == 0) sc = scale0; }
        const int col0 = colt + wc * 32 + 8 * fq, bcol0 = u.pn * BM + wc * 32 + 8 * fq;
        f32x4 bv[2][2];
#pragma unroll
        for (int bj = 0; bj < 2; ++bj)
#pragma unroll
            for (int n = 0; n < 2; ++n) bv[bj][n] = bias ? *(const f32x4*)(bias + bcol0 + bj * HALF + 4 * n) : (f32x4){0.f, 0.f, 0.f, 0.f};
#pragma unroll
        for (int ai = 0; ai < 2; ++ai)
#pragma unroll
            for (int m = 0; m < 4; ++m) { bf16_t* rowp = base + (size_t)(row0 + ai * HALF + m * 16) * ldc + col0;
#pragma unroll
                for (int bj = 0; bj < 2; ++bj) { f32x4 v0 = acc[ai][bj][m][0] + bv[bj][0], v1 = acc[ai][bj][m][1] + bv[bj][1];
                    if (ACT == 1) { f32x2 a = gelu_pk((f32x2){v0[0], v0[1]}), b = gelu_pk((f32x2){v0[2], v0[3]}), c = gelu_pk((f32x2){v1[0], v1[1]}), d = gelu_pk((f32x2){v1[2], v1[3]});
                        v0 = (f32x4){a.x, a.y, b.x, b.y}; v1 = (f32x4){c.x, c.y, d.x, d.y}; }
                    v0 = v0 * sc; v1 = v1 * sc; u32x4 w; w.x = cvt_pk_bf16(v0[0], v0[1]); w.y = cvt_pk_bf16(v0[2], v0[3]); w.z = cvt_pk_bf16(v1[0], v1[1]); w.w = cvt_pk_bf16(v1[2], v1[3]);
                    *(u32x4*)(rowp + bj * HALF) = w; } }
    }
};
template <class Epi, class Sched, bool ALIGN_EPI = false, bool SP2 = false>
__device__ __forceinline__ void gemm_phase(PG8_LAS unsigned char* lds, const Gemm g, const Sched& S, const Epi& E, int tid_in) {
    int tid_ = tid_in; asm volatile("" : "+v"(tid_));
    const int tid = tid_, wid = __builtin_amdgcn_readfirstlane(tid >> 6), lane = tid & 63, wr = wid >> 2, wc = wid & 3, fr = lane & 15, fq = lane >> 4;
    const int K = g.K, nt = K / BK;
    unsigned voffA[2], voffB[2];
#pragma unroll
    for (int i = 0; i < 2; ++i) { int R, C; stage_rc(tid * 16 + i * 8192, R, C); const int Rb = Epi::PERM ? ((R & ~31) + perm32(R & 31)) : R;
        voffA[i] = (unsigned)(R * K + C) * 2u; voffB[i] = (unsigned)(Rb * K + C) * 2u; }
    const size_t kstep = (size_t)(BK * 2);
    const size_t hstep = (size_t)HALF * K * 2;
    const size_t tstep = 2 * hstep;
    const unsigned ldsw = (unsigned)wid * 1024u;
    const int aoff = lds_byte(wr * 64 + fr, fq * 8), boff = lds_byte(wc * 32 + fr, fq * 8);
#define PG8_SA(b, h) (((b) * 2 + (h)) * HTB)
#define PG8_SB(b, h) ((4 + (b) * 2 + (h)) * HTB)
#define PG8_STAGE(bufoff, gbase, voff) do { _Pragma("unroll") for (int _i = 0; _i < 2; ++_i) \
        __builtin_amdgcn_global_load_lds((const unsigned*)((const char*)(gbase) + (voff)[_i]), (PG8_LAS unsigned*)(lds + (bufoff) + ldsw + _i * 8192), 16, 0, 0); } while (0)
#define PG8_LDA(dst, b, h) do { _Pragma("unroll") for (int m = 0; m < 4; ++m) _Pragma("unroll") for (int k = 0; k < 2; ++k) dst[m][k] = *(const PG8_LAS bf16x8*)(lds + PG8_SA(b, h) + aoff + m * 2048 + k * 1024); } while (0)
#define PG8_LDB(dst, b, h) do { _Pragma("unroll") for (int n = 0; n < 2; ++n) _Pragma("unroll") for (int k = 0; k < 2; ++k) dst[n][k] = *(const PG8_LAS bf16x8*)(lds + PG8_SB(b, h) + boff + n * 2048 + k * 1024); } while (0)
#define PG8_MMA(ai, bj, At, Bt) do { __builtin_amdgcn_s_setprio(1); _Pragma("unroll") for (int m = 0; m < 4; ++m) _Pragma("unroll") for (int n = 0; n < 2; ++n) _Pragma("unroll") for (int k = 0; k < 2; ++k) \
        acc[ai][bj][m][n] = __builtin_amdgcn_mfma_f32_16x16x32_bf16(Bt[n][k], At[m][k], acc[ai][bj][m][n], 0, 0, 0); __builtin_amdgcn_s_setprio(0); } while (0)
#define PG8_WAIT_V(n) asm volatile("s_waitcnt vmcnt(" #n ")" ::: "memory")
#define PG8_WAIT_L(n) asm volatile("s_waitcnt lgkmcnt(" #n ")" ::: "memory")
#define PG8_BAR __builtin_amdgcn_s_barrier()
#define PG8_SCHED __builtin_amdgcn_sched_barrier(0)
    Unit cur, nxt; int ui = 0;
    if (!S.next(0, cur)) return;
    f32x4 acc[2][2][4][2];
#pragma unroll
    for (int a = 0; a < 2; ++a)
#pragma unroll
        for (int b = 0; b < 2; ++b)
#pragma unroll
            for (int m = 0; m < 4; ++m)
#pragma unroll
                for (int n = 0; n < 2; ++n) acc[a][b][m][n] = (f32x4){0.f, 0.f, 0.f, 0.f};
    bf16x8 At[4][2], B0[2][2], B1[2][2];
    const char* cA = (const char*)g.A + (size_t)cur.pm * tstep; const char* cB = (const char*)g.Bt + (size_t)cur.pn * tstep;
    S.a_ready(cur);
    if constexpr (SP2) {
        PG8_STAGE(PG8_SB(0, 0), cB, voffB); PG8_STAGE(PG8_SB(0, 1), cB + hstep, voffB); PG8_STAGE(PG8_SA(0, 0), cA, voffA); PG8_STAGE(PG8_SA(0, 1), cA + hstep, voffA);
        if (wr == 1) PG8_BAR;
        PG8_WAIT_V(2); PG8_BAR;
        PG8_STAGE(PG8_SB(1, 0), cB + kstep, voffB); PG8_STAGE(PG8_SA(1, 0), cA + kstep, voffA); PG8_STAGE(PG8_SB(1, 1), cB + hstep + kstep, voffB);
        PG8_WAIT_V(6); PG8_BAR;
    } else {
        PG8_STAGE(PG8_SB(0, 0), cB, voffB); PG8_STAGE(PG8_SA(0, 0), cA, voffA); PG8_STAGE(PG8_SB(0, 1), cB + hstep, voffB); PG8_STAGE(PG8_SA(0, 1), cA + hstep, voffA);
        if (wr == 1) PG8_BAR;
        PG8_WAIT_V(4); PG8_BAR;
        PG8_STAGE(PG8_SB(1, 0), cB + kstep, voffB); PG8_STAGE(PG8_SA(1, 0), cA + kstep, voffA); PG8_STAGE(PG8_SB(1, 1), cB + hstep + kstep, voffB);
        PG8_WAIT_V(6); PG8_BAR;
    }
    for (;;) {
        const bool has_next = S.next(ui + 1, nxt);
        const char* nA = has_next ? (const char*)g.A + (size_t)nxt.pm * tstep : cA; const char* nB = has_next ? (const char*)g.Bt + (size_t)nxt.pn * tstep : cB;
        for (int t = 0; t < nt; t += 2) {
            const bool last = (t == nt - 2);
            const char* a1 = cA + (size_t)(t + 1) * kstep;
            const char* a2 = last ? nA : cA + (size_t)(t + 2) * kstep; const char* b2 = last ? nB : cB + (size_t)(t + 2) * kstep;
            const char* a3 = a2 + kstep; const char* b3 = b2 + kstep;
            if (last && has_next) S.a_ready(nxt);
            if constexpr (SP2) {
            PG8_LDB(B0, 0, 0); PG8_LDB(B1, 0, 1); PG8_SCHED; PG8_LDA(At, 0, 0); PG8_STAGE(PG8_SA(1, 1), a1 + hstep, voffA);
            PG8_WAIT_V(8); PG8_WAIT_L(0); PG8_BAR; PG8_MMA(0, 0, At, B0); PG8_MMA(0, 1, At, B1); PG8_BAR; PG8_SCHED;
            PG8_LDA(At, 0, 1); PG8_STAGE(PG8_SB(0, 0), b2, voffB); PG8_STAGE(PG8_SB(0, 1), b2 + hstep, voffB); PG8_STAGE(PG8_SA(0, 0), a2, voffA);
            PG8_WAIT_V(8); PG8_WAIT_L(0); PG8_BAR; PG8_MMA(1, 0, At, B0); PG8_MMA(1, 1, At, B1); PG8_BAR; PG8_SCHED;
            PG8_LDB(B0, 1, 0); PG8_LDB(B1, 1, 1); PG8_SCHED; PG8_LDA(At, 1, 0); PG8_STAGE(PG8_SA(0, 1), a2 + hstep, voffA);
            PG8_WAIT_V(8); PG8_WAIT_L(0); PG8_BAR; PG8_MMA(0, 0, At, B0); PG8_MMA(0, 1, At, B1); PG8_BAR; PG8_SCHED;
            PG8_LDA(At, 1, 1); PG8_STAGE(PG8_SB(1, 0), b3, voffB); PG8_STAGE(PG8_SB(1, 1), b3 + hstep, voffB); PG8_STAGE(PG8_SA(1, 0), a3, voffA);
            PG8_WAIT_V(8); PG8_WAIT_L(0); PG8_BAR; PG8_MMA(1, 0, At, B0); PG8_MMA(1, 1, At, B1); PG8_BAR; PG8_SCHED;
            } else {
            PG8_LDB(B0, 0, 0); PG8_SCHED; PG8_LDA(At, 0, 0); PG8_STAGE(PG8_SA(1, 1), a1 + hstep, voffA);
            PG8_WAIT_L(8); PG8_BAR; PG8_WAIT_L(0); PG8_MMA(0, 0, At, B0); PG8_BAR; PG8_SCHED;
            PG8_LDB(B1, 0, 1); PG8_STAGE(PG8_SB(0, 0), b2, voffB);
            PG8_BAR; PG8_WAIT_L(0); PG8_MMA(0, 1, At, B1); PG8_BAR;
            PG8_LDA(At, 0, 1); PG8_STAGE(PG8_SA(0, 0), a2, voffA);
            PG8_BAR; PG8_WAIT_L(0); PG8_MMA(1, 0, At, B0); PG8_BAR; PG8_SCHED;
            PG8_STAGE(PG8_SB(0, 1), b2 + hstep, voffB);
            PG8_WAIT_V(6); PG8_BAR; PG8_MMA(1, 1, At, B1); PG8_BAR;
            PG8_LDB(B0, 1, 0); PG8_SCHED; PG8_LDA(At, 1, 0); PG8_STAGE(PG8_SA(0, 1), a2 + hstep, voffA);
            PG8_WAIT_L(8); PG8_BAR; PG8_WAIT_L(0); PG8_MMA(0, 0, At, B0); PG8_BAR; PG8_SCHED;
            PG8_LDB(B1, 1, 1); PG8_STAGE(PG8_SB(1, 0), b3, voffB);
            PG8_BAR; PG8_WAIT_L(0); PG8_MMA(0, 1, At, B1); PG8_BAR;
            PG8_LDA(At, 1, 1); PG8_STAGE(PG8_SA(1, 0), a3, voffA);
            PG8_BAR; PG8_WAIT_L(0); PG8_MMA(1, 0, At, B0); PG8_BAR; PG8_SCHED;
            PG8_STAGE(PG8_SB(1, 1), b3 + hstep, voffB);
            PG8_WAIT_V(6); PG8_BAR; PG8_MMA(1, 1, At, B1); PG8_BAR;
            }
        }
        if constexpr (ALIGN_EPI) { if (wr == 0) PG8_BAR; }
        if constexpr (!Epi::AFTER_DRAIN) { E(acc, cur, wr, wc, fr, fq); S.done(cur); }
        if (!has_next) break;
#pragma unroll
        for (int a = 0; a < 2; ++a)
#pragma unroll
            for (int b = 0; b < 2; ++b)
#pragma unroll
                for (int m = 0; m < 4; ++m)
#pragma unroll
                    for (int n = 0; n < 2; ++n) acc[a][b][m][n] = (f32x4){0.f, 0.f, 0.f, 0.f};
        cur = nxt; cA = nA; cB = nB; ++ui;
        if constexpr (ALIGN_EPI) { if (wr == 1) PG8_BAR; }
    }
    PG8_WAIT_V(0);
    if constexpr (!ALIGN_EPI) { if (wr == 0) PG8_BAR; }
    PG8_BAR;
    if constexpr (Epi::AFTER_DRAIN) { E.fused(acc, cur, wr, wc, fr, fq, lds, wid, lane); S.done(cur); }
#undef PG8_SA
#undef PG8_SB
#undef PG8_STAGE
#undef PG8_LDA
#undef PG8_LDB
#undef PG8_MMA
#undef PG8_WAIT_V
#undef PG8_WAIT_L
#undef PG8_BAR
#undef PG8_SCHED
}
}
#define LAS __attribute__((address_space(3)))
typedef unsigned short bf16_t;
typedef short bf16x8 __attribute__((ext_vector_type(8)));
typedef float f32x4 __attribute__((ext_vector_type(4)));
typedef unsigned u32x4 __attribute__((ext_vector_type(4)));
typedef unsigned u32x2 __attribute__((ext_vector_type(2)));

constexpr int DM = 2048, NB = 4, SEQ = 2048, DEPTH = 4, DECB = 128, MP = NB * SEQ, MT = MP + DECB;
constexpr int NH = 8, HD = 128, DIN = 8208, DINP = 8224, NZ = 8192, MODLD = DEPTH * 3 * DM;
constexpr float EPS = 1e-6f;
constexpr size_t MiB = 1u << 20;
constexpr size_t WS_WIN = 0, WS_WOUT = 130 * MiB, WS_WADA = 162 * MiB, WS_CA = 258 * MiB, WS_MOD = 259 * MiB, WS_HB = 283 * MiB, WS_Z = 316 * MiB,
                 WS_ZS = 444 * MiB, WS_BA = 449 * MiB, WS_X = 450 * MiB, WS_YCAT = 515 * MiB, WS_TR = 548 * MiB, WS_GL = 652 * MiB, WS_CTL = 653 * MiB, WS_OB = 654 * MiB, WS_END = 686 * MiB;
constexpr size_t TR_W = 0, TR_Q = 16384, TR_A = 32768, TR_K = 40960, TR_G = 57344, TR_U = 73728, TR_SZ = 106496;
constexpr int LDS_BYTES = 147456;
constexpr size_t O_YP = 0, O_YS = O_YP + (size_t)MP * DM, O_CAP = O_YS + (size_t)DECB * DM, O_CQP = O_CAP + (size_t)DEPTH * NB * 2 * 1024,
                 O_SP = O_CQP + (size_t)DEPTH * NB * 3 * 3072, O_CAS = O_SP + (size_t)DEPTH * NB * NH * HD * HD, O_CQS = O_CAS + (size_t)DEPTH * DECB * 2 * 1024,
                 O_SS = O_CQS + (size_t)DEPTH * DECB * 3 * 3072, O_END = O_SS + (size_t)DEPTH * DECB * NH * HD * HD;

__device__ __forceinline__ float bflo(unsigned w) { return __uint_as_float(w << 16); }
__device__ __forceinline__ float bfhi(unsigned w) { return __uint_as_float(w & 0xffff0000u); }
__device__ __forceinline__ float bf2f(bf16_t h) { return __uint_as_float((unsigned)h << 16); }
__device__ __forceinline__ unsigned pk2(float lo, float hi) { return pg8::cvt_pk_bf16(lo, hi); }
__device__ __forceinline__ bf16_t f2bf(float f) { return (bf16_t)(pk2(f, 0.f) & 0xffffu); }
__device__ __forceinline__ float rcp_f(float x) { return __builtin_amdgcn_rcpf(x); }
__device__ __forceinline__ float rsq_f(float x) { return __builtin_amdgcn_rsqf(x); }
__device__ __forceinline__ float exp_f(float x) { return __builtin_amdgcn_exp2f(x * 1.4426950408889634f); }
__device__ __forceinline__ float silu_f(float x) { return x * rcp_f(1.f + exp_f(-x)); }
__device__ __forceinline__ float sigmoid_f(float x) { return rcp_f(1.f + exp_f(-x)); }
__device__ __forceinline__ float softplus_f(float x) { return fmaxf(x, 0.f) + __logf(1.f + exp_f(-fabsf(x))); }
__device__ __forceinline__ float wave_sum(float v) {
#pragma unroll
    for (int o = 1; o < 64; o <<= 1) v += __shfl_xor(v, o);
    return v;
}
__device__ __forceinline__ float wave_sum2(float v, int lane) {
    v += __builtin_bit_cast(float, __builtin_amdgcn_update_dpp(0, __builtin_bit_cast(int, v), 0xB1, 0xF, 0xF, true));
    v += __builtin_bit_cast(float, __builtin_amdgcn_update_dpp(0, __builtin_bit_cast(int, v), 0x4E, 0xF, 0xF, true));
    v += __builtin_bit_cast(float, __builtin_amdgcn_update_dpp(0, __builtin_bit_cast(int, v), 0x141, 0xF, 0xF, true));
    v += __builtin_bit_cast(float, __builtin_amdgcn_update_dpp(0, __builtin_bit_cast(int, v), 0x140, 0xF, 0xF, true));
    v += __builtin_bit_cast(float, __builtin_amdgcn_ds_bpermute((lane ^ 16) << 2, __builtin_bit_cast(int, v)));
    v += __builtin_bit_cast(float, __builtin_amdgcn_ds_bpermute((lane ^ 32) << 2, __builtin_bit_cast(int, v)));
    return v;
}
#define LBAR() do { asm volatile("s_waitcnt lgkmcnt(0)" ::: "memory"); __builtin_amdgcn_s_barrier(); asm volatile("" ::: "memory"); } while (0)
#define LDS_WAIT() asm volatile("s_waitcnt lgkmcnt(0)" ::: "memory")

struct EpiF32Bias {
    static constexpr bool PERM = false, AFTER_DRAIN = false;
    float* out; int ldc; const float* bias;
    __device__ __forceinline__ void operator()(const f32x4 (&acc)[2][2][4][2], const pg8::Unit& u, int wr, int wc, int fr, int fq) const {
        const int row0 = u.pm * 256 + wr * 64 + fr, col0 = u.pn * 256 + wc * 32 + 4 * fq;
#pragma unroll
        for (int ai = 0; ai < 2; ++ai)
#pragma unroll
            for (int m = 0; m < 4; ++m) { const size_t off = (size_t)(row0 + ai * 128 + m * 16) * ldc + col0;
#pragma unroll
                for (int bj = 0; bj < 2; ++bj)
#pragma unroll
                    for (int n = 0; n < 2; ++n) { const f32x4 bv = *(const f32x4*)(bias + col0 + bj * 128 + n * 16); *(f32x4*)(out + off + bj * 128 + n * 16) = acc[ai][bj][m][n] + bv; }
                asm volatile("" ::: "memory"); }
    }
};
struct EpiResGate {
    static constexpr bool PERM = false, AFTER_DRAIN = false;
    const float* base; float* out; const float* gate; int ldc;
    __device__ __forceinline__ void operator()(const f32x4 (&acc)[2][2][4][2], const pg8::Unit& u, int wr, int wc, int fr, int fq) const {
        const int row0 = u.pm * 256 + wr * 64 + fr, col0 = u.pn * 256 + wc * 32 + 4 * fq;
        const float* gp = gate + (size_t)((u.pm * 256) / SEQ) * MODLD + col0;
        f32x4 gv[2][2];
#pragma unroll
        for (int bj = 0; bj < 2; ++bj)
#pragma unroll
            for (int n = 0; n < 2; ++n) gv[bj][n] = *(const f32x4*)(gp + bj * 128 + n * 16);
#pragma unroll
        for (int ai = 0; ai < 2; ++ai)
#pragma unroll
            for (int m = 0; m < 4; ++m) { const size_t off = (size_t)(row0 + ai * 128 + m * 16) * ldc + col0;
#pragma unroll
                for (int bj = 0; bj < 2; ++bj)
#pragma unroll
                    for (int n = 0; n < 2; ++n) { const f32x4 b = *(const f32x4*)(base + off + bj * 128 + n * 16); *(f32x4*)(out + off + bj * 128 + n * 16) = b + gv[bj][n] * acc[ai][bj][m][n]; }
                asm volatile("" ::: "memory"); }
    }
};

__device__ __forceinline__ f32x4 skinny16(const bf16_t* A, int lda, const bf16_t* Bt, int ldb, int K, int lane) {
    const int r = lane & 15, q = lane >> 4;
    const bf16x8* ap = (const bf16x8*)(A + (size_t)r * lda + q * 8);
    const bf16x8* bp = (const bf16x8*)(Bt + (size_t)r * ldb + q * 8);
    f32x4 acc0 = {0.f, 0.f, 0.f, 0.f}, acc1 = {0.f, 0.f, 0.f, 0.f};
#pragma unroll 1
    for (int k = 0; k < K / 32; k += 16) {
        bf16x8 a[16], b[16];
#pragma unroll
        for (int i = 0; i < 16; ++i) { a[i] = ap[(k + i) * 4]; b[i] = bp[(k + i) * 4]; }
#pragma unroll
        for (int i = 0; i < 16; i += 2) { acc0 = __builtin_amdgcn_mfma_f32_16x16x32_bf16(a[i], b[i], acc0, 0, 0, 0); acc1 = __builtin_amdgcn_mfma_f32_16x16x32_bf16(a[i + 1], b[i + 1], acc1, 0, 0, 0); }
    }
    return acc0 + acc1;
}


__device__ __forceinline__ void sample_gemm32(LAS unsigned char* lds, const bf16_t* A, const bf16_t* Bt, float* out, int ldo, int n0, int tid, int lane, int wave) {
    constexpr int CK = 512, BS = CK + 8, BUFB = 32 * BS * 2, NC = DM / CK;
    const int r = lane & 15, q8 = lane >> 4;
    const bf16_t* ap = A + (size_t)(wave * 16 + r) * DM + q8 * 8;
    const bf16_t* bp = Bt + (size_t)(tid >> 6) * DM + (tid & 63) * 8;
    const unsigned bw = (unsigned)((tid >> 6) * BS + (tid & 63) * 8) * 2u;
    f32x4 acc[2] = {{0.f, 0.f, 0.f, 0.f}, {0.f, 0.f, 0.f, 0.f}};
    bf16x8 fa[16], fn[16]; u32x4 sb[4];
#define SG_LA(c, d) do { _Pragma("unroll") for (int ks = 0; ks < 16; ++ks) d[ks] = *(const bf16x8*)(ap + (c) * CK + ks * 32); } while (0)
#define SG_LB(c) do { _Pragma("unroll") for (int i = 0; i < 4; ++i) sb[i] = *(const u32x4*)(bp + (size_t)(8 * i) * DM + (c) * CK); } while (0)
#define SG_SB(bufp) do { _Pragma("unroll") for (int i = 0; i < 4; ++i) *(LAS u32x4*)((bufp) + bw + (unsigned)(8 * i * BS * 2)) = sb[i]; } while (0)
    SG_LB(0); SG_LA(0, fa);
    SG_SB(lds);
    SG_LB(1);
    __syncthreads();
#pragma unroll 1
    for (int c = 0; c < NC; ++c) {
        if (c + 1 < NC) SG_LA(c + 1, fn);
        const LAS bf16_t* Bl = (const LAS bf16_t*)(lds + (c & 1) * BUFB);
#pragma unroll
        for (int ks = 0; ks < 16; ++ks) {
            const bf16x8 b0 = *(const LAS bf16x8*)(Bl + r * BS + ks * 32 + q8 * 8), b1 = *(const LAS bf16x8*)(Bl + (16 + r) * BS + ks * 32 + q8 * 8);
            acc[0] = __builtin_amdgcn_mfma_f32_16x16x32_bf16(fa[ks], b0, acc[0], 0, 0, 0); acc[1] = __builtin_amdgcn_mfma_f32_16x16x32_bf16(fa[ks], b1, acc[1], 0, 0, 0); }
        if (c + 1 < NC) SG_SB(lds + ((c + 1) & 1) * BUFB);
        if (c + 2 < NC) SG_LB(c + 2);
#pragma unroll
        for (int ks = 0; ks < 16; ++ks) fa[ks] = fn[ks];
        __syncthreads();
    }
#undef SG_LA
#undef SG_LB
#undef SG_SB
#pragma unroll
    for (int nt = 0; nt < 2; ++nt)
#pragma unroll
        for (int j = 0; j < 4; ++j) out[(size_t)(wave * 16 + q8 * 4 + j) * ldo + n0 + nt * 16 + r] = acc[nt][j];
}

__device__ __forceinline__ void transpose_item(const float* W, int K, int N, bf16_t* WT, LAS float* scr, int item, int lane) {
    const int nblk = (N + 31) / 32, kb = item / nblk, nb = item % nblk, k0 = 64 * kb, n0 = 32 * nb;
    const int nn = n0 + (lane & 31); const bool ok = nn < N;
    float v[32];
#pragma unroll
    for (int i = 0; i < 32; ++i) { const int kk = 2 * i + (lane >> 5); v[i] = ok ? W[(size_t)(k0 + kk) * N + nn] : 0.f; }
#pragma unroll
    for (int i = 0; i < 32; ++i) { const int kk = 2 * i + (lane >> 5); scr[kk * 33 + (lane & 31)] = v[i]; }
    LDS_WAIT(); asm volatile("" ::: "memory");
    const int c = lane & 7;
#pragma unroll
    for (int j = 0; j < 4; ++j) { const int n = (lane >> 3) + 8 * j; const LAS float* s = scr + (8 * c) * 33 + n;
        u32x4 o; o.x = pk2(s[0 * 33], s[1 * 33]); o.y = pk2(s[2 * 33], s[3 * 33]); o.z = pk2(s[4 * 33], s[5 * 33]); o.w = pk2(s[6 * 33], s[7 * 33]);
        *(u32x4*)(WT + (size_t)(n0 + n) * K + k0 + 8 * c) = o; }
    LDS_WAIT(); asm volatile("" ::: "memory");
}

#define RLX_AGENT __ATOMIC_RELAXED, __HIP_MEMORY_SCOPE_AGENT
#define XB_TMO      128
#define XB_XCNT(j)  (256  + 64 * (j))
#define XB_XSUB(j)  (1280 + 64 * (j))
#define XB_XGEN(j)  (2304 + 64 * (j))
#define XB_TOP      3328
#define XB_TOPGEN   3392
#define XCD_BAR_WORDS 3456
#define XB_SPIN_CAP (1u << 17)

__device__ __forceinline__ unsigned xb_ld(unsigned* p)              { return __hip_atomic_load(p, __ATOMIC_RELAXED, __HIP_MEMORY_SCOPE_AGENT); }
__device__ __forceinline__ unsigned xb_add(unsigned* p, unsigned v) { return __hip_atomic_fetch_add(p, v, __ATOMIC_RELAXED, __HIP_MEMORY_SCOPE_AGENT); }
__device__ __forceinline__ unsigned xb_xcc_id() { return (unsigned)__builtin_amdgcn_s_getreg((3 << 11) | 20) & 0xFu; }
#define XB_SPIN(cond, bar) do { unsigned _sp = 0; while (cond) { __builtin_amdgcn_s_sleep(6); \
    if ((++_sp & 255u) == 0u) { if (xb_ld(&(bar)[XB_TMO])) break; if (_sp > XB_SPIN_CAP) { atomicAdd(&(bar)[XB_TMO], 1u); break; } } } } while (0)

struct XcdBarrier {
    unsigned* bar; unsigned x;
    volatile LAS unsigned* st;
};

__device__ __forceinline__ XcdBarrier xcd_barrier_post(unsigned* bar, volatile LAS unsigned* st) {
    XcdBarrier b; b.bar = bar; b.x = xb_xcc_id(); b.st = st;
    if (threadIdx.x == 0) (void)xb_add(&bar[XB_XCNT(b.x)], 1u);
    return b;
}
__device__ __forceinline__ void xcd_barrier_complete(unsigned* bar, unsigned x, unsigned& nloc, unsigned& nx) {
    const unsigned G = gridDim.x * gridDim.y * gridDim.z;
    unsigned sum, cnt, mine, sp = 0u;
    for (;;) {
        sum = 0u; cnt = 0u; mine = 0u;
#pragma unroll
        for (unsigned j = 0; j < 16; ++j) { const unsigned c = xb_ld(&bar[XB_XCNT(j)]); sum += c; cnt += (c > 0u) ? 1u : 0u; mine = (j == x) ? c : mine; }
        if (sum == G) break;
        __builtin_amdgcn_s_sleep(6);
        if ((++sp & 255u) == 0u) { if (xb_ld(&bar[XB_TMO])) break; if (sp > XB_SPIN_CAP) { atomicAdd(&bar[XB_TMO], 1u); break; } }
    }
    nloc = mine > 0u ? mine : 1u; nx = cnt > 0u ? cnt : 1u;
}

__device__ __forceinline__ void xcd_barrier(const XcdBarrier& b) {
    asm volatile("s_waitcnt vmcnt(0)" ::: "memory");
    __syncthreads();
    if (threadIdx.x == 0) {
        unsigned* bar = b.bar;
        __builtin_amdgcn_s_waitcnt(0);
        unsigned nloc = b.st[0], nx = b.st[1];
        if (nloc == 0u) { xcd_barrier_complete(bar, b.x, nloc, nx); b.st[0] = nloc; b.st[1] = nx; }
        const unsigned old = xb_add(&bar[XB_XSUB(b.x)], 1u);
        const unsigned gen = old / nloc;
        if (old + 1u == (gen + 1u) * nloc) {
            __builtin_amdgcn_fence(__ATOMIC_RELEASE, "agent");
            asm volatile("s_waitcnt vmcnt(0)" ::: "memory");
            const unsigned og = xb_add(&bar[XB_TOP], 1u);
            const unsigned tg = og / nx;
            if (og + 1u == (tg + 1u) * nx) xb_add(&bar[XB_TOPGEN], 1u);
            else XB_SPIN(xb_ld(&bar[XB_TOPGEN]) == tg, bar);
            __builtin_amdgcn_fence(__ATOMIC_ACQUIRE, "agent");
            xb_add(&bar[XB_XGEN(b.x)], 1u);
            asm volatile("s_waitcnt vmcnt(0)" ::: "memory");
        } else {
            XB_SPIN(xb_ld(&bar[XB_XGEN(b.x)]) == gen, bar);
            __builtin_amdgcn_fence(__ATOMIC_ACQUIRE, "agent");
            asm volatile("s_waitcnt vmcnt(0)" ::: "memory");
        }
    }
    __syncthreads();
}

__device__ __forceinline__ void phase_norm(const float* xp, const float* xs, const float* ng, const float* modl, bf16_t* hb, int gw, int NGW, int lane) {
    {
        const int row0 = gw * 4, mrow = row0 / SEQ;
        const float* sh = modl + (size_t)mrow * MODLD; const float* sc = sh + DM;
        f32x4 gg[8], ss0[8];
#pragma unroll
        for (int j = 0; j < 8; ++j) { const int c4 = lane + 64 * j; gg[j] = ((const f32x4*)ng)[c4] * (1.f + ((const f32x4*)sc)[c4]); ss0[j] = ((const f32x4*)sh)[c4]; }
#pragma unroll
        for (int k = 0; k < 4; ++k) {
            f32x4 v[8]; float ss = 0.f;
#pragma unroll
            for (int j = 0; j < 8; ++j) { v[j] = ((const f32x4*)(xp + (size_t)(row0 + k) * DM))[lane + 64 * j]; ss += (v[j].x * v[j].x + v[j].y * v[j].y) + (v[j].z * v[j].z + v[j].w * v[j].w); }
            const float rstd = rsq_f(wave_sum2(ss, lane) * (1.f / DM) + EPS);
#pragma unroll
            for (int j = 0; j < 8; ++j) { const int c4 = lane + 64 * j; const f32x4 h = v[j] * rstd * gg[j] + ss0[j]; u32x2 o; o.x = pk2(h.x, h.y); o.y = pk2(h.z, h.w); *(u32x2*)(hb + (size_t)(row0 + k) * DM + c4 * 4) = o; }
        }
    }
    for (int rs = gw; rs < DECB; rs += NGW) {
        const int row = MP + rs; const float* xr = xs + (size_t)rs * DM;
        const float* sh = modl + (size_t)(NB + rs) * MODLD; const float* sc = sh + DM;
        f32x4 v[8]; float ss = 0.f;
#pragma unroll
        for (int j = 0; j < 8; ++j) { v[j] = ((const f32x4*)xr)[lane + 64 * j]; ss += (v[j].x * v[j].x + v[j].y * v[j].y) + (v[j].z * v[j].z + v[j].w * v[j].w); }
        const float rstd = rsq_f(wave_sum2(ss, lane) * (1.f / DM) + EPS);
#pragma unroll
        for (int j = 0; j < 8; ++j) { const int c4 = lane + 64 * j; const f32x4 g = ((const f32x4*)ng)[c4], s1 = ((const f32x4*)sc)[c4], s0 = ((const f32x4*)sh)[c4];
            const f32x4 h = v[j] * rstd * g * (1.f + s1) + s0; u32x2 o; o.x = pk2(h.x, h.y); o.y = pk2(h.z, h.w); *(u32x2*)(hb + (size_t)row * DM + c4 * 4) = o; }
    }
}
__device__ __forceinline__ void final_row(const f32x4 (&v)[8], const f32x4 (&g)[8], float* orow, int lane) {
    float ss = 0.f;
#pragma unroll
    for (int j = 0; j < 8; ++j) ss += (v[j].x * v[j].x + v[j].y * v[j].y) + (v[j].z * v[j].z + v[j].w * v[j].w);
    const float rstd = rsq_f(wave_sum(ss) * (1.f / DM) + EPS);
#pragma unroll
    for (int j = 0; j < 8; ++j) ((f32x4*)orow)[lane + 64 * j] = v[j] * rstd * g[j];
}
__device__ __forceinline__ void phase_final(const float* x, const float* g, float* out, int gw, int NGW, int lane) {
    f32x4 gg[8];
#pragma unroll
    for (int j = 0; j < 8; ++j) gg[j] = ((const f32x4*)g)[lane + 64 * j];
    const int row0 = gw * 4;
    f32x4 v[8], w[8];
#pragma unroll
    for (int j = 0; j < 8; ++j) v[j] = ((const f32x4*)(x + (size_t)row0 * DM))[lane + 64 * j];
#pragma unroll
    for (int k = 0; k < 4; ++k) {
        if (k < 3) {
#pragma unroll
            for (int j = 0; j < 8; ++j) w[j] = ((const f32x4*)(x + (size_t)(row0 + k + 1) * DM))[lane + 64 * j];
        }
        final_row(v, gg, out + (size_t)(row0 + k) * DM, lane);
#pragma unroll
        for (int j = 0; j < 8; ++j) v[j] = w[j];
    }
    for (int row = MP + gw; row < MT; row += NGW) {
#pragma unroll
        for (int j = 0; j < 8; ++j) v[j] = ((const f32x4*)(x + (size_t)row * DM))[lane + 64 * j];
        final_row(v, gg, out + (size_t)row * DM, lane);
    }
}

template <int I, int C> __device__ __forceinline__ void s2_load(const LAS float* Ll, f32x4 (&lr)[16]) {
    if constexpr (4 * C < I) { lr[C] = *(const LAS f32x4*)(Ll + I * 64 + 4 * C); s2_load<I, C + 1>(Ll, lr); }
}
template <int I, int C> __device__ __forceinline__ void s2_fma(const f32x4 (&lr)[16], const float (&Xc)[64], float& a0, float& a1, float& a2, float& a3) {
    if constexpr (4 * C < I) {
        a0 += lr[C].x * Xc[4 * C];
        if constexpr (4 * C + 1 < I) a1 += lr[C].y * Xc[4 * C + 1];
        if constexpr (4 * C + 2 < I) a2 += lr[C].z * Xc[4 * C + 2];
        if constexpr (4 * C + 3 < I) a3 += lr[C].w * Xc[4 * C + 3];
        s2_fma<I, C + 1>(lr, Xc, a0, a1, a2, a3);
    }
}
template <int I> __device__ __forceinline__ void s2_row(const LAS float* Ll, float (&Xc)[64], int lane) {
    if constexpr (I < 64) {
        float a0 = Ll[I * 64 + lane], a1 = 0.f, a2 = 0.f, a3 = 0.f;
        f32x4 lr[16];
        s2_load<I, 0>(Ll, lr);
        s2_fma<I, 0>(lr, Xc, a0, a1, a2, a3);
        Xc[I] = -((a0 + a1) + (a2 + a3));
        asm volatile("" ::: "memory");
        s2_row<I + 1>(Ll, Xc, lane);
    }
}
struct PrepP { const bf16_t* z; const float* ba; const float* cw; const float* alog; const float* dtb; unsigned char* tr; float* gl; };
constexpr int PS = 136, TS = 72;
__device__ __forceinline__ void conv8(const u32x4 (&x)[4], const LAS float* w, float (&o)[8]) {
    f32x4 wa[4], wb[4];
#pragma unroll
    for (int j = 0; j < 4; ++j) { wa[j] = *(const LAS f32x4*)(w + j * 384); wb[j] = *(const LAS f32x4*)(w + j * 384 + 4); }
#pragma unroll
    for (int i = 0; i < 8; ++i) o[i] = 0.f;
#pragma unroll
    for (int j = 0; j < 4; ++j) {
        o[0] += wa[j].x * bflo(x[j].x); o[1] += wa[j].y * bfhi(x[j].x); o[2] += wa[j].z * bflo(x[j].y); o[3] += wa[j].w * bfhi(x[j].y);
        o[4] += wb[j].x * bflo(x[j].z); o[5] += wb[j].y * bfhi(x[j].z); o[6] += wb[j].z * bflo(x[j].w); o[7] += wb[j].w * bfhi(x[j].w); }
#pragma unroll
    for (int i = 0; i < 8; ++i) o[i] = silu_f(o[i]);
}
__device__ __forceinline__ u32x4 pack8(const float* v) { u32x4 o; o.x = pk2(v[0], v[1]); o.y = pk2(v[2], v[3]); o.z = pk2(v[4], v[5]); o.w = pk2(v[6], v[7]); return o; }
__device__ __forceinline__ void prep_weights(LAS unsigned char* lds, const float* cqw, int h, int tid) {
    LAS float* wl = (LAS float*)(lds + 114688);
#pragma unroll
    for (int i = 0; i < 3; ++i) { const int idx = tid + 512 * i, j = idx / 384, rem = idx - j * 384, m = rem >> 7, c = rem & 127; wl[idx] = cqw[j * 3072 + m * 1024 + h * 128 + c]; }
}
__device__ __forceinline__ void prep_task(LAS unsigned char* lds, const PrepP& P, int task, int tid, int lane, int wave) {
    asm volatile("" : "+v"(tid));
    lane = tid & 63;
    unsigned lb = 0; asm volatile("" : "+v"(lb)); lds += (lb & ~15u);
    const int h = task & 7, n = (task >> 3) & 31, b = task >> 8;
    const int row0 = b * SEQ + n * 64;
    unsigned char* trp = P.tr + (size_t)task * TR_SZ;
    LAS bf16_t* Kl = (LAS bf16_t*)lds; LAS bf16_t* Ql = Kl + 64 * PS; LAS bf16_t* Vl = Ql + 64 * PS; LAS bf16_t* KBl = Vl + 64 * PS; LAS bf16_t* KTl = KBl + 64 * PS;
    LAS float* Ll = (LAS float*)(lds + 5 * 64 * PS * 2);
    LAS bf16_t* Tl = (LAS bf16_t*)(lds + 5 * 64 * PS * 2 + 16384);
    LAS float* gcl = (LAS float*)(lds + 5 * 64 * PS * 2 + 16384 + 64 * TS * 2);
    const int r = lane & 15, q8 = lane >> 4;
    if (wave == 0) {
        const float* bar = P.ba + (size_t)(row0 + lane) * 16;
        float g = -exp_f(P.alog[h]) * softplus_f(bar[8 + h] + P.dtb[h]);
#pragma unroll
        for (int o = 1; o < 64; o <<= 1) { const float v = __shfl_up(g, o); if (lane >= o) g += v; }
        gcl[lane] = g; gcl[64 + lane] = sigmoid_f(bar[h]);
        if (lane == 63) P.gl[task] = exp_f(g);
    }
    __syncthreads();
    {
        const int t = tid >> 3, seg = tid & 7;
        const float beta = gcl[64 + t], gc = gcl[t], glc = gcl[63];
        const float eg = exp_f(gc), et = exp_f(glc - gc);
        const int tt = n * 64 + t;
        const bf16_t* zr = P.z + (size_t)(row0 + t) * NZ + 4096 + h * 128 + seg * 16;
        const LAS float* cw = (const LAS float*)(lds + 114688) + seg * 16;
        u32x4 xz[3][2][4];
#pragma unroll
        for (int m = 0; m < 3; ++m)
#pragma unroll
            for (int hf = 0; hf < 2; ++hf)
#pragma unroll
                for (int j = 0; j < 4; ++j) { const bool ok = tt - 3 + j >= 0; xz[m][hf][j] = *(const u32x4*)(zr + m * 1024 + hf * 8 + (ptrdiff_t)(ok ? j - 3 : 0) * NZ); if (!ok) xz[m][hf][j] = (u32x4){0u, 0u, 0u, 0u}; }
        const int lo = t * PS + seg * 16;
        float x[16], y[16];
        { float o[8]; conv8(xz[2][0], cw + 256, o);
#pragma unroll
          for (int i = 0; i < 8; ++i) x[i] = o[i] * beta;
          conv8(xz[2][1], cw + 256 + 8, o);
#pragma unroll
          for (int i = 0; i < 8; ++i) x[8 + i] = o[i] * beta; }
        *(LAS u32x4*)(Vl + lo) = pack8(x); *(LAS u32x4*)(Vl + lo + 8) = pack8(x + 8);
        asm volatile("" ::: "memory");
        { float o[8]; conv8(xz[1][0], cw + 128, o);
#pragma unroll
          for (int i = 0; i < 8; ++i) x[i] = o[i];
          conv8(xz[1][1], cw + 128 + 8, o);
#pragma unroll
          for (int i = 0; i < 8; ++i) x[8 + i] = o[i]; }
        { float sk = 0.f;
#pragma unroll
          for (int i = 0; i < 16; ++i) sk += x[i] * x[i];
          sk += __shfl_xor(sk, 1); sk += __shfl_xor(sk, 2); sk += __shfl_xor(sk, 4);
          const float rk = rsq_f(sk + EPS);
#pragma unroll
          for (int i = 0; i < 16; ++i) x[i] *= rk; }
        *(LAS u32x4*)(Kl + lo) = pack8(x); *(LAS u32x4*)(Kl + lo + 8) = pack8(x + 8);
#pragma unroll
        for (int i = 0; i < 16; ++i) y[i] = x[i] * (beta * eg);
        *(LAS u32x4*)(KBl + lo) = pack8(y); *(LAS u32x4*)(KBl + lo + 8) = pack8(y + 8);
#pragma unroll
        for (int i = 0; i < 16; ++i) y[i] = x[i] * et;
        *(LAS u32x4*)(KTl + lo) = pack8(y); *(LAS u32x4*)(KTl + lo + 8) = pack8(y + 8);
        asm volatile("" ::: "memory");
        { float o[8]; conv8(xz[0][0], cw, o);
#pragma unroll
          for (int i = 0; i < 8; ++i) x[i] = o[i];
          conv8(xz[0][1], cw + 8, o);
#pragma unroll
          for (int i = 0; i < 8; ++i) x[8 + i] = o[i]; }
        { float sq = 0.f;
#pragma unroll
          for (int i = 0; i < 16; ++i) sq += x[i] * x[i];
          sq += __shfl_xor(sq, 1); sq += __shfl_xor(sq, 2); sq += __shfl_xor(sq, 4);
          const float rq = rsq_f(sq + EPS) * 0.08838834764831845f;
#pragma unroll
          for (int i = 0; i < 16; ++i) x[i] *= rq; }
        *(LAS u32x4*)(Ql + lo) = pack8(x); *(LAS u32x4*)(Ql + lo + 8) = pack8(x + 8);
#pragma unroll
        for (int i = 0; i < 16; ++i) y[i] = x[i] * eg;
        bf16_t* qo = (bf16_t*)(trp + TR_Q) + t * 128 + seg * 16;
        *(u32x4*)qo = pack8(y); *(u32x4*)(qo + 8) = pack8(y + 8);
    }
    __syncthreads();
    {
        const int it = wave >> 1, jt0 = (wave & 1) * 2;
        bf16x8 aK[4], aQ[4];
#pragma unroll
        for (int ks = 0; ks < 4; ++ks) { aK[ks] = *(const LAS bf16x8*)(Kl + (it * 16 + r) * PS + ks * 32 + q8 * 8); aQ[ks] = *(const LAS bf16x8*)(Ql + (it * 16 + r) * PS + ks * 32 + q8 * 8); }
#pragma unroll
        for (int jj = 0; jj < 2; ++jj) {
            const int jt = jt0 + jj;
            bf16_t* ap = (bf16_t*)(trp + TR_A) + (it * 16 + r) * 64 + jt * 16 + q8 * 4;
            if (jt > it) { *(u32x2*)ap = (u32x2){lb, lb};
#pragma unroll
                for (int j = 0; j < 4; ++j) Ll[(it * 16 + q8 * 4 + j) * 64 + jt * 16 + r] = 0.f;
                continue; }
            f32x4 accL = {0.f, 0.f, 0.f, 0.f}, accA = {0.f, 0.f, 0.f, 0.f};
#pragma unroll
            for (int ks = 0; ks < 4; ++ks) { const bf16x8 bK = *(const LAS bf16x8*)(Kl + (jt * 16 + r) * PS + ks * 32 + q8 * 8);
                accL = __builtin_amdgcn_mfma_f32_16x16x32_bf16(aK[ks], bK, accL, 0, 0, 0);
                accA = __builtin_amdgcn_mfma_f32_16x16x32_bf16(bK, aQ[ks], accA, 0, 0, 0); }
            float av[4];
#pragma unroll
            for (int j = 0; j < 4; ++j) {
                { const int i = it * 16 + q8 * 4 + j, jx = jt * 16 + r; const float e = exp_f(gcl[i] - gcl[jx]) * gcl[64 + i] * accL[j]; Ll[i * 64 + jx] = (i > jx) ? e : 0.f; }
                { const int i = it * 16 + r, jx = jt * 16 + q8 * 4 + j; const float e = exp_f(gcl[i] - gcl[jx]) * accA[j]; av[j] = (i >= jx) ? e : 0.f; } }
            u32x2 o; o.x = pk2(av[0], av[1]); o.y = pk2(av[2], av[3]); *(u32x2*)ap = o;
        }
    }
    __syncthreads();
    if (wave == 0) {
        float Xc[64];
        s2_row<0>(Ll, Xc, lane);
#pragma unroll
        for (int i = 0; i < 64; ++i) Tl[i * TS + lane] = f2bf(Xc[i]);
        asm volatile("s_waitcnt lgkmcnt(0)" ::: "memory");
        Tl[lane * TS + lane] = (bf16_t)0x3F80u;
    }
    __syncthreads();
    {
        const int c0 = wave * 16;
        bf16x8 bv[2], bk[2];
#pragma unroll
        for (int ks = 0; ks < 2; ++ks)
#pragma unroll
            for (int j = 0; j < 8; ++j) { const int tok = ks * 32 + q8 * 8 + j; bv[ks][j] = (short)Vl[tok * PS + c0 + r]; bk[ks][j] = (short)KBl[tok * PS + c0 + r]; }
#pragma unroll
        for (int mt = 0; mt < 4; ++mt) {
            f32x4 aU = {0.f, 0.f, 0.f, 0.f}, aW = {0.f, 0.f, 0.f, 0.f};
#pragma unroll
            for (int ks = 0; ks < 2; ++ks) { if (ks == 1 && mt < 2) continue;
                const bf16x8 aT = *(const LAS bf16x8*)(Tl + (mt * 16 + r) * TS + ks * 32 + q8 * 8);
                aU = __builtin_amdgcn_mfma_f32_16x16x32_bf16(aT, bv[ks], aU, 0, 0, 0);
                aW = __builtin_amdgcn_mfma_f32_16x16x32_bf16(bk[ks], aT, aW, 0, 0, 0); }
            *(f32x4*)((float*)(trp + TR_U) + ((wave * 4 + mt) * 64 + lane) * 4) = aU;
            u32x2 o; o.x = pk2(-aW[0], -aW[1]); o.y = pk2(-aW[2], -aW[3]);
            *(u32x2*)((bf16_t*)(trp + TR_W) + (mt * 16 + r) * 128 + c0 + q8 * 4) = o;
        }
#pragma unroll
        for (int ii = 0; ii < 2; ++ii) { const int item = tid + 512 * ii, dk = item & 127, oct = item >> 7; float kv[8];
#pragma unroll
            for (int j = 0; j < 8; ++j) kv[j] = bf2f(KTl[(oct * 8 + j) * PS + dk]);
            *(u32x4*)((bf16_t*)(trp + TR_K) + dk * 64 + oct * 8) = pack8(kv); }
    }
    __syncthreads();
}
__device__ __forceinline__ void conva_prompt(const bf16_t* z, const float* caw, bf16_t* ycat, int gt, int GT) {
#pragma unroll 2
    for (int idx = gt; idx < MP * 128; idx += GT) {
        const int row = idx >> 7, c8 = (idx & 127) * 8, t = row & (SEQ - 1);
        const bf16_t* zr = z + (size_t)row * NZ + c8;
        float conv[8];
#pragma unroll
        for (int i = 0; i < 8; ++i) conv[i] = 0.f;
#pragma unroll
        for (int j = 0; j < 3; ++j) {
            const bool ok = t - 2 + j >= 0; const ptrdiff_t ro = (ptrdiff_t)(ok ? j - 2 : 0) * NZ;
            u32x4 c = *(const u32x4*)(zr + ro + 1024); const u32x4 hh = *(const u32x4*)(zr + ro + 2048);
            if (!ok) c = (u32x4){0u, 0u, 0u, 0u};
            const f32x4 w0 = *(const f32x4*)(caw + j * 1024 + c8), w1 = *(const f32x4*)(caw + j * 1024 + c8 + 4);
            conv[0] += w0.x * (bflo(c.x) * bflo(hh.x)); conv[1] += w0.y * (bfhi(c.x) * bfhi(hh.x)); conv[2] += w0.z * (bflo(c.y) * bflo(hh.y)); conv[3] += w0.w * (bfhi(c.y) * bfhi(hh.y));
            conv[4] += w1.x * (bflo(c.z) * bflo(hh.z)); conv[5] += w1.y * (bfhi(c.z) * bfhi(hh.z)); conv[6] += w1.z * (bflo(c.w) * bflo(hh.w)); conv[7] += w1.w * (bfhi(c.w) * bfhi(hh.w));
        }
        const u32x4 bb = *(const u32x4*)zr, gg = *(const u32x4*)(zr + 3072);
        float y[8];
        y[0] = bflo(bb.x) * conv[0] * silu_f(bflo(gg.x)); y[1] = bfhi(bb.x) * conv[1] * silu_f(bfhi(gg.x)); y[2] = bflo(bb.y) * conv[2] * silu_f(bflo(gg.y)); y[3] = bfhi(bb.y) * conv[3] * silu_f(bfhi(gg.y));
        y[4] = bflo(bb.z) * conv[4] * silu_f(bflo(gg.z)); y[5] = bfhi(bb.z) * conv[5] * silu_f(bfhi(gg.z)); y[6] = bflo(bb.w) * conv[6] * silu_f(bflo(gg.w)); y[7] = bfhi(bb.w) * conv[7] * silu_f(bfhi(gg.w));
        *(u32x4*)(ycat + (size_t)row * DM + c8) = pack8(y);
    }
}
__device__ __forceinline__ void conv_states_prompt(const bf16_t* z, float* oca, float* ocq, int gt, int GT) {
    for (int idx = gt; idx < NB * 2 * 1024; idx += GT) { const int c = idx & 1023, j = (idx >> 10) & 1, b = idx >> 11;
        const bf16_t* zr = z + (size_t)(b * SEQ + SEQ - 2 + j) * NZ; oca[idx] = bf2f(zr[1024 + c]) * bf2f(zr[2048 + c]); }
    for (int idx = gt; idx < NB * 3 * 3072; idx += GT) { const int c = (int)((unsigned)idx % 3072u), j = (int)((unsigned)idx / 3072u) % 3, b = (int)((unsigned)idx / 9216u);
        ocq[idx] = bf2f(z[(size_t)(b * SEQ + SEQ - 3 + j) * NZ + 4096 + c]); }
}

struct ScanP { const unsigned char* tr; const float* gl; float* obuf; float* sout; };
constexpr int SB_W = 0, SB_Q = 64 * PS * 2, SB_A = 2 * 64 * PS * 2, SB_K = SB_A + 64 * TS * 2, SB_SZ = SB_K + 128 * TS * 2;
static_assert(2 * SB_SZ <= 131072, "scan LDS");
__device__ __forceinline__ bf16x8 frag1(const LAS bf16_t* p) { return *(const LAS bf16x8*)p; }
__device__ __forceinline__ bf16x8 packB(const f32x4& a, const f32x4& b) { u32x4 v = {pk2(a[0], a[1]), pk2(a[2], a[3]), pk2(b[0], b[1]), pk2(b[2], b[3])}; return __builtin_bit_cast(bf16x8, v); }
__device__ __forceinline__ void scan_bh(LAS unsigned char* lds, const ScanP& P, int b, int h, int half, int tid, int lane, int wave) {
    const bool cw = wave < 4;
    const int r = lane & 15, q8 = lane >> 4, ct = half * 4 + (wave & 3), c0 = ct * 16;
    if (!cw) {
        const int lt = tid - 256, wrow = lt >> 4, wc16 = lt & 15, arow = lt >> 3, ac16 = lt & 7;
        const int wperm = (wc16 >> 2) * 32 + ((((wc16 & 3) * 8) & 15) >> 2) * 8 + (((wc16 & 3) * 8) >> 4) * 4, aperm = (ac16 >> 2) * 32 + ((((ac16 & 3) * 8) & 15) >> 2) * 8 + (((ac16 & 3) * 8) >> 4) * 4;
        const unsigned oW = (unsigned)TR_W + (unsigned)(wrow * 128 + wc16 * 8) * 2u, oQ = oW + (unsigned)(TR_Q - TR_W), oA = (unsigned)TR_A + (unsigned)(arow * 64 + ac16 * 8) * 2u, oK = oA + (unsigned)(TR_K - TR_A);
        const unsigned lW = (unsigned)(wrow * PS + wperm) * 2u, lA = (unsigned)(arow * TS + aperm) * 2u;
        u32x4 sa[14], sb[14];
#define L_LOAD(nn, d) do { const unsigned char* tr_ = P.tr + (size_t)((b << 8) | ((nn) << 3) | h) * TR_SZ; \
            _Pragma("unroll") for (int i = 0; i < 4; ++i) { d[i] = *(const u32x4*)(tr_ + (oW + 4096u * i)); d[4 + i] = *(const u32x4*)(tr_ + (oQ + 4096u * i)); d[10 + i] = *(const u32x4*)(tr_ + (oK + 4096u * i)); } \
            d[8] = *(const u32x4*)(tr_ + oA); d[9] = *(const u32x4*)(tr_ + (oA + 4096u)); } while (0)
#define ST2(base, boff, v) do { *(LAS u32x2*)((base) + (boff)) = (u32x2){(v).x, (v).y}; *(LAS u32x2*)((base) + (boff) + 16u) = (u32x2){(v).z, (v).w}; } while (0)
#define L_STORE(bufp, s_) do { LAS unsigned char* bp_ = (bufp); \
            _Pragma("unroll") for (int i = 0; i < 4; ++i) { ST2(bp_ + SB_W, lW + (unsigned)(16 * PS * 2 * i), s_[i]); ST2(bp_ + SB_Q, lW + (unsigned)(16 * PS * 2 * i), s_[4 + i]); ST2(bp_ + SB_K, lA + (unsigned)(32 * TS * 2 * i), s_[10 + i]); } \
            ST2(bp_ + SB_A, lA, s_[8]); ST2(bp_ + SB_A, lA + (unsigned)(32 * TS * 2), s_[9]); } while (0)
        L_LOAD(0, sa); L_STORE(lds, sa); L_LOAD(1, sa);
        __syncthreads();
#pragma unroll 1
        for (int n = 0; n < 32; n += 2) {
            if (n + 2 < 32) L_LOAD(n + 2, sb);
            L_STORE(lds + ((n + 1) & 1) * SB_SZ, sa);
            LBAR();
            if (n + 3 < 32) L_LOAD(n + 3, sa);
            if (n + 2 < 32) L_STORE(lds + ((n + 2) & 1) * SB_SZ, sb);
            LBAR();
        }
#undef L_LOAD
#undef L_STORE
#undef ST2
    } else {
        f32x4 S[8];
#pragma unroll
        for (int i = 0; i < 8; ++i) S[i] = (f32x4){0.f, 0.f, 0.f, 0.f};
        const float glv = (lane < 32) ? P.gl[(b << 8) | (lane << 3) | h] : 0.f;
        f32x4 ubn[4];
        const unsigned oU = (unsigned)TR_U + (unsigned)(ct * 256 + lane) * 16u;
#define U_LOAD(nn) do { const unsigned char* tr_ = P.tr + (size_t)((b << 8) | ((nn) << 3) | h) * TR_SZ; \
            _Pragma("unroll") for (int mt_ = 0; mt_ < 4; ++mt_) ubn[mt_] = *(const f32x4*)(tr_ + (oU + (unsigned)mt_ * 1024u)); } while (0)
        U_LOAD(0);
        __syncthreads();
#pragma unroll 1
        for (int n = 0; n < 32; ++n) {
            LAS unsigned char* buf = lds + (n & 1) * SB_SZ;
            const LAS bf16_t* Wl = (const LAS bf16_t*)(buf + SB_W); const LAS bf16_t* Ql = (const LAS bf16_t*)(buf + SB_Q);
            const LAS bf16_t* Al = (const LAS bf16_t*)(buf + SB_A); const LAS bf16_t* Kl = (const LAS bf16_t*)(buf + SB_K);
            f32x4 u[4], o[4];
#pragma unroll
            for (int mt = 0; mt < 4; ++mt) { u[mt] = ubn[mt]; o[mt] = (f32x4){0.f, 0.f, 0.f, 0.f}; }
            if (n + 1 < 32) U_LOAD(n + 1);
        bf16x8 Sb[4];
#pragma unroll
        for (int ks = 0; ks < 4; ++ks) Sb[ks] = packB(S[2 * ks], S[2 * ks + 1]);
#define SBAR() __builtin_amdgcn_sched_barrier(0)
#define LD4(d, base, mt, stride) do { _Pragma("unroll") for (int ks = 0; ks < 4; ++ks) d[ks] = frag1((base) + ((mt) * 16 + r) * (stride) + ks * 32 + q8 * 8); } while (0)
#define MM4(acc, s_) do { _Pragma("unroll") for (int ks = 0; ks < 4; ++ks) acc = __builtin_amdgcn_mfma_f32_16x16x32_bf16(s_[ks], Sb[ks], acc, 0, 0, 0); } while (0)
        {
            bf16x8 fA[4], fB[4];
            LD4(fA, Wl, 0, PS); SBAR(); LD4(fB, Ql, 0, PS); SBAR();
            MM4(u[0], fA); SBAR(); LD4(fA, Wl, 1, PS); SBAR(); MM4(o[0], fB); SBAR(); LD4(fB, Ql, 1, PS); SBAR();
            MM4(u[1], fA); SBAR(); LD4(fA, Wl, 2, PS); SBAR(); MM4(o[1], fB); SBAR(); LD4(fB, Ql, 2, PS); SBAR();
            MM4(u[2], fA); SBAR(); LD4(fA, Wl, 3, PS); SBAR(); MM4(o[2], fB); SBAR(); LD4(fB, Ql, 3, PS); SBAR();
            MM4(u[3], fA); SBAR(); MM4(o[3], fB); SBAR();
        }
        bf16x8 Ub[2];
        Ub[0] = packB(u[0], u[1]); Ub[1] = packB(u[2], u[3]);
        const float gl = __shfl(glv, n);
#define LDK(d, dt0) do { d[0] = frag1(Kl + ((dt0) * 16 + r) * TS + q8 * 8); d[1] = frag1(Kl + ((dt0) * 16 + r) * TS + 32 + q8 * 8); d[2] = frag1(Kl + (((dt0) + 1) * 16 + r) * TS + q8 * 8); d[3] = frag1(Kl + (((dt0) + 1) * 16 + r) * TS + 32 + q8 * 8); } while (0)
#define MMK(s_, dt0) do { S[dt0] = S[dt0] * gl; S[(dt0) + 1] = S[(dt0) + 1] * gl; \
            S[dt0] = __builtin_amdgcn_mfma_f32_16x16x32_bf16(s_[0], Ub[0], S[dt0], 0, 0, 0); S[(dt0) + 1] = __builtin_amdgcn_mfma_f32_16x16x32_bf16(s_[2], Ub[0], S[(dt0) + 1], 0, 0, 0); \
            S[dt0] = __builtin_amdgcn_mfma_f32_16x16x32_bf16(s_[1], Ub[1], S[dt0], 0, 0, 0); S[(dt0) + 1] = __builtin_amdgcn_mfma_f32_16x16x32_bf16(s_[3], Ub[1], S[(dt0) + 1], 0, 0, 0); } while (0)
        {
            bf16x8 aA[6], kA[4], kB[4];
            aA[0] = frag1(Al + (0 * 16 + r) * TS + q8 * 8); aA[1] = frag1(Al + (1 * 16 + r) * TS + q8 * 8);
            aA[2] = frag1(Al + (2 * 16 + r) * TS + q8 * 8); aA[3] = frag1(Al + (2 * 16 + r) * TS + 32 + q8 * 8);
            aA[4] = frag1(Al + (3 * 16 + r) * TS + q8 * 8); aA[5] = frag1(Al + (3 * 16 + r) * TS + 32 + q8 * 8);
            SBAR(); LDK(kA, 0); SBAR();
            o[0] = __builtin_amdgcn_mfma_f32_16x16x32_bf16(aA[0], Ub[0], o[0], 0, 0, 0); o[1] = __builtin_amdgcn_mfma_f32_16x16x32_bf16(aA[1], Ub[0], o[1], 0, 0, 0);
            o[2] = __builtin_amdgcn_mfma_f32_16x16x32_bf16(aA[2], Ub[0], o[2], 0, 0, 0); o[3] = __builtin_amdgcn_mfma_f32_16x16x32_bf16(aA[4], Ub[0], o[3], 0, 0, 0);
            o[2] = __builtin_amdgcn_mfma_f32_16x16x32_bf16(aA[3], Ub[1], o[2], 0, 0, 0); o[3] = __builtin_amdgcn_mfma_f32_16x16x32_bf16(aA[5], Ub[1], o[3], 0, 0, 0);
            SBAR(); LDK(kB, 2); SBAR(); MMK(kA, 0); SBAR(); LDK(kA, 4); SBAR(); MMK(kB, 2); SBAR(); LDK(kB, 6); SBAR(); MMK(kA, 4); SBAR(); MMK(kB, 6); SBAR();
        }
#undef LD4
#undef MM4
#undef LDK
#undef MMK
#undef SBAR
        { unsigned oO = (unsigned)((q8 * 4) * 1024 + c0 + r) * 4u; asm volatile("" : "+v"(oO));
          unsigned char* ob = (unsigned char*)(P.obuf + (size_t)(b * SEQ + n * 64) * 1024 + h * 128);
#pragma unroll
          for (int mt = 0; mt < 4; ++mt)
#pragma unroll
              for (int j = 0; j < 4; ++j) *(float*)(ob + (oO + (unsigned)(mt * 16 + j) * 4096u)) = o[mt][j]; }
            LBAR();
        }
#undef U_LOAD
#pragma unroll
        for (int dt = 0; dt < 8; ++dt)
#pragma unroll
            for (int j = 0; j < 4; ++j) P.sout[(size_t)(dt * 16 + q8 * 4 + j) * HD + c0 + r] = S[dt][j];
    }
    __syncthreads();
}
__device__ __forceinline__ void onorm_pass(const float* obuf, const bf16_t* z, const float* ong, bf16_t* ycat, int gw, int NGW, int lane) {
    const int cl = (lane & 7) * 16;
    f32x4 g[4];
#pragma unroll
    for (int i = 0; i < 4; ++i) g[i] = *(const f32x4*)(ong + cl + 4 * i);
#pragma unroll 2
    for (int row = gw; row < MP; row += NGW) {
        const float* op = obuf + (size_t)row * 1024 + lane * 16; const bf16_t* zp = z + (size_t)row * NZ + 7168 + lane * 16;
        f32x4 v[4]; float ss = 0.f;
#pragma unroll
        for (int i = 0; i < 4; ++i) { v[i] = *(const f32x4*)(op + 4 * i); ss += (v[i].x * v[i].x + v[i].y * v[i].y) + (v[i].z * v[i].z + v[i].w * v[i].w); }
        const u32x4 g0 = *(const u32x4*)zp, g1 = *(const u32x4*)(zp + 8);
        ss += __builtin_bit_cast(float, __builtin_amdgcn_update_dpp(0, __builtin_bit_cast(int, ss), 0xB1, 0xF, 0xF, true));
        ss += __builtin_bit_cast(float, __builtin_amdgcn_update_dpp(0, __builtin_bit_cast(int, ss), 0x4E, 0xF, 0xF, true));
        ss += __builtin_bit_cast(float, __builtin_amdgcn_update_dpp(0, __builtin_bit_cast(int, ss), 0x141, 0xF, 0xF, true));
        const float rstd = rsq_f(ss * (1.f / HD) + EPS);
        float y[16];
        y[0] = v[0].x * rstd * g[0].x * silu_f(bflo(g0.x)); y[1] = v[0].y * rstd * g[0].y * silu_f(bfhi(g0.x)); y[2] = v[0].z * rstd * g[0].z * silu_f(bflo(g0.y)); y[3] = v[0].w * rstd * g[0].w * silu_f(bfhi(g0.y));
        y[4] = v[1].x * rstd * g[1].x * silu_f(bflo(g0.z)); y[5] = v[1].y * rstd * g[1].y * silu_f(bfhi(g0.z)); y[6] = v[1].z * rstd * g[1].z * silu_f(bflo(g0.w)); y[7] = v[1].w * rstd * g[1].w * silu_f(bfhi(g0.w));
        y[8] = v[2].x * rstd * g[2].x * silu_f(bflo(g1.x)); y[9] = v[2].y * rstd * g[2].y * silu_f(bfhi(g1.x)); y[10] = v[2].z * rstd * g[2].z * silu_f(bflo(g1.y)); y[11] = v[2].w * rstd * g[2].w * silu_f(bfhi(g1.y));
        y[12] = v[3].x * rstd * g[3].x * silu_f(bflo(g1.z)); y[13] = v[3].y * rstd * g[3].y * silu_f(bfhi(g1.z)); y[14] = v[3].z * rstd * g[3].z * silu_f(bflo(g1.w)); y[15] = v[3].w * rstd * g[3].w * silu_f(bfhi(g1.w));
        bf16_t* yp = ycat + (size_t)row * DM + 1024 + lane * 16;
        *(u32x4*)yp = pack8(y); *(u32x4*)(yp + 8) = pack8(y + 8);
    }
}
struct SampP { const float* zs; const float* sca; const float* scq; const float* s0; const float* caw; const float* cqw; const float* alog; const float* dtb; const float* ong;
               bf16_t* ycat; float* oca; float* ocq; float* oss; };
__device__ __forceinline__ void sample_task(LAS unsigned char* lds, const SampP& P, int task, int tid, int lane, int wave) {
    const int h = task & 7, bs = task >> 3;
    LAS float* qv = (LAS float*)lds; LAS float* kv = qv + 128; LAS float* vv = kv + 128; LAS float* part = vv + 128; LAS float* pks = part + 16; LAS float* pqs = pks + 1024;
    const float* s0 = P.s0 + (size_t)(bs * 8 + h) * 16384; float* so = P.oss + (size_t)(bs * 8 + h) * 16384;
    const int half = lane >> 5, c4 = (lane & 31) * 4;
    f32x4 sr[8];
#pragma unroll
    for (int i = 0; i < 8; ++i) sr[i] = *(const f32x4*)(s0 + (size_t)(wave * 16 + 2 * i + half) * 128 + c4);
    const float* zr = P.zs + (size_t)bs * DINP;
    const float zbeta = zr[8192 + h], zalpha = zr[8200 + h], alg = P.alog[h], dtbv = P.dtb[h];
    f32x4 ongv = {0.f, 0.f, 0.f, 0.f}, gbv = {0.f, 0.f, 0.f, 0.f};
    if (wave == 0 && lane < 32) { ongv = *(const f32x4*)(P.ong + c4); gbv = *(const f32x4*)(zr + 7168 + h * 128 + c4); }
    float qkv[3] = {0.f, 0.f, 0.f};
    if (tid < 128) {
        const int cc = h * 128 + tid;
        { const float ch = zr[1024 + cc] * zr[2048 + cc]; const float s0a = P.sca[(bs * 2 + 0) * 1024 + cc], s1a = P.sca[(bs * 2 + 1) * 1024 + cc];
          const float conv = P.caw[cc] * s0a + P.caw[1024 + cc] * s1a + P.caw[2048 + cc] * ch;
          P.ycat[(size_t)(MP + bs) * DM + cc] = f2bf(zr[cc] * conv * silu_f(zr[3072 + cc]));
          P.oca[(bs * 2 + 0) * 1024 + cc] = s1a; P.oca[(bs * 2 + 1) * 1024 + cc] = ch; }
#pragma unroll
        for (int m = 0; m < 3; ++m) { const int c3 = m * 1024 + cc; const float pre = zr[4096 + c3];
            const float a0 = P.scq[(bs * 3 + 0) * 3072 + c3], a1 = P.scq[(bs * 3 + 1) * 3072 + c3], a2 = P.scq[(bs * 3 + 2) * 3072 + c3];
            qkv[m] = silu_f(P.cqw[c3] * a0 + P.cqw[3072 + c3] * a1 + P.cqw[2 * 3072 + c3] * a2 + P.cqw[3 * 3072 + c3] * pre);
            P.ocq[(bs * 3 + 0) * 3072 + c3] = a1; P.ocq[(bs * 3 + 1) * 3072 + c3] = a2; P.ocq[(bs * 3 + 2) * 3072 + c3] = pre; }
        const float sq = wave_sum(qkv[0] * qkv[0]), sk = wave_sum(qkv[1] * qkv[1]);
        if (lane == 0) { part[wave * 2] = sq; part[wave * 2 + 1] = sk; }
    }
    __syncthreads();
    if (tid < 128) { const float sq = part[0] + part[2], sk = part[1] + part[3];
        qv[tid] = qkv[0] * rsq_f(sq + EPS) * 0.08838834764831845f; kv[tid] = qkv[1] * rsq_f(sk + EPS); vv[tid] = qkv[2]; }
    __syncthreads();
    f32x4 pk = {0.f, 0.f, 0.f, 0.f}, pq = {0.f, 0.f, 0.f, 0.f};
#pragma unroll
    for (int i = 0; i < 8; ++i) { const int row = wave * 16 + 2 * i + half; pk += kv[row] * sr[i]; pq += qv[row] * sr[i]; }
#pragma unroll
    for (int e = 0; e < 4; ++e) { pk[e] += __shfl_xor(pk[e], 32); pq[e] += __shfl_xor(pq[e], 32); }
    if (lane < 32) { *(LAS f32x4*)(pks + wave * 128 + c4) = pk; *(LAS f32x4*)(pqs + wave * 128 + c4) = pq; }
    const float qk = wave_sum(qv[lane] * kv[lane] + qv[lane + 64] * kv[lane + 64]);
    __syncthreads();
    f32x4 ks = {0.f, 0.f, 0.f, 0.f}, qs = {0.f, 0.f, 0.f, 0.f};
#pragma unroll
    for (int w = 0; w < 8; ++w) { ks += *(const LAS f32x4*)(pks + w * 128 + c4); qs += *(const LAS f32x4*)(pqs + w * 128 + c4); }
    const float beta = sigmoid_f(zbeta);
    const float eg = exp_f(-exp_f(alg) * softplus_f(zalpha + dtbv));
    const f32x4 v4 = *(const LAS f32x4*)(vv + c4);
    const f32x4 u = beta * (v4 - eg * ks);
    const f32x4 o = eg * qs + qk * u;
#pragma unroll
    for (int i = 0; i < 8; ++i) { const int row = wave * 16 + 2 * i + half; *(f32x4*)(so + (size_t)row * 128 + c4) = eg * sr[i] + kv[row] * u; }
    if (wave == 0) {
        float ss = (lane < 32) ? (o.x * o.x + o.y * o.y) + (o.z * o.z + o.w * o.w) : 0.f;
        const float rstd = rsq_f(wave_sum(ss) * (1.f / HD) + EPS);
        if (lane < 32) { const f32x4 g = ongv, gb = gbv;
            u32x2 w; w.x = pk2(o.x * rstd * g.x * silu_f(gb.x), o.y * rstd * g.y * silu_f(gb.y)); w.y = pk2(o.z * rstd * g.z * silu_f(gb.z), o.w * rstd * g.w * silu_f(gb.w));
            *(u32x2*)(P.ycat + (size_t)(MP + bs) * DM + 1024 + h * 128 + c4) = w; }
    }
    __syncthreads();
}

struct Args { const float* in[18]; float* out; unsigned char* ws; };
#define GAS __attribute__((address_space(1)))
struct ArgsG { const GAS float* in[18]; GAS float* out; GAS unsigned char* ws; };
__global__ void __launch_bounds__(512, 2) mega(Args a) {
    extern __shared__ __attribute__((aligned(16))) unsigned char lds_raw[];
    cg::grid_group grid = cg::this_grid();
    LAS unsigned char* lds = (LAS unsigned char*)lds_raw;
    constexpr int G = 256, NGW = G * 8, GT = G * 512;
    const int bx0 = blockIdx.x, wave0 = __builtin_amdgcn_readfirstlane(threadIdx.x >> 6);
    const ArgsG* ap0 = (const ArgsG*)__builtin_amdgcn_kernarg_segment_ptr();
#define FRESH() unsigned m_ = ~0u; asm volatile("" : "+s"(m_)); int tid = (wave0 << 6) | (int)__builtin_amdgcn_mbcnt_hi(m_, __builtin_amdgcn_mbcnt_lo(m_, 0u)); asm volatile("" : "+v"(tid)); FRESH_S(); const int lane = tid & 63, wave = __builtin_amdgcn_readfirstlane(tid >> 6), gw = bx * 8 + wave, gt = bx * 512 + tid; (void)lane; (void)gw; (void)gt
#define FRESH_S() int bx = bx0; const ArgsG* ap = ap0; asm volatile("" : "+s"(bx), "+s"(ap)); unsigned char* ws = (unsigned char*)ap->ws
#define GBAR() do { FRESH_S(); XcdBarrier xb_; xb_.bar = (unsigned*)(ws + WS_CTL); xb_.x = xb_xcc_id(); xb_.st = (volatile LAS unsigned*)(lds + 131072 + 32); xcd_barrier(xb_); } while (0)
#define WSP(T, off) ((T*)(ws + (off)))
    { volatile LAS unsigned* misc = (volatile LAS unsigned*)(lds + 131072); if (threadIdx.x < 32) misc[threadIdx.x] = 0u; __syncthreads();
      (void)xcd_barrier_post((unsigned*)((unsigned char*)ap0->ws + WS_CTL), misc + 8); }
    constexpr int I_IN = 32 * 257, I_OUT = 32 * 64, I_ADA = 32 * 192;
    {
        FRESH();
        LAS float* scr = (LAS float*)(lds + wave * 16384);
#pragma unroll 1
        for (int it = gw; it < 4 * I_ADA; it += NGW) { const int l = it / I_ADA, r = it - l * I_ADA;
            transpose_item(((const float*)ap->in[8]) + (size_t)l * DM * 3 * DM, DM, 3 * DM, WSP(bf16_t, WS_WADA) + (size_t)l * 3 * DM * DM, scr, r, lane); }
        const float* c_prompt = ((const float*)ap->in[5]); const float* c_sample = ((const float*)ap->in[6]); bf16_t* ca = WSP(bf16_t, WS_CA);
        for (int idx = gt; idx < (NB + DECB) * DM; idx += GT) { const int row = idx >> 11, c = idx & 2047;
            const float v = row < NB ? c_prompt[row * DM + c] : c_sample[(row - NB) * DM + c]; ca[idx] = f2bf(silu_f(v)); }
    }
    if (ap0->out == nullptr) grid.sync();
    GBAR();
    {
        FRESH();
        constexpr int NGEMM = MODLD / 256, NIT2 = 4 * (I_IN + I_OUT), N1 = 35000;
        if (bx < NGEMM) {
            pg8::Gemm g{WSP(bf16_t, WS_CA), WSP(bf16_t, WS_WADA), 256, MODLD, DM}; pg8::StaticOrder S; S.init(256, MODLD, G, bx);
            EpiF32Bias E{WSP(float, WS_MOD), MODLD, ((const float*)ap->in[9])};
            pg8::gemm_phase<EpiF32Bias, pg8::StaticOrder, true, true>(lds, g, S, E, tid);
        }
        LAS float* scr = (LAS float*)(lds + wave * 16384);
        const int it0 = bx < NGEMM ? N1 + bx * 8 + wave : (bx - NGEMM) * 8 + wave, itN = bx < NGEMM ? NIT2 : N1, its = bx < NGEMM ? NGEMM * 8 : (G - NGEMM) * 8;
#pragma unroll 1
        for (int it = it0; it < itN; it += its) {
            int r = it;
            if (r < 4 * I_IN) { const int l = r / I_IN; r -= l * I_IN; transpose_item(((const float*)ap->in[10]) + (size_t)l * DM * DIN, DM, DIN, WSP(bf16_t, WS_WIN) + (size_t)l * DINP * DM, scr, r, lane); }
            else { r -= 4 * I_IN; const int l = r / I_OUT; r -= l * I_OUT; transpose_item(((const float*)ap->in[16]) + (size_t)l * DM * DM, DM, DM, WSP(bf16_t, WS_WOUT) + (size_t)l * DM * DM, scr, r, lane); }
        }
    }
    GBAR();
#pragma unroll 1
    for (int l = 0; l < DEPTH; ++l) {
        {
            FRESH();
            float* xcur = WSP(float, WS_X);
            phase_norm(l == 0 ? ((const float*)ap->in[0]) : xcur, l == 0 ? ((const float*)ap->in[1]) : xcur + (size_t)MP * DM, ((const float*)ap->in[7]) + l * DM, WSP(float, WS_MOD) + (size_t)l * 3 * DM, WSP(bf16_t, WS_HB), gw, NGW, lane);
        }
        GBAR();
        {
            FRESH();
            const bf16_t* Wi = WSP(bf16_t, WS_WIN) + (size_t)l * DINP * DM; const bf16_t* hb = WSP(bf16_t, WS_HB);
            {
                pg8::Gemm g{hb, Wi, MP, NZ, DM}; pg8::StaticOrder S; S.init(MP, NZ, G, bx);
                pg8::EpiBf16<0> E{WSP(bf16_t, WS_Z), NZ, nullptr, 0, 0, 1.f};
                pg8::gemm_phase<pg8::EpiBf16<0>, pg8::StaticOrder, true, true>(lds, g, S, E, tid);
            }
            float* zs = WSP(float, WS_ZS); float* ba = WSP(float, WS_BA);
            const int r = lane & 15, q8 = lane >> 4;
#pragma unroll 1
            for (int task = bx; task < NZ / 32; task += G) sample_gemm32(lds, hb + (size_t)MP * DM, Wi + (size_t)task * 32 * DM, zs, DINP, task * 32, tid, lane, wave);
            for (int task = wave * G + bx; task < 8 + MP / 16; task += NGW) {
                if (task < 8) { const int mt = task;
                    const f32x4 acc = skinny16(hb + (size_t)(MP + mt * 16) * DM, DM, Wi + (size_t)NZ * DM, DM, DM, lane);
#pragma unroll
                    for (int j = 0; j < 4; ++j) zs[(size_t)(mt * 16 + q8 * 4 + j) * DINP + NZ + r] = acc[j];
                } else { const int pt = task - 8;
                    const f32x4 acc = skinny16(hb + (size_t)pt * 16 * DM, DM, Wi + (size_t)NZ * DM, DM, DM, lane);
#pragma unroll
                    for (int j = 0; j < 4; ++j) ba[(size_t)(pt * 16 + q8 * 4 + j) * 16 + r] = acc[j];
                }
            }
        }
        GBAR();
        {
            FRESH();
            const bf16_t* z = WSP(bf16_t, WS_Z);
            PrepP P{z, WSP(float, WS_BA), ((const float*)ap->in[12]) + (size_t)l * 4 * 3072, ((const float*)ap->in[13]) + l * NH, ((const float*)ap->in[14]) + l * NH, WSP(unsigned char, WS_TR), WSP(float, WS_GL)};
            prep_weights(lds, P.cw, bx & 7, tid);
#pragma unroll 1
            for (int task = bx; task < NB * 32 * NH; task += G) prep_task(lds, P, task, tid, lane, wave);
        }
        GBAR();
        if (bx0 < 2 * NB * NH) {
            FRESH();
            const int b = bx >> 4, h = (bx >> 1) & 7, half = bx & 1;
            ScanP P{WSP(unsigned char, WS_TR), WSP(float, WS_GL), WSP(float, WS_OB), ((float*)ap->out) + O_SP + ((size_t)(l * NB + b) * NH + h) * HD * HD};
            scan_bh(lds, P, b, h, half, tid, lane, wave);
        } else {
            FRESH();
            SampP P{WSP(float, WS_ZS), ((const float*)ap->in[2]) + (size_t)l * DECB * 2 * 1024, ((const float*)ap->in[3]) + (size_t)l * DECB * 3 * 3072, ((const float*)ap->in[4]) + (size_t)l * DECB * NH * HD * HD, ((const float*)ap->in[11]) + (size_t)l * 3 * 1024,
                    ((const float*)ap->in[12]) + (size_t)l * 4 * 3072, ((const float*)ap->in[13]) + l * NH, ((const float*)ap->in[14]) + l * NH, ((const float*)ap->in[15]) + l * HD, WSP(bf16_t, WS_YCAT), ((float*)ap->out) + O_CAS + (size_t)l * DECB * 2 * 1024,
                    ((float*)ap->out) + O_CQS + (size_t)l * DECB * 3 * 3072, ((float*)ap->out) + O_SS + (size_t)l * DECB * NH * HD * HD};
#pragma unroll 1
            for (int task = bx - 2 * NB * NH; task < DECB * NH; task += G - 2 * NB * NH) sample_task(lds, P, task, tid, lane, wave);
            { constexpr int GT2 = (G - 2 * NB * NH) * 512; const int gt2 = (bx - 2 * NB * NH) * 512 + tid; const bf16_t* z = WSP(bf16_t, WS_Z);
              conva_prompt(z, ((const float*)ap->in[11]) + (size_t)l * 3 * 1024, WSP(bf16_t, WS_YCAT), gt2, GT2);
              conv_states_prompt(z, ((float*)ap->out) + O_CAP + (size_t)l * NB * 2 * 1024, ((float*)ap->out) + O_CQP + (size_t)l * NB * 3 * 3072, gt2, GT2); }
        }
        GBAR();
        {
            FRESH();
            if (wave >= 4) onorm_pass(WSP(float, WS_OB), WSP(bf16_t, WS_Z), ((const float*)ap->in[15]) + l * HD, WSP(bf16_t, WS_YCAT), bx * 4 + (wave - 4), G * 4, lane);
            else {
                const bf16_t* Wo = WSP(bf16_t, WS_WOUT) + (size_t)l * DM * DM; const bf16_t* ycat = WSP(bf16_t, WS_YCAT); float* xcur = WSP(float, WS_X);
                const float* modg = WSP(float, WS_MOD) + (size_t)l * 3 * DM + 2 * DM;
                const int r = lane & 15, q8 = lane >> 4;
                const float* xb = l == 0 ? ((const float*)ap->in[1]) : xcur + (size_t)MP * DM;
                const int task = wave * G + bx, mt = task & 7, nt = task >> 3;
                const f32x4 acc = skinny16(ycat + (size_t)(MP + mt * 16) * DM, DM, Wo + (size_t)nt * 16 * DM, DM, DM, lane);
#pragma unroll
                for (int j = 0; j < 4; ++j) { const int row = mt * 16 + q8 * 4 + j, col = nt * 16 + r;
                    xcur[(size_t)(MP + row) * DM + col] = xb[(size_t)row * DM + col] + modg[(size_t)(NB + row) * MODLD + col] * acc[j]; }
            }
        }
        GBAR();
        {
            FRESH();
            const bf16_t* Wo = WSP(bf16_t, WS_WOUT) + (size_t)l * DM * DM; const bf16_t* ycat = WSP(bf16_t, WS_YCAT); float* xcur = WSP(float, WS_X);
            const float* modg = WSP(float, WS_MOD) + (size_t)l * 3 * DM + 2 * DM;
            {
                pg8::Gemm g{ycat, Wo, MP, DM, DM}; pg8::StaticOrder S; S.init(MP, DM, G, bx);
                EpiResGate E{l == 0 ? ((const float*)ap->in[0]) : xcur, xcur, modg, DM};
                pg8::gemm_phase<EpiResGate, pg8::StaticOrder, true, true>(lds, g, S, E, tid);
            }
        }
        GBAR();
    }
    { FRESH(); phase_final(WSP(float, WS_X), ((const float*)ap->in[17]), ((float*)ap->out), gw, NGW, lane); }
#undef FRESH
#undef GBAR
#undef WSP
}

extern "C" void kernel_launch(void* const* d_in, const int* in_sizes, int n_in, void* d_out, int out_size, void* d_ws, size_t ws_size, hipStream_t stream) {
    static int grid = 0;
    if (!grid) {
        if (n_in != 18 || (size_t)out_size != O_END || ws_size < WS_END) { fprintf(stderr, "kernel_launch: unexpected shapes (n_in %d out %d ws %zu)\n", n_in, out_size, ws_size); grid = -1; return; }
        int dev = 0, cus = 0, per_cu = 0;
        (void)hipGetDevice(&dev);
        (void)hipDeviceGetAttribute(&cus, hipDeviceAttributeMultiprocessorCount, dev);
        (void)hipFuncSetAttribute((const void*)mega, hipFuncAttributeMaxDynamicSharedMemorySize, LDS_BYTES);
        (void)hipOccupancyMaxActiveBlocksPerMultiprocessor(&per_cu, (const void*)mega, 512, LDS_BYTES);
        if (per_cu < 1) per_cu = 1;
        grid = cus * per_cu;
        if (grid != 256) { fprintf(stderr, "kernel_launch: this kernel is built for a 256-workgroup grid (256 CUs x 1), got %d\n", grid); grid = -1; return; }
        fprintf(stderr, "kernel_launch: grid %d (cus %d per_cu %d)\n", grid, cus, per_cu);
    }
    if (grid < 0) return;
    if (hipMemsetAsync((char*)d_ws + WS_CTL, 0, 16384, stream) != hipSuccess) { fprintf(stderr, "kernel_launch: memset of the barrier words failed\n"); return; }
    Args a{};
    for (int i = 0; i < 18; ++i) a.in[i] = (const float*)d_in[i];
    a.out = (float*)d_out; a.ws = (unsigned char*)d_ws;
    void* args[] = {&a};
    hipError_t e = hipLaunchCooperativeKernel((void*)mega, dim3(grid), dim3(512), args, LDS_BYTES, stream);
    if (e != hipSuccess) fprintf(stderr, "cooperative launch failed: %s (grid %d)\n", hipGetErrorString(e), grid);
}
```

```cpp
#include <hip/hip_runtime.h>
#include <hip/hip_cooperative_groups.h>
#include <cstdio>
#include <cstdint>
namespace cg = cooperative_groups;
namespace pg8 {
#define PG8_LAS __attribute__((address_space(3)))
typedef unsigned short bf16_t;
typedef short bf16x8 __attribute__((ext_vector_type(8)));
typedef float f32x4 __attribute__((ext_vector_type(4)));
typedef unsigned u32x4 __attribute__((ext_vector_type(4)));
constexpr int BM = 256, BK = 64, HALF = 128, HTB = HALF * BK * 2  , STAGE_BYTES = 8 * HTB, NXCD = 8, WGM = 8;

__host__ __device__ __forceinline__ int lds_byte(int r, int c) { const int st = (r >> 4) * 2 + (c >> 5), rr = r & 15, cc = c & 31, ob = rr * 64 + cc * 2; return st * 1024 + (ob ^ (((ob >> 9) & 1) << 5)); }
__host__ __device__ __forceinline__ void stage_rc(int b, int& R, int& C) { const int st = b / 1024, sb = b % 1024, swz = sb ^ (((sb >> 9) & 1) << 5); R = (st >> 1) * 16 + swz / 64; C = (st & 1) * 32 + (swz % 64) / 2; }
__host__ __device__ __forceinline__ int perm32(int rho) { const int n = rho >> 4, i = rho & 15; return 8 * (i >> 2) + 4 * n + (i & 3); }

struct Unit { int pm, pn; };
struct Gemm { const bf16_t* A; const bf16_t* Bt; int M, N, K; };

struct StaticOrder {
    int nM, nN, nwg, G, c;
    __host__ __device__ void init(int M, int N, int G_, int c_) { nM = M / BM; nN = N / BM; nwg = nM * nN; G = G_; c = c_; }
    __host__ __device__ bool next(int i, Unit& u) const {
        const long L = (long)i * G + c; if (L >= nwg) return false;
        int wgid = (int)L; { const int q = nwg / NXCD, r = nwg % NXCD, xcd = wgid % NXCD, off = wgid / NXCD; wgid = (xcd < r ? xcd * (q + 1) : r * (q + 1) + (xcd - r) * q) + off; }
        const int nig = WGM * nN, gid = wgid / nig, fm = gid * WGM, gsz = (nM - fm) < WGM ? (nM - fm) : WGM;
        u.pm = fm + ((wgid % nig) % gsz); u.pn = (wgid % nig) / gsz; return true;
    }
    __device__ __forceinline__ void a_ready(const Unit&) const {}
    __device__ __forceinline__ void done(const Unit&) const {}
};

__device__ __forceinline__ unsigned cvt_pk_bf16(float lo, float hi) { unsigned r; asm("v_cvt_pk_bf16_f32 %0, %1, %2" : "=v"(r) : "v"(lo), "v"(hi)); return r; }
typedef float f32x2 __attribute__((ext_vector_type(2)));
__device__ __forceinline__ f32x2 gelu_pk(f32x2 v) {
    const f32x2 av = __builtin_elementwise_abs(v), d = av * 0.2316418882f + 1.0f;
    f32x2 t; t.x = __builtin_amdgcn_rcpf(d.x); t.y = __builtin_amdgcn_rcpf(d.y);
    f32x2 q = t * 0.5307027145f + (-0.7265760135f); q = q * t + 0.7107068705f; q = q * t + (-0.142248368f); q = q * t + 0.127414796f; q = q * t;
    const f32x2 s = (v * v) * (-0.72134752044f);
    f32x2 e; e.x = __builtin_amdgcn_exp2f(s.x); e.y = __builtin_amdgcn_exp2f(s.y);
    const f32x2 m = v * (q * e), r = v - m;
    f32x2 o; o.x = v.x < 0.f ? m.x : r.x; o.y = v.y < 0.f ? m.y : r.y; return o;
}

template <int ACT  > struct EpiBf16 {
    static constexpr bool PERM = true, AFTER_DRAIN = false; static_assert(ACT == 0 || ACT == 1, "EpiBf16: ACT is 0 (none) or 1 (gelu_pk)");
    bf16_t* O; int ldc; const float* bias; int split_cols; size_t split_stride; float scale0;
    __device__ __forceinline__ void operator()(const f32x4 (&acc)[2][2][4][2], const Unit& u, int wr, int wc, int fr, int fq) const {
        const int row0 = u.pm * BM + wr * 64 + fr; int colt = u.pn * BM; bf16_t* base = O;
        float sc = 1.f; if (split_cols) { const int t = colt / split_cols; base += (size_t)t * split_stride; colt -= t * split_cols; if (t == 0) sc = scale0; }
        const int col0 = colt + wc * 32 + 8 * fq, bcol0 = u.pn * BM + wc * 32 + 8 * fq;
        f32x4 bv[2][2];
#pragma unroll
        for (int bj = 0; bj < 2; ++bj)
#pragma unroll
            for (int n = 0; n < 2; ++n) bv[bj][n] = bias ? *(const f32x4*)(bias + bcol0 + bj * HALF + 4 * n) : (f32x4){0.f, 0.f, 0.f, 0.f};
#pragma unroll
        for (int ai = 0; ai < 2; ++ai)
#pragma unroll
            for (int m = 0; m < 4; ++m) { bf16_t* rowp = base + (size_t)(row0 + ai * HALF + m * 16) * ldc + col0;
#pragma unroll
                for (int bj = 0; bj < 2; ++bj) { f32x4 v0 = acc[ai][bj][m][0] + bv[bj][0], v1 = acc[ai][bj][m][1] + bv[bj][1];
                    if (ACT == 1) { f32x2 a = gelu_pk((f32x2){v0[0], v0[1]}), b = gelu_pk((f32x2){v0[2], v0[3]}), c = gelu_pk((f32x2){v1[0], v1[1]}), d = gelu_pk((f32x2){v1[2], v1[3]});
                        v0 = (f32x4){a.x, a.y, b.x, b.y}; v1 = (f32x4){c.x, c.y, d.x, d.y}; }
                    v0 = v0 * sc; v1 = v1 * sc; u32x4 w; w.x = cvt_pk_bf16(v0[0], v0[1]); w.y = cvt_pk_bf16(v0[2], v0[3]); w.z = cvt_pk_bf16(v1[0], v1[1]); w.w = cvt_pk_bf16(v1[2], v1[3]);
                    *(u32x4*)(rowp + bj * HALF) = w; } }
    }
};
template <class Epi, class Sched, bool ALIGN_EPI = false, bool SP2 = false>
__device__ __forceinline__ void gemm_phase(PG8_LAS unsigned char* lds, const Gemm g, const Sched& S, const Epi& E, int tid_in) {
    int tid_ = tid_in; asm volatile("" : "+v"(tid_));
    const int tid = tid_, wid = __builtin_amdgcn_readfirstlane(tid >> 6), lane = tid & 63, wr = wid >> 2, wc = wid & 3, fr = lane & 15, fq = lane >> 4;
    const int K = g.K, nt = K / BK;
    unsigned voffA[2], voffB[2];
#pragma unroll
    for (int i = 0; i < 2; ++i) { int R, C; stage_rc(tid * 16 + i * 8192, R, C); const int Rb = Epi::PERM ? ((R & ~31) + perm32(R & 31)) : R;
        voffA[i] = (unsigned)(R * K + C) * 2u; voffB[i] = (unsigned)(Rb * K + C) * 2u; }
    const size_t kstep = (size_t)(BK * 2);
    const size_t hstep = (size_t)HALF * K * 2;
    const size_t tstep = 2 * hstep;
    const unsigned ldsw = (unsigned)wid * 1024u;
    const int aoff = lds_byte(wr * 64 + fr, fq * 8), boff = lds_byte(wc * 32 + fr, fq * 8);
#define PG8_SA(b, h) (((b) * 2 + (h)) * HTB)
#define PG8_SB(b, h) ((4 + (b) * 2 + (h)) * HTB)
#define PG8_STAGE(bufoff, gbase, voff) do { _Pragma("unroll") for (int _i = 0; _i < 2; ++_i) \
        __builtin_amdgcn_global_load_lds((const unsigned*)((const char*)(gbase) + (voff)[_i]), (PG8_LAS unsigned*)(lds + (bufoff) + ldsw + _i * 8192), 16, 0, 0); } while (0)
#define PG8_LDA(dst, b, h) do { _Pragma("unroll") for (int m = 0; m < 4; ++m) _Pragma("unroll") for (int k = 0; k < 2; ++k) dst[m][k] = *(const PG8_LAS bf16x8*)(lds + PG8_SA(b, h) + aoff + m * 2048 + k * 1024); } while (0)
#define PG8_LDB(dst, b, h) do { _Pragma("unroll") for (int n = 0; n < 2; ++n) _Pragma("unroll") for (int k = 0; k < 2; ++k) dst[n][k] = *(const PG8_LAS bf16x8*)(lds + PG8_SB(b, h) + boff + n * 2048 + k * 1024); } while (0)
#define PG8_MMA(ai, bj, At, Bt) do { __builtin_amdgcn_s_setprio(1); _Pragma("unroll") for (int m = 0; m < 4; ++m) _Pragma("unroll") for (int n = 0; n < 2; ++n) _Pragma("unroll") for (int k = 0; k < 2; ++k) \
        acc[ai][bj][m][n] = __builtin_amdgcn_mfma_f32_16x16x32_bf16(Bt[n][k], At[m][k], acc[ai][bj][m][n], 0, 0, 0); __builtin_amdgcn_s_setprio(0); } while (0)
#define PG8_WAIT_V(n) asm volatile("s_waitcnt vmcnt(" #n ")" ::: "memory")
#define PG8_WAIT_L(n) asm volatile("s_waitcnt lgkmcnt(" #n ")" ::: "memory")
#define PG8_BAR __builtin_amdgcn_s_barrier()
#define PG8_SCHED __builtin_amdgcn_sched_barrier(0)
    Unit cur, nxt; int ui = 0;
    if (!S.next(0, cur)) return;
    f32x4 acc[2][2][4][2];
#pragma unroll
    for (int a = 0; a < 2; ++a)
#pragma unroll
        for (int b = 0; b < 2; ++b)
#pragma unroll
            for (int m = 0; m < 4; ++m)
#pragma unroll
                for (int n = 0; n < 2; ++n) acc[a][b][m][n] = (f32x4){0.f, 0.f, 0.f, 0.f};
    bf16x8 At[4][2], B0[2][2], B1[2][2];
    const char* cA = (const char*)g.A + (size_t)cur.pm * tstep; const char* cB = (const char*)g.Bt + (size_t)cur.pn * tstep;
    S.a_ready(cur);
    if constexpr (SP2) {
        PG8_STAGE(PG8_SB(0, 0), cB, voffB); PG8_STAGE(PG8_SB(0, 1), cB + hstep, voffB); PG8_STAGE(PG8_SA(0, 0), cA, voffA); PG8_STAGE(PG8_SA(0, 1), cA + hstep, voffA);
        if (wr == 1) PG8_BAR;
        PG8_WAIT_V(2); PG8_BAR;
        PG8_STAGE(PG8_SB(1, 0), cB + kstep, voffB); PG8_STAGE(PG8_SA(1, 0), cA + kstep, voffA); PG8_STAGE(PG8_SB(1, 1), cB + hstep + kstep, voffB);
        PG8_WAIT_V(6); PG8_BAR;
    } else {
        PG8_STAGE(PG8_SB(0, 0), cB, voffB); PG8_STAGE(PG8_SA(0, 0), cA, voffA); PG8_STAGE(PG8_SB(0, 1), cB + hstep, voffB); PG8_STAGE(PG8_SA(0, 1), cA + hstep, voffA);
        if (wr == 1) PG8_BAR;
        PG8_WAIT_V(4); PG8_BAR;
        PG8_STAGE(PG8_SB(1, 0), cB + kstep, voffB); PG8_STAGE(PG8_SA(1, 0), cA + kstep, voffA); PG8_STAGE(PG8_SB(1, 1), cB + hstep + kstep, voffB);
        PG8_WAIT_V(6); PG8_BAR;
    }
    for (;;) {
        const bool has_next = S.next(ui + 1, nxt);
        const char* nA = has_next ? (const char*)g.A + (size_t)nxt.pm * tstep : cA; const char* nB = has_next ? (const char*)g.Bt + (size_t)nxt.pn * tstep : cB;
        for (int t = 0; t < nt; t += 2) {
            const bool last = (t == nt - 2);
            const char* a1 = cA + (size_t)(t + 1) * kstep;
            const char* a2 = last ? nA : cA + (size_t)(t + 2) * kstep; const char* b2 = last ? nB : cB + (size_t)(t + 2) * kstep;
            const char* a3 = a2 + kstep; const char* b3 = b2 + kstep;
            if (last && has_next) S.a_ready(nxt);
            if constexpr (SP2) {
            PG8_LDB(B0, 0, 0); PG8_LDB(B1, 0, 1); PG8_SCHED; PG8_LDA(At, 0, 0); PG8_STAGE(PG8_SA(1, 1), a1 + hstep, voffA);
            PG8_WAIT_V(8); PG8_WAIT_L(0); PG8_BAR; PG8_MMA(0, 0, At, B0); PG8_MMA(0, 1, At, B1); PG8_BAR; PG8_SCHED;
            PG8_LDA(At, 0, 1); PG8_STAGE(PG8_SB(0, 0), b2, voffB); PG8_STAGE(PG8_SB(0, 1), b2 + hstep, voffB); PG8_STAGE(PG8_SA(0, 0), a2, voffA);
            PG8_WAIT_V(8); PG8_WAIT_L(0); PG8_BAR; PG8_MMA(1, 0, At, B0); PG8_MMA(1, 1, At, B1); PG8_BAR; PG8_SCHED;
            PG8_LDB(B0, 1, 0); PG8_LDB(B1, 1, 1); PG8_SCHED; PG8_LDA(At, 1, 0); PG8_STAGE(PG8_SA(0, 1), a2 + hstep, voffA);
            PG8_WAIT_V(8); PG8_WAIT_L(0); PG8_BAR; PG8_MMA(0, 0, At, B0); PG8_MMA(0, 1, At, B1); PG8_BAR; PG8_SCHED;
            PG8_LDA(At, 1, 1); PG8_STAGE(PG8_SB(1, 0), b3, voffB); PG8_STAGE(PG8_SB(1, 1), b3 + hstep, voffB); PG8_STAGE(PG8_SA(1, 0), a3, voffA);
            PG8_WAIT_V(8); PG8_WAIT_L(0); PG8_BAR; PG8_MMA(1, 0, At, B0); PG8_MMA(1, 1, At, B1); PG8_BAR; PG8_SCHED;
            } else {
            PG8_LDB(B0, 0, 0); PG8_SCHED; PG8_LDA(At, 0, 0); PG8_STAGE(PG8_SA(1, 1), a1 + hstep, voffA);
            PG8_WAIT_L(8); PG8_BAR; PG8_WAIT_L(0); PG8_MMA(0, 0, At, B0); PG8_BAR; PG8_SCHED;
            PG8_LDB(B1, 0, 1); PG8_STAGE(PG8_SB(0, 0), b2, voffB);
            PG8_BAR; PG8_WAIT_L(0); PG8_MMA(0, 1, At, B1); PG8_BAR;
            PG8_LDA(At, 0, 1); PG8_STAGE(PG8_SA(0, 0), a2, voffA);
            PG8_BAR; PG8_WAIT_L(0); PG8_MMA(1, 0, At, B0); PG8_BAR; PG8_SCHED;
            PG8_STAGE(PG8_SB(0, 1), b2 + hstep, voffB);
            PG8_WAIT_V(6); PG8_BAR; PG8_MMA(1, 1, At, B1); PG8_BAR;
            PG8_LDB(B0, 1, 0); PG8_SCHED; PG8_LDA(At, 1, 0); PG8_STAGE(PG8_SA(0, 1), a2 + hstep, voffA);
            PG8_WAIT_L(8); PG8_BAR; PG8_WAIT_L(0); PG8_MMA(0, 0, At, B0); PG8_BAR; PG8_SCHED;
            PG8_LDB(B1, 1, 1); PG8_STAGE(PG8_SB(1, 0), b3, voffB);
            PG8_BAR; PG8_WAIT_L(0); PG8_MMA(0, 1, At, B1); PG8_BAR;
            PG8_LDA(At, 1, 1); PG8_STAGE(PG8_SA(1, 0), a3, voffA);
            PG8_BAR; PG8_WAIT_L(0); PG8_MMA(1, 0, At, B0); PG8_BAR; PG8_SCHED;
            PG8_STAGE(PG8_SB(1, 1), b3 + hstep, voffB);
            PG8_WAIT_V(6); PG8_BAR; PG8_MMA(1, 1, At, B1); PG8_BAR;
            }
        }
        if constexpr (ALIGN_EPI) { if (wr == 0) PG8_BAR; }
        if constexpr (!Epi::AFTER_DRAIN) { E(acc, cur, wr, wc, fr, fq); S.done(cur); }
        if (!has_next) break;
#pragma unroll
        for (int a = 0; a < 2; ++a)
#pragma unroll
            for (int b = 0; b < 2; ++b)
#pragma unroll
                for (int m = 0; m < 4; ++m)
#pragma unroll
                    for (int n = 0; n < 2; ++n) acc[a][b][m][n] = (f32x4){0.f, 0.f, 0.f, 0.f};
        cur = nxt; cA = nA; cB = nB; ++ui;
        if constexpr (ALIGN_EPI) { if (wr == 1) PG8_BAR; }
    }
    PG8_WAIT_V(0);
    if constexpr (!ALIGN_EPI) { if (wr == 0) PG8_BAR; }
    PG8_BAR;
    if constexpr (Epi::AFTER_DRAIN) { E.fused(acc, cur, wr, wc, fr, fq, lds, wid, lane); S.done(cur); }
#undef PG8_SA
#undef PG8_SB
#undef PG8_STAGE
#undef PG8_LDA
#undef PG8_LDB
#undef PG8_MMA
#undef PG8_WAIT_V
#undef PG8_WAIT_L
#undef PG8_BAR
#undef PG8_SCHED
}
}
#define LAS __attribute__((address_space(3)))
typedef unsigned short bf16_t;
typedef short bf16x8 __attribute__((ext_vector_type(8)));
typedef float f32x4 __attribute__((ext_vector_type(4)));
typedef unsigned u32x4 __attribute__((ext_vector_type(4)));
typedef unsigned u32x2 __attribute__((ext_vector_type(2)));

constexpr int DM = 2048, NB = 4, SEQ = 2048, DEPTH = 4, DECB = 128, MP = NB * SEQ, MT = MP + DECB;
constexpr int NH = 8, HD = 128, DIN = 8208, DINP = 8224, NZ = 8192, MODLD = DEPTH * 3 * DM;
constexpr float EPS = 1e-6f;
constexpr size_t MiB = 1u << 20;
constexpr size_t WS_WIN = 0, WS_WOUT = 130 * MiB, WS_WADA = 162 * MiB, WS_CA = 258 * MiB, WS_MOD = 259 * MiB, WS_HB = 283 * MiB, WS_Z = 316 * MiB,
                 WS_ZS = 444 * MiB, WS_BA = 449 * MiB, WS_X = 450 * MiB, WS_YCAT = 515 * MiB, WS_TR = 548 * MiB, WS_GL = 652 * MiB, WS_CTL = 653 * MiB, WS_OB = 654 * MiB, WS_END = 686 * MiB;
constexpr size_t TR_W = 0, TR_Q = 16384, TR_A = 32768, TR_K = 40960, TR_G = 57344, TR_U = 73728, TR_SZ = 106496;
constexpr int LDS_BYTES = 147456;
constexpr size_t O_YP = 0, O_YS = O_YP + (size_t)MP * DM, O_CAP = O_YS + (size_t)DECB * DM, O_CQP = O_CAP + (size_t)DEPTH * NB * 2 * 1024,
                 O_SP = O_CQP + (size_t)DEPTH * NB * 3 * 3072, O_CAS = O_SP + (size_t)DEPTH * NB * NH * HD * HD, O_CQS = O_CAS + (size_t)DEPTH * DECB * 2 * 1024,
                 O_SS = O_CQS + (size_t)DEPTH * DECB * 3 * 3072, O_END = O_SS + (size_t)DEPTH * DECB * NH * HD * HD;

__device__ __forceinline__ float bflo(unsigned w) { return __uint_as_float(w << 16); }
__device__ __forceinline__ float bfhi(unsigned w) { return __uint_as_float(w & 0xffff0000u); }
__device__ __forceinline__ float bf2f(bf16_t h) { return __uint_as_float((unsigned)h << 16); }
__device__ __forceinline__ unsigned pk2(float lo, float hi) { return pg8::cvt_pk_bf16(lo, hi); }
__device__ __forceinline__ bf16_t f2bf(float f) { return (bf16_t)(pk2(f, 0.f) & 0xffffu); }
__device__ __forceinline__ float rcp_f(float x) { return __builtin_amdgcn_rcpf(x); }
__device__ __forceinline__ float rsq_f(float x) { return __builtin_amdgcn_rsqf(x); }
__device__ __forceinline__ float exp_f(float x) { return __builtin_amdgcn_exp2f(x * 1.4426950408889634f); }
__device__ __forceinline__ float silu_f(float x) { return x * rcp_f(1.f + exp_f(-x)); }
__device__ __forceinline__ float sigmoid_f(float x) { return rcp_f(1.f + exp_f(-x)); }
__device__ __forceinline__ float softplus_f(float x) { return fmaxf(x, 0.f) + __logf(1.f + exp_f(-fabsf(x))); }
__device__ __forceinline__ float wave_sum(float v) {
#pragma unroll
    for (int o = 1; o < 64; o <<= 1) v += __shfl_xor(v, o);
    return v;
}
__device__ __forceinline__ float wave_sum2(float v, int lane) {
    v += __builtin_bit_cast(float, __builtin_amdgcn_update_dpp(0, __builtin_bit_cast(int, v), 0xB1, 0xF, 0xF, true));
    v += __builtin_bit_cast(float, __builtin_amdgcn_update_dpp(0, __builtin_bit_cast(int, v), 0x4E, 0xF, 0xF, true));
    v += __builtin_bit_cast(float, __builtin_amdgcn_update_dpp(0, __builtin_bit_cast(int, v), 0x141, 0xF, 0xF, true));
    v += __builtin_bit_cast(float, __builtin_amdgcn_update_dpp(0, __builtin_bit_cast(int, v), 0x140, 0xF, 0xF, true));
    v += __builtin_bit_cast(float, __builtin_amdgcn_ds_bpermute((lane ^ 16) << 2, __builtin_bit_cast(int, v)));
    v += __builtin_bit_cast(float, __builtin_amdgcn_ds_bpermute((lane ^ 32) << 2, __builtin_bit_cast(int, v)));
    return v;
}
#define LBAR() do { asm volatile("s_waitcnt lgkmcnt(0)" ::: "memory"); __builtin_amdgcn_s_barrier(); asm volatile("" ::: "memory"); } while (0)
#define LDS_WAIT() asm volatile("s_waitcnt lgkmcnt(0)" ::: "memory")

struct EpiF32Bias {
    static constexpr bool PERM = false, AFTER_DRAIN = false;
    float* out; int ldc; const float* bias;
    __device__ __forceinline__ void operator()(const f32x4 (&acc)[2][2][4][2], const pg8::Unit& u, int wr, int wc, int fr, int fq) const {
        const int row0 = u.pm * 256 + wr * 64 + fr, col0 = u.pn * 256 + wc * 32 + 4 * fq;
#pragma unroll
        for (int ai = 0; ai < 2; ++ai)
#pragma unroll
            for (int m = 0; m < 4; ++m) { const size_t off = (size_t)(row0 + ai * 128 + m * 16) * ldc + col0;
#pragma unroll
                for (int bj = 0; bj < 2; ++bj)
#pragma unroll
                    for (int n = 0; n < 2; ++n) { const f32x4 bv = *(const f32x4*)(bias + col0 + bj * 128 + n * 16); *(f32x4*)(out + off + bj * 128 + n * 16) = acc[ai][bj][m][n] + bv; }
                asm volatile("" ::: "memory"); }
    }
};
struct EpiResGate {
    static constexpr bool PERM = false, AFTER_DRAIN = false;
    const float* base; float* out; const float* gate; int ldc;
    __device__ __forceinline__ void operator()(const f32x4 (&acc)[2][2][4][2], const pg8::Unit& u, int wr, int wc, int fr, int fq) const {
        const int row0 = u.pm * 256 + wr * 64 + fr, col0 = u.pn * 256 + wc * 32 + 4 * fq;
        const float* gp = gate + (size_t)((u.pm * 256) / SEQ) * MODLD + col0;
        f32x4 gv[2][2];
#pragma unroll
        for (int bj = 0; bj < 2; ++bj)
#pragma unroll
            for (int n = 0; n < 2; ++n) gv[bj][n] = *(const f32x4*)(gp + bj * 128 + n * 16);
#pragma unroll
        for (int ai = 0; ai < 2; ++ai)
#pragma unroll
            for (int m = 0; m < 4; ++m) { const size_t off = (size_t)(row0 + ai * 128 + m * 16) * ldc + col0;
#pragma unroll
                for (int bj = 0; bj < 2; ++bj)
#pragma unroll
                    for (int n = 0; n < 2; ++n) { const f32x4 b = *(const f32x4*)(base + off + bj * 128 + n * 16); *(f32x4*)(out + off + bj * 128 + n * 16) = b + gv[bj][n] * acc[ai][bj][m][n]; }
                asm volatile("" ::: "memory"); }
    }
};

__device__ __forceinline__ f32x4 skinny16(const bf16_t* A, int lda, const bf16_t* Bt, int ldb, int K, int lane) {
    const int r = lane & 15, q = lane >> 4;
    const bf16x8* ap = (const bf16x8*)(A + (size_t)r * lda + q * 8);
    const bf16x8* bp = (const bf16x8*)(Bt + (size_t)r * ldb + q * 8);
    f32x4 acc0 = {0.f, 0.f, 0.f, 0.f}, acc1 = {0.f, 0.f, 0.f, 0.f};
#pragma unroll 1
    for (int k = 0; k < K / 32; k += 16) {
        bf16x8 a[16], b[16];
#pragma unroll
        for (int i = 0; i < 16; ++i) { a[i] = ap[(k + i) * 4]; b[i] = bp[(k + i) * 4]; }
#pragma unroll
        for (int i = 0; i < 16; i += 2) { acc0 = __builtin_amdgcn_mfma_f32_16x16x32_bf16(a[i], b[i], acc0, 0, 0, 0); acc1 = __builtin_amdgcn_mfma_f32_16x16x32_bf16(a[i + 1], b[i + 1], acc1, 0, 0, 0); }
    }
    return acc0 + acc1;
}


__device__ __forceinline__ void sample_gemm32(LAS unsigned char* lds, const bf16_t* A, const bf16_t* Bt, float* out, int ldo, int n0, int tid, int lane, int wave) {
    constexpr int CK = 512, BS = CK + 8, BUFB = 32 * BS * 2, NC = DM / CK;
    const int r = lane & 15, q8 = lane >> 4;
    const bf16_t* ap = A + (size_t)(wave * 16 + r) * DM + q8 * 8;
    const bf16_t* bp = Bt + (size_t)(tid >> 6) * DM + (tid & 63) * 8;
    const unsigned bw = (unsigned)((tid >> 6) * BS + (tid & 63) * 8) * 2u;
    f32x4 acc[2] = {{0.f, 0.f, 0.f, 0.f}, {0.f, 0.f, 0.f, 0.f}};
    bf16x8 fa[16], fn[16]; u32x4 sb[4];
#define SG_LA(c, d) do { _Pragma("unroll") for (int ks = 0; ks < 16; ++ks) d[ks] = *(const bf16x8*)(ap + (c) * CK + ks * 32); } while (0)
#define SG_LB(c) do { _Pragma("unroll") for (int i = 0; i < 4; ++i) sb[i] = *(const u32x4*)(bp + (size_t)(8 * i) * DM + (c) * CK); } while (0)
#define SG_SB(bufp) do { _Pragma("unroll") for (int i = 0; i < 4; ++i) *(LAS u32x4*)((bufp) + bw + (unsigned)(8 * i * BS * 2)) = sb[i]; } while (0)
    SG_LB(0); SG_LA(0, fa);
    SG_SB(lds);
    SG_LB(1);
    __syncthreads();
#define SG_MM(f_, c_) do { const LAS bf16_t* Bl = (const LAS bf16_t*)(lds + ((c_) & 1) * BUFB); \
        _Pragma("unroll") for (int ks = 0; ks < 16; ++ks) { \
            const bf16x8 b0 = *(const LAS bf16x8*)(Bl + r * BS + ks * 32 + q8 * 8), b1 = *(const LAS bf16x8*)(Bl + (16 + r) * BS + ks * 32 + q8 * 8); \
            acc[0] = __builtin_amdgcn_mfma_f32_16x16x32_bf16(f_[ks], b0, acc[0], 0, 0, 0); acc[1] = __builtin_amdgcn_mfma_f32_16x16x32_bf16(f_[ks], b1, acc[1], 0, 0, 0); } } while (0)
#pragma unroll 1
    for (int c = 0; c < NC; c += 2) {
        SG_LA(c + 1, fn);
        SG_MM(fa, c);
        SG_SB(lds + ((c + 1) & 1) * BUFB);
        if (c + 2 < NC) SG_LB(c + 2);
        LBAR();
        if (c + 2 < NC) SG_LA(c + 2, fa);
        SG_MM(fn, c + 1);
        if (c + 2 < NC) SG_SB(lds + ((c + 2) & 1) * BUFB);
        if (c + 3 < NC) SG_LB(c + 3);
        LBAR();
    }
#undef SG_MM
#undef SG_LA
#undef SG_LB
#undef SG_SB
#pragma unroll
    for (int nt = 0; nt < 2; ++nt)
#pragma unroll
        for (int j = 0; j < 4; ++j) out[(size_t)(wave * 16 + q8 * 4 + j) * ldo + n0 + nt * 16 + r] = acc[nt][j];
}

__device__ __forceinline__ void transpose_item(const float* W, int K, int N, bf16_t* WT, LAS float* scr, int item, int lane) {
    const int nblk = (N + 31) / 32, kb = item / nblk, nb = item % nblk, k0 = 64 * kb, n0 = 32 * nb;
    const int nn = n0 + (lane & 31); const bool ok = nn < N;
    float v[32];
#pragma unroll
    for (int i = 0; i < 32; ++i) { const int kk = 2 * i + (lane >> 5); v[i] = ok ? W[(size_t)(k0 + kk) * N + nn] : 0.f; }
#pragma unroll
    for (int i = 0; i < 32; ++i) { const int kk = 2 * i + (lane >> 5); scr[kk * 33 + (lane & 31)] = v[i]; }
    LDS_WAIT(); asm volatile("" ::: "memory");
    const int c = lane & 7;
#pragma unroll
    for (int j = 0; j < 4; ++j) { const int n = (lane >> 3) + 8 * j; const LAS float* s = scr + (8 * c) * 33 + n;
        u32x4 o; o.x = pk2(s[0 * 33], s[1 * 33]); o.y = pk2(s[2 * 33], s[3 * 33]); o.z = pk2(s[4 * 33], s[5 * 33]); o.w = pk2(s[6 * 33], s[7 * 33]);
        *(u32x4*)(WT + (size_t)(n0 + n) * K + k0 + 8 * c) = o; }
    LDS_WAIT(); asm volatile("" ::: "memory");
}

#define RLX_AGENT __ATOMIC_RELAXED, __HIP_MEMORY_SCOPE_AGENT
#define XB_TMO      128
#define XB_XCNT(j)  (256  + 64 * (j))
#define XB_XSUB(j)  (1280 + 64 * (j))
#define XB_XGEN(j)  (2304 + 64 * (j))
#define XB_TOP      3328
#define XB_TOPGEN   3392
#define XCD_BAR_WORDS 3456
#define XB_SPIN_CAP (1u << 17)

__device__ __forceinline__ unsigned xb_ld(unsigned* p)              { return __hip_atomic_load(p, __ATOMIC_RELAXED, __HIP_MEMORY_SCOPE_AGENT); }
__device__ __forceinline__ unsigned xb_add(unsigned* p, unsigned v) { return __hip_atomic_fetch_add(p, v, __ATOMIC_RELAXED, __HIP_MEMORY_SCOPE_AGENT); }
__device__ __forceinline__ unsigned xb_xcc_id() { return (unsigned)__builtin_amdgcn_s_getreg((3 << 11) | 20) & 0xFu; }
#define XB_SPIN(cond, bar) do { unsigned _sp = 0; while (cond) { __builtin_amdgcn_s_sleep(6); \
    if ((++_sp & 255u) == 0u) { if (xb_ld(&(bar)[XB_TMO])) break; if (_sp > XB_SPIN_CAP) { atomicAdd(&(bar)[XB_TMO], 1u); break; } } } } while (0)

struct XcdBarrier {
    unsigned* bar; unsigned x;
    volatile LAS unsigned* st;
};

__device__ __forceinline__ XcdBarrier xcd_barrier_post(unsigned* bar, volatile LAS unsigned* st) {
    XcdBarrier b; b.bar = bar; b.x = xb_xcc_id(); b.st = st;
    if (threadIdx.x == 0) (void)xb_add(&bar[XB_XCNT(b.x)], 1u);
    return b;
}
__device__ __forceinline__ void xcd_barrier_complete(unsigned* bar, unsigned x, unsigned& nloc, unsigned& nx) {
    const unsigned G = gridDim.x * gridDim.y * gridDim.z;
    unsigned sum, cnt, mine, sp = 0u;
    for (;;) {
        sum = 0u; cnt = 0u; mine = 0u;
#pragma unroll
        for (unsigned j = 0; j < 16; ++j) { const unsigned c = xb_ld(&bar[XB_XCNT(j)]); sum += c; cnt += (c > 0u) ? 1u : 0u; mine = (j == x) ? c : mine; }
        if (sum == G) break;
        __builtin_amdgcn_s_sleep(6);
        if ((++sp & 255u) == 0u) { if (xb_ld(&bar[XB_TMO])) break; if (sp > XB_SPIN_CAP) { atomicAdd(&bar[XB_TMO], 1u); break; } }
    }
    nloc = mine > 0u ? mine : 1u; nx = cnt > 0u ? cnt : 1u;
}

__device__ __forceinline__ void xcd_barrier(const XcdBarrier& b) {
    asm volatile("s_waitcnt vmcnt(0)" ::: "memory");
    __syncthreads();
    if (threadIdx.x == 0) {
        unsigned* bar = b.bar;
        __builtin_amdgcn_s_waitcnt(0);
        unsigned nloc = b.st[0], nx = b.st[1];
        if (nloc == 0u) { xcd_barrier_complete(bar, b.x, nloc, nx); b.st[0] = nloc; b.st[1] = nx; }
        const unsigned old = xb_add(&bar[XB_XSUB(b.x)], 1u);
        const unsigned gen = old / nloc;
        if (old + 1u == (gen + 1u) * nloc) {
            __builtin_amdgcn_fence(__ATOMIC_RELEASE, "agent");
            asm volatile("s_waitcnt vmcnt(0)" ::: "memory");
            const unsigned og = xb_add(&bar[XB_TOP], 1u);
            const unsigned tg = og / nx;
            if (og + 1u == (tg + 1u) * nx) xb_add(&bar[XB_TOPGEN], 1u);
            else XB_SPIN(xb_ld(&bar[XB_TOPGEN]) == tg, bar);
            __builtin_amdgcn_fence(__ATOMIC_ACQUIRE, "agent");
            xb_add(&bar[XB_XGEN(b.x)], 1u);
            asm volatile("s_waitcnt vmcnt(0)" ::: "memory");
        } else {
            XB_SPIN(xb_ld(&bar[XB_XGEN(b.x)]) == gen, bar);
            __builtin_amdgcn_fence(__ATOMIC_ACQUIRE, "agent");
            asm volatile("s_waitcnt vmcnt(0)" ::: "memory");
        }
    }
    __syncthreads();
}

__device__ __forceinline__ void phase_norm(const float* xp, const float* xs, const float* ng, const float* modl, bf16_t* hb, int gw, int NGW, int lane) {
    {
        const int row0 = gw * 4, mrow = row0 / SEQ;
        const float* sh = modl + (size_t)mrow * MODLD; const float* sc = sh + DM;
        f32x4 gg[8], ss0[8];
#pragma unroll
        for (int j = 0; j < 8; ++j) { const int c4 = lane + 64 * j; gg[j] = ((const f32x4*)ng)[c4] * (1.f + ((const f32x4*)sc)[c4]); ss0[j] = ((const f32x4*)sh)[c4]; }
#pragma unroll
        for (int k = 0; k < 4; ++k) {
            f32x4 v[8]; float ss = 0.f;
#pragma unroll
            for (int j = 0; j < 8; ++j) { v[j] = ((const f32x4*)(xp + (size_t)(row0 + k) * DM))[lane + 64 * j]; ss += (v[j].x * v[j].x + v[j].y * v[j].y) + (v[j].z * v[j].z + v[j].w * v[j].w); }
            const float rstd = rsq_f(wave_sum2(ss, lane) * (1.f / DM) + EPS);
#pragma unroll
            for (int j = 0; j < 8; ++j) { const int c4 = lane + 64 * j; const f32x4 h = v[j] * rstd * gg[j] + ss0[j]; u32x2 o; o.x = pk2(h.x, h.y); o.y = pk2(h.z, h.w); *(u32x2*)(hb + (size_t)(row0 + k) * DM + c4 * 4) = o; }
        }
    }
    for (int rs = gw; rs < DECB; rs += NGW) {
        const int row = MP + rs; const float* xr = xs + (size_t)rs * DM;
        const float* sh = modl + (size_t)(NB + rs) * MODLD; const float* sc = sh + DM;
        f32x4 v[8]; float ss = 0.f;
#pragma unroll
        for (int j = 0; j < 8; ++j) { v[j] = ((const f32x4*)xr)[lane + 64 * j]; ss += (v[j].x * v[j].x + v[j].y * v[j].y) + (v[j].z * v[j].z + v[j].w * v[j].w); }
        const float rstd = rsq_f(wave_sum2(ss, lane) * (1.f / DM) + EPS);
#pragma unroll
        for (int j = 0; j < 8; ++j) { const int c4 = lane + 64 * j; const f32x4 g = ((const f32x4*)ng)[c4], s1 = ((const f32x4*)sc)[c4], s0 = ((const f32x4*)sh)[c4];
            const f32x4 h = v[j] * rstd * g * (1.f + s1) + s0; u32x2 o; o.x = pk2(h.x, h.y); o.y = pk2(h.z, h.w); *(u32x2*)(hb + (size_t)row * DM + c4 * 4) = o; }
    }
}
__device__ __forceinline__ void final_row(const f32x4 (&v)[8], const f32x4 (&g)[8], float* orow, int lane) {
    float ss = 0.f;
#pragma unroll
    for (int j = 0; j < 8; ++j) ss += (v[j].x * v[j].x + v[j].y * v[j].y) + (v[j].z * v[j].z + v[j].w * v[j].w);
    const float rstd = rsq_f(wave_sum(ss) * (1.f / DM) + EPS);
#pragma unroll
    for (int j = 0; j < 8; ++j) ((f32x4*)orow)[lane + 64 * j] = v[j] * rstd * g[j];
}
__device__ __forceinline__ void phase_final(const float* x, const float* g, float* out, int gw, int NGW, int lane) {
    f32x4 gg[8];
#pragma unroll
    for (int j = 0; j < 8; ++j) gg[j] = ((const f32x4*)g)[lane + 64 * j];
    const int row0 = gw * 4;
    f32x4 v[8], w[8];
#pragma unroll
    for (int j = 0; j < 8; ++j) v[j] = ((const f32x4*)(x + (size_t)row0 * DM))[lane + 64 * j];
#pragma unroll
    for (int k = 0; k < 4; ++k) {
        if (k < 3) {
#pragma unroll
            for (int j = 0; j < 8; ++j) w[j] = ((const f32x4*)(x + (size_t)(row0 + k + 1) * DM))[lane + 64 * j];
        }
        final_row(v, gg, out + (size_t)(row0 + k) * DM, lane);
#pragma unroll
        for (int j = 0; j < 8; ++j) v[j] = w[j];
    }
    for (int row = MP + gw; row < MT; row += NGW) {
#pragma unroll
        for (int j = 0; j < 8; ++j) v[j] = ((const f32x4*)(x + (size_t)row * DM))[lane + 64 * j];
        final_row(v, gg, out + (size_t)row * DM, lane);
    }
}

template <int I, int C> __device__ __forceinline__ void s2_load(const LAS float* Ll, f32x4 (&lr)[16]) {
    if constexpr (4 * C < I) { lr[C] = *(const LAS f32x4*)(Ll + I * 64 + 4 * C); s2_load<I, C + 1>(Ll, lr); }
}
template <int I, int C> __device__ __forceinline__ void s2_fma(const f32x4 (&lr)[16], const float (&Xc)[64], float& a0, float& a1, float& a2, float& a3) {
    if constexpr (4 * C < I) {
        a0 += lr[C].x * Xc[4 * C];
        if constexpr (4 * C + 1 < I) a1 += lr[C].y * Xc[4 * C + 1];
        if constexpr (4 * C + 2 < I) a2 += lr[C].z * Xc[4 * C + 2];
        if constexpr (4 * C + 3 < I) a3 += lr[C].w * Xc[4 * C + 3];
        s2_fma<I, C + 1>(lr, Xc, a0, a1, a2, a3);
    }
}
template <int I> __device__ __forceinline__ void s2_row(const LAS float* Ll, float (&Xc)[64], int lane) {
    if constexpr (I < 64) {
        float a0 = Ll[I * 64 + lane], a1 = 0.f, a2 = 0.f, a3 = 0.f;
        f32x4 lr[16];
        s2_load<I, 0>(Ll, lr);
        s2_fma<I, 0>(lr, Xc, a0, a1, a2, a3);
        Xc[I] = -((a0 + a1) + (a2 + a3));
        asm volatile("" ::: "memory");
        s2_row<I + 1>(Ll, Xc, lane);
    }
}
struct PrepP { const bf16_t* z; const float* ba; const float* cw; const float* alog; const float* dtb; unsigned char* tr; float* gl; };
constexpr int PS = 136, TS = 72;
__device__ __forceinline__ void conv8(const u32x4 (&x)[4], const LAS float* w, float (&o)[8]) {
    f32x4 wa[4], wb[4];
#pragma unroll
    for (int j = 0; j < 4; ++j) { wa[j] = *(const LAS f32x4*)(w + j * 384); wb[j] = *(const LAS f32x4*)(w + j * 384 + 4); }
#pragma unroll
    for (int i = 0; i < 8; ++i) o[i] = 0.f;
#pragma unroll
    for (int j = 0; j < 4; ++j) {
        o[0] += wa[j].x * bflo(x[j].x); o[1] += wa[j].y * bfhi(x[j].x); o[2] += wa[j].z * bflo(x[j].y); o[3] += wa[j].w * bfhi(x[j].y);
        o[4] += wb[j].x * bflo(x[j].z); o[5] += wb[j].y * bfhi(x[j].z); o[6] += wb[j].z * bflo(x[j].w); o[7] += wb[j].w * bfhi(x[j].w); }
#pragma unroll
    for (int i = 0; i < 8; ++i) o[i] = silu_f(o[i]);
}
__device__ __forceinline__ u32x4 pack8(const float* v) { u32x4 o; o.x = pk2(v[0], v[1]); o.y = pk2(v[2], v[3]); o.z = pk2(v[4], v[5]); o.w = pk2(v[6], v[7]); return o; }
__device__ __forceinline__ void prep_weights(LAS unsigned char* lds, const float* cqw, int h, int tid) {
    LAS float* wl = (LAS float*)(lds + 114688);
#pragma unroll
    for (int i = 0; i < 3; ++i) { const int idx = tid + 512 * i, j = idx / 384, rem = idx - j * 384, m = rem >> 7, c = rem & 127; wl[idx] = cqw[j * 3072 + m * 1024 + h * 128 + c]; }
}
__device__ __forceinline__ void prep_task(LAS unsigned char* lds, const PrepP& P, int task, int tid, int lane, int wave) {
    asm volatile("" : "+v"(tid));
    lane = tid & 63;
    unsigned lb = 0; asm volatile("" : "+v"(lb)); lds += (lb & ~15u);
    const int h = task & 7, n = (task >> 3) & 31, b = task >> 8;
    const int row0 = b * SEQ + n * 64;
    unsigned char* trp = P.tr + (size_t)task * TR_SZ;
    LAS bf16_t* Kl = (LAS bf16_t*)lds; LAS bf16_t* Ql = Kl + 64 * PS; LAS bf16_t* Vl = Ql + 64 * PS; LAS bf16_t* KBl = Vl + 64 * PS; LAS bf16_t* KTl = KBl + 64 * PS;
    LAS float* Ll = (LAS float*)(lds + 5 * 64 * PS * 2);
    LAS bf16_t* Tl = (LAS bf16_t*)(lds + 5 * 64 * PS * 2 + 16384);
    LAS float* gcl = (LAS float*)(lds + 5 * 64 * PS * 2 + 16384 + 64 * TS * 2);
    const int r = lane & 15, q8 = lane >> 4;
    if (wave == 0) {
        const float* bar = P.ba + (size_t)(row0 + lane) * 16;
        float g = -exp_f(P.alog[h]) * softplus_f(bar[8 + h] + P.dtb[h]);
#pragma unroll
        for (int o = 1; o < 64; o <<= 1) { const float v = __shfl_up(g, o); if (lane >= o) g += v; }
        gcl[lane] = g; gcl[64 + lane] = sigmoid_f(bar[h]);
        if (lane == 63) P.gl[task] = exp_f(g);
    }
    __syncthreads();
    {
        const int t = tid >> 3, seg = tid & 7;
        const float beta = gcl[64 + t], gc = gcl[t], glc = gcl[63];
        const float eg = exp_f(gc), et = exp_f(glc - gc);
        const int tt = n * 64 + t;
        const bf16_t* zr = P.z + (size_t)(row0 + t) * NZ + 4096 + h * 128 + seg * 16;
        const LAS float* cw = (const LAS float*)(lds + 114688) + seg * 16;
        u32x4 xz[3][2][4];
#pragma unroll
        for (int m = 0; m < 3; ++m)
#pragma unroll
            for (int hf = 0; hf < 2; ++hf)
#pragma unroll
                for (int j = 0; j < 4; ++j) { const bool ok = tt - 3 + j >= 0; xz[m][hf][j] = *(const u32x4*)(zr + m * 1024 + hf * 8 + (ptrdiff_t)(ok ? j - 3 : 0) * NZ); if (!ok) xz[m][hf][j] = (u32x4){0u, 0u, 0u, 0u}; }
        const int lo = t * PS + seg * 16;
        float x[16], y[16];
        { float o[8]; conv8(xz[2][0], cw + 256, o);
#pragma unroll
          for (int i = 0; i < 8; ++i) x[i] = o[i] * beta;
          conv8(xz[2][1], cw + 256 + 8, o);
#pragma unroll
          for (int i = 0; i < 8; ++i) x[8 + i] = o[i] * beta; }
        *(LAS u32x4*)(Vl + lo) = pack8(x); *(LAS u32x4*)(Vl + lo + 8) = pack8(x + 8);
        asm volatile("" ::: "memory");
        { float o[8]; conv8(xz[1][0], cw + 128, o);
#pragma unroll
          for (int i = 0; i < 8; ++i) x[i] = o[i];
          conv8(xz[1][1], cw + 128 + 8, o);
#pragma unroll
          for (int i = 0; i < 8; ++i) x[8 + i] = o[i]; }
        { float sk = 0.f;
#pragma unroll
          for (int i = 0; i < 16; ++i) sk += x[i] * x[i];
          sk += __shfl_xor(sk, 1); sk += __shfl_xor(sk, 2); sk += __shfl_xor(sk, 4);
          const float rk = rsq_f(sk + EPS);
#pragma unroll
          for (int i = 0; i < 16; ++i) x[i] *= rk; }
        *(LAS u32x4*)(Kl + lo) = pack8(x); *(LAS u32x4*)(Kl + lo + 8) = pack8(x + 8);
#pragma unroll
        for (int i = 0; i < 16; ++i) y[i] = x[i] * (beta * eg);
        *(LAS u32x4*)(KBl + lo) = pack8(y); *(LAS u32x4*)(KBl + lo + 8) = pack8(y + 8);
#pragma unroll
        for (int i = 0; i < 16; ++i) y[i] = x[i] * et;
        *(LAS u32x4*)(KTl + lo) = pack8(y); *(LAS u32x4*)(KTl + lo + 8) = pack8(y + 8);
        asm volatile("" ::: "memory");
        { float o[8]; conv8(xz[0][0], cw, o);
#pragma unroll
          for (int i = 0; i < 8; ++i) x[i] = o[i];
          conv8(xz[0][1], cw + 8, o);
#pragma unroll
          for (int i = 0; i < 8; ++i) x[8 + i] = o[i]; }
        { float sq = 0.f;
#pragma unroll
          for (int i = 0; i < 16; ++i) sq += x[i] * x[i];
          sq += __shfl_xor(sq, 1); sq += __shfl_xor(sq, 2); sq += __shfl_xor(sq, 4);
          const float rq = rsq_f(sq + EPS) * 0.08838834764831845f;
#pragma unroll
          for (int i = 0; i < 16; ++i) x[i] *= rq; }
        *(LAS u32x4*)(Ql + lo) = pack8(x); *(LAS u32x4*)(Ql + lo + 8) = pack8(x + 8);
#pragma unroll
        for (int i = 0; i < 16; ++i) y[i] = x[i] * eg;
        bf16_t* qo = (bf16_t*)(trp + TR_Q) + t * 128 + seg * 16;
        *(u32x4*)qo = pack8(y); *(u32x4*)(qo + 8) = pack8(y + 8);
    }
    __syncthreads();
    {
        const int it = wave >> 1, jt0 = (wave & 1) * 2;
        bf16x8 aK[4], aQ[4];
#pragma unroll
        for (int ks = 0; ks < 4; ++ks) { aK[ks] = *(const LAS bf16x8*)(Kl + (it * 16 + r) * PS + ks * 32 + q8 * 8); aQ[ks] = *(const LAS bf16x8*)(Ql + (it * 16 + r) * PS + ks * 32 + q8 * 8); }
#pragma unroll
        for (int jj = 0; jj < 2; ++jj) {
            const int jt = jt0 + jj;
            bf16_t* ap = (bf16_t*)(trp + TR_A) + (it * 16 + r) * 64 + jt * 16 + q8 * 4;
            if (jt > it) { *(u32x2*)ap = (u32x2){lb, lb};
#pragma unroll
                for (int j = 0; j < 4; ++j) Ll[(it * 16 + q8 * 4 + j) * 64 + jt * 16 + r] = 0.f;
                continue; }
            f32x4 accL = {0.f, 0.f, 0.f, 0.f}, accA = {0.f, 0.f, 0.f, 0.f};
#pragma unroll
            for (int ks = 0; ks < 4; ++ks) { const bf16x8 bK = *(const LAS bf16x8*)(Kl + (jt * 16 + r) * PS + ks * 32 + q8 * 8);
                accL = __builtin_amdgcn_mfma_f32_16x16x32_bf16(aK[ks], bK, accL, 0, 0, 0);
                accA = __builtin_amdgcn_mfma_f32_16x16x32_bf16(bK, aQ[ks], accA, 0, 0, 0); }
            float av[4];
#pragma unroll
            for (int j = 0; j < 4; ++j) {
                { const int i = it * 16 + q8 * 4 + j, jx = jt * 16 + r; const float e = exp_f(gcl[i] - gcl[jx]) * gcl[64 + i] * accL[j]; Ll[i * 64 + jx] = (i > jx) ? e : 0.f; }
                { const int i = it * 16 + r, jx = jt * 16 + q8 * 4 + j; const float e = exp_f(gcl[i] - gcl[jx]) * accA[j]; av[j] = (i >= jx) ? e : 0.f; } }
            u32x2 o; o.x = pk2(av[0], av[1]); o.y = pk2(av[2], av[3]); *(u32x2*)ap = o;
        }
    }
    __syncthreads();
    if (wave == 0) {
        float Xc[64];
        s2_row<0>(Ll, Xc, lane);
#pragma unroll
        for (int i = 0; i < 64; ++i) Tl[i * TS + lane] = f2bf(Xc[i]);
        asm volatile("s_waitcnt lgkmcnt(0)" ::: "memory");
        Tl[lane * TS + lane] = (bf16_t)0x3F80u;
    }
    __syncthreads();
    {
        const int c0 = wave * 16;
        bf16x8 bv[2], bk[2];
#pragma unroll
        for (int ks = 0; ks < 2; ++ks)
#pragma unroll
            for (int j = 0; j < 8; ++j) { const int tok = ks * 32 + q8 * 8 + j; bv[ks][j] = (short)Vl[tok * PS + c0 + r]; bk[ks][j] = (short)KBl[tok * PS + c0 + r]; }
#pragma unroll
        for (int mt = 0; mt < 4; ++mt) {
            f32x4 aU = {0.f, 0.f, 0.f, 0.f}, aW = {0.f, 0.f, 0.f, 0.f};
#pragma unroll
            for (int ks = 0; ks < 2; ++ks) { if (ks == 1 && mt < 2) continue;
                const bf16x8 aT = *(const LAS bf16x8*)(Tl + (mt * 16 + r) * TS + ks * 32 + q8 * 8);
                aU = __builtin_amdgcn_mfma_f32_16x16x32_bf16(aT, bv[ks], aU, 0, 0, 0);
                aW = __builtin_amdgcn_mfma_f32_16x16x32_bf16(bk[ks], aT, aW, 0, 0, 0); }
            *(f32x4*)((float*)(trp + TR_U) + ((wave * 4 + mt) * 64 + lane) * 4) = aU;
            u32x2 o; o.x = pk2(-aW[0], -aW[1]); o.y = pk2(-aW[2], -aW[3]);
            *(u32x2*)((bf16_t*)(trp + TR_W) + (mt * 16 + r) * 128 + c0 + q8 * 4) = o;
        }
#pragma unroll
        for (int ii = 0; ii < 2; ++ii) { const int item = tid + 512 * ii, dk = item & 127, oct = item >> 7; float kv[8];
#pragma unroll
            for (int j = 0; j < 8; ++j) kv[j] = bf2f(KTl[(oct * 8 + j) * PS + dk]);
            *(u32x4*)((bf16_t*)(trp + TR_K) + dk * 64 + oct * 8) = pack8(kv); }
    }
    __syncthreads();
}
__device__ __forceinline__ void conva_prompt(const bf16_t* z, const float* caw, bf16_t* ycat, int gt, int GT) {
#pragma unroll 2
    for (int idx = gt; idx < MP * 128; idx += GT) {
        const int row = idx >> 7, c8 = (idx & 127) * 8, t = row & (SEQ - 1);
        const bf16_t* zr = z + (size_t)row * NZ + c8;
        float conv[8];
#pragma unroll
        for (int i = 0; i < 8; ++i) conv[i] = 0.f;
#pragma unroll
        for (int j = 0; j < 3; ++j) {
            const bool ok = t - 2 + j >= 0; const ptrdiff_t ro = (ptrdiff_t)(ok ? j - 2 : 0) * NZ;
            u32x4 c = *(const u32x4*)(zr + ro + 1024); const u32x4 hh = *(const u32x4*)(zr + ro + 2048);
            if (!ok) c = (u32x4){0u, 0u, 0u, 0u};
            const f32x4 w0 = *(const f32x4*)(caw + j * 1024 + c8), w1 = *(const f32x4*)(caw + j * 1024 + c8 + 4);
            conv[0] += w0.x * (bflo(c.x) * bflo(hh.x)); conv[1] += w0.y * (bfhi(c.x) * bfhi(hh.x)); conv[2] += w0.z * (bflo(c.y) * bflo(hh.y)); conv[3] += w0.w * (bfhi(c.y) * bfhi(hh.y));
            conv[4] += w1.x * (bflo(c.z) * bflo(hh.z)); conv[5] += w1.y * (bfhi(c.z) * bfhi(hh.z)); conv[6] += w1.z * (bflo(c.w) * bflo(hh.w)); conv[7] += w1.w * (bfhi(c.w) * bfhi(hh.w));
        }
        const u32x4 bb = *(const u32x4*)zr, gg = *(const u32x4*)(zr + 3072);
        float y[8];
        y[0] = bflo(bb.x) * conv[0] * silu_f(bflo(gg.x)); y[1] = bfhi(bb.x) * conv[1] * silu_f(bfhi(gg.x)); y[2] = bflo(bb.y) * conv[2] * silu_f(bflo(gg.y)); y[3] = bfhi(bb.y) * conv[3] * silu_f(bfhi(gg.y));
        y[4] = bflo(bb.z) * conv[4] * silu_f(bflo(gg.z)); y[5] = bfhi(bb.z) * conv[5] * silu_f(bfhi(gg.z)); y[6] = bflo(bb.w) * conv[6] * silu_f(bflo(gg.w)); y[7] = bfhi(bb.w) * conv[7] * silu_f(bfhi(gg.w));
        *(u32x4*)(ycat + (size_t)row * DM + c8) = pack8(y);
    }
}
__device__ __forceinline__ void conv_states_prompt(const bf16_t* z, float* oca, float* ocq, int gt, int GT) {
    for (int idx = gt; idx < NB * 2 * 1024; idx += GT) { const int c = idx & 1023, j = (idx >> 10) & 1, b = idx >> 11;
        const bf16_t* zr = z + (size_t)(b * SEQ + SEQ - 2 + j) * NZ; oca[idx] = bf2f(zr[1024 + c]) * bf2f(zr[2048 + c]); }
    for (int idx = gt; idx < NB * 3 * 3072; idx += GT) { const int c = (int)((unsigned)idx % 3072u), j = (int)((unsigned)idx / 3072u) % 3, b = (int)((unsigned)idx / 9216u);
        ocq[idx] = bf2f(z[(size_t)(b * SEQ + SEQ - 3 + j) * NZ + 4096 + c]); }
}

struct ScanP { const unsigned char* tr; const float* gl; float* obuf; float* sout; };
constexpr int SB_W = 0, SB_Q = 64 * PS * 2, SB_A = 2 * 64 * PS * 2, SB_K = SB_A + 64 * TS * 2, SB_SZ = SB_K + 128 * TS * 2;
static_assert(2 * SB_SZ <= 131072, "scan LDS");
__device__ __forceinline__ bf16x8 frag1(const LAS bf16_t* p) { return *(const LAS bf16x8*)p; }
__device__ __forceinline__ bf16x8 packB(const f32x4& a, const f32x4& b) { u32x4 v = {pk2(a[0], a[1]), pk2(a[2], a[3]), pk2(b[0], b[1]), pk2(b[2], b[3])}; return __builtin_bit_cast(bf16x8, v); }
__device__ __forceinline__ void scan_bh(LAS unsigned char* lds, const ScanP& P, int b, int h, int half, int tid, int lane, int wave) {
    const bool cw = wave < 4;
    const int r = lane & 15, q8 = lane >> 4, ct = half * 4 + (wave & 3), c0 = ct * 16;
    if (!cw) {
        const int lt = tid - 256, wrow = lt >> 4, wc16 = lt & 15, arow = lt >> 3, ac16 = lt & 7;
        const int wperm = (wc16 >> 2) * 32 + ((((wc16 & 3) * 8) & 15) >> 2) * 8 + (((wc16 & 3) * 8) >> 4) * 4, aperm = (ac16 >> 2) * 32 + ((((ac16 & 3) * 8) & 15) >> 2) * 8 + (((ac16 & 3) * 8) >> 4) * 4;
        const unsigned oW = (unsigned)TR_W + (unsigned)(wrow * 128 + wc16 * 8) * 2u, oQ = oW + (unsigned)(TR_Q - TR_W), oA = (unsigned)TR_A + (unsigned)(arow * 64 + ac16 * 8) * 2u, oK = oA + (unsigned)(TR_K - TR_A);
        const unsigned lW = (unsigned)(wrow * PS + wperm) * 2u, lA = (unsigned)(arow * TS + aperm) * 2u;
        u32x4 sa[14], sb[14];
#define L_LOAD(nn, d) do { const unsigned char* tr_ = P.tr + (size_t)((b << 8) | ((nn) << 3) | h) * TR_SZ; \
            _Pragma("unroll") for (int i = 0; i < 4; ++i) { d[i] = *(const u32x4*)(tr_ + (oW + 4096u * i)); d[4 + i] = *(const u32x4*)(tr_ + (oQ + 4096u * i)); d[10 + i] = *(const u32x4*)(tr_ + (oK + 4096u * i)); } \
            d[8] = *(const u32x4*)(tr_ + oA); d[9] = *(const u32x4*)(tr_ + (oA + 4096u)); } while (0)
#define ST2(base, boff, v) do { *(LAS u32x2*)((base) + (boff)) = (u32x2){(v).x, (v).y}; *(LAS u32x2*)((base) + (boff) + 16u) = (u32x2){(v).z, (v).w}; } while (0)
#define L_STORE(bufp, s_) do { LAS unsigned char* bp_ = (bufp); \
            _Pragma("unroll") for (int i = 0; i < 4; ++i) { ST2(bp_ + SB_W, lW + (unsigned)(16 * PS * 2 * i), s_[i]); ST2(bp_ + SB_Q, lW + (unsigned)(16 * PS * 2 * i), s_[4 + i]); ST2(bp_ + SB_K, lA + (unsigned)(32 * TS * 2 * i), s_[10 + i]); } \
            ST2(bp_ + SB_A, lA, s_[8]); ST2(bp_ + SB_A, lA + (unsigned)(32 * TS * 2), s_[9]); } while (0)
        L_LOAD(0, sa); L_STORE(lds, sa); L_LOAD(1, sa);
        __syncthreads();
#pragma unroll 1
        for (int n = 0; n < 32; n += 2) {
            if (n + 2 < 32) L_LOAD(n + 2, sb);
            L_STORE(lds + ((n + 1) & 1) * SB_SZ, sa);
            LBAR();
            if (n + 3 < 32) L_LOAD(n + 3, sa);
            if (n + 2 < 32) L_STORE(lds + ((n + 2) & 1) * SB_SZ, sb);
            LBAR();
        }
#undef L_LOAD
#undef L_STORE
#undef ST2
    } else {
        f32x4 S[8];
#pragma unroll
        for (int i = 0; i < 8; ++i) S[i] = (f32x4){0.f, 0.f, 0.f, 0.f};
        const float glv = (lane < 32) ? P.gl[(b << 8) | (lane << 3) | h] : 0.f;
        f32x4 ubn[4];
        const unsigned oU = (unsigned)TR_U + (unsigned)(ct * 256 + lane) * 16u;
#define U_LOAD(nn) do { const unsigned char* tr_ = P.tr + (size_t)((b << 8) | ((nn) << 3) | h) * TR_SZ; \
            _Pragma("unroll") for (int mt_ = 0; mt_ < 4; ++mt_) ubn[mt_] = *(const f32x4*)(tr_ + (oU + (unsigned)mt_ * 1024u)); } while (0)
        U_LOAD(0);
        __syncthreads();
#pragma unroll 1
        for (int n = 0; n < 32; ++n) {
            LAS unsigned char* buf = lds + (n & 1) * SB_SZ;
            const LAS bf16_t* Wl = (const LAS bf16_t*)(buf + SB_W); const LAS bf16_t* Ql = (const LAS bf16_t*)(buf + SB_Q);
            const LAS bf16_t* Al = (const LAS bf16_t*)(buf + SB_A); const LAS bf16_t* Kl = (const LAS bf16_t*)(buf + SB_K);
            f32x4 u[4], o[4];
#pragma unroll
            for (int mt = 0; mt < 4; ++mt) { u[mt] = ubn[mt]; o[mt] = (f32x4){0.f, 0.f, 0.f, 0.f}; }
            if (n + 1 < 32) U_LOAD(n + 1);
        bf16x8 Sb[4];
#pragma unroll
        for (int ks = 0; ks < 4; ++ks) Sb[ks] = packB(S[2 * ks], S[2 * ks + 1]);
#define SBAR() __builtin_amdgcn_sched_barrier(0)
#define LD4(d, base, mt, stride) do { _Pragma("unroll") for (int ks = 0; ks < 4; ++ks) d[ks] = frag1((base) + ((mt) * 16 + r) * (stride) + ks * 32 + q8 * 8); } while (0)
#define MM4(acc, s_) do { _Pragma("unroll") for (int ks = 0; ks < 4; ++ks) acc = __builtin_amdgcn_mfma_f32_16x16x32_bf16(s_[ks], Sb[ks], acc, 0, 0, 0); } while (0)
        {
            bf16x8 fA[4], fB[4];
            LD4(fA, Wl, 0, PS); SBAR(); LD4(fB, Ql, 0, PS); SBAR();
            MM4(u[0], fA); SBAR(); LD4(fA, Wl, 1, PS); SBAR(); MM4(o[0], fB); SBAR(); LD4(fB, Ql, 1, PS); SBAR();
            MM4(u[1], fA); SBAR(); LD4(fA, Wl, 2, PS); SBAR(); MM4(o[1], fB); SBAR(); LD4(fB, Ql, 2, PS); SBAR();
            MM4(u[2], fA); SBAR(); LD4(fA, Wl, 3, PS); SBAR(); MM4(o[2], fB); SBAR(); LD4(fB, Ql, 3, PS); SBAR();
            MM4(u[3], fA); SBAR(); MM4(o[3], fB); SBAR();
        }
        bf16x8 Ub[2];
        Ub[0] = packB(u[0], u[1]); Ub[1] = packB(u[2], u[3]);
        const float gl = __shfl(glv, n);
#define LDK(d, dt0) do { d[0] = frag1(Kl + ((dt0) * 16 + r) * TS + q8 * 8); d[1] = frag1(Kl + ((dt0) * 16 + r) * TS + 32 + q8 * 8); d[2] = frag1(Kl + (((dt0) + 1) * 16 + r) * TS + q8 * 8); d[3] = frag1(Kl + (((dt0) + 1) * 16 + r) * TS + 32 + q8 * 8); } while (0)
#define MMK(s_, dt0) do { S[dt0] = S[dt0] * gl; S[(dt0) + 1] = S[(dt0) + 1] * gl; \
            S[dt0] = __builtin_amdgcn_mfma_f32_16x16x32_bf16(s_[0], Ub[0], S[dt0], 0, 0, 0); S[(dt0) + 1] = __builtin_amdgcn_mfma_f32_16x16x32_bf16(s_[2], Ub[0], S[(dt0) + 1], 0, 0, 0); \
            S[dt0] = __builtin_amdgcn_mfma_f32_16x16x32_bf16(s_[1], Ub[1], S[dt0], 0, 0, 0); S[(dt0) + 1] = __builtin_amdgcn_mfma_f32_16x16x32_bf16(s_[3], Ub[1], S[(dt0) + 1], 0, 0, 0); } while (0)
        {
            bf16x8 aA[6], kA[4], kB[4];
            aA[0] = frag1(Al + (0 * 16 + r) * TS + q8 * 8); aA[1] = frag1(Al + (1 * 16 + r) * TS + q8 * 8);
            aA[2] = frag1(Al + (2 * 16 + r) * TS + q8 * 8); aA[3] = frag1(Al + (2 * 16 + r) * TS + 32 + q8 * 8);
            aA[4] = frag1(Al + (3 * 16 + r) * TS + q8 * 8); aA[5] = frag1(Al + (3 * 16 + r) * TS + 32 + q8 * 8);
            SBAR(); LDK(kA, 0); SBAR();
            o[0] = __builtin_amdgcn_mfma_f32_16x16x32_bf16(aA[0], Ub[0], o[0], 0, 0, 0); o[1] = __builtin_amdgcn_mfma_f32_16x16x32_bf16(aA[1], Ub[0], o[1], 0, 0, 0);
            o[2] = __builtin_amdgcn_mfma_f32_16x16x32_bf16(aA[2], Ub[0], o[2], 0, 0, 0); o[3] = __builtin_amdgcn_mfma_f32_16x16x32_bf16(aA[4], Ub[0], o[3], 0, 0, 0);
            o[2] = __builtin_amdgcn_mfma_f32_16x16x32_bf16(aA[3], Ub[1], o[2], 0, 0, 0); o[3] = __builtin_amdgcn_mfma_f32_16x16x32_bf16(aA[5], Ub[1], o[3], 0, 0, 0);
            SBAR(); LDK(kB, 2); SBAR(); MMK(kA, 0); SBAR(); LDK(kA, 4); SBAR(); MMK(kB, 2); SBAR(); LDK(kB, 6); SBAR(); MMK(kA, 4); SBAR(); MMK(kB, 6); SBAR();
        }
#undef LD4
#undef MM4
#undef LDK
#undef MMK
#undef SBAR
        { unsigned oO = (unsigned)((q8 * 4) * 1024 + c0 + r) * 4u; asm volatile("" : "+v"(oO));
          unsigned char* ob = (unsigned char*)(P.obuf + (size_t)(b * SEQ + n * 64) * 1024 + h * 128);
#pragma unroll
          for (int mt = 0; mt < 4; ++mt)
#pragma unroll
              for (int j = 0; j < 4; ++j) *(float*)(ob + (oO + (unsigned)(mt * 16 + j) * 4096u)) = o[mt][j]; }
            LBAR();
        }
#undef U_LOAD
#pragma unroll
        for (int dt = 0; dt < 8; ++dt)
#pragma unroll
            for (int j = 0; j < 4; ++j) P.sout[(size_t)(dt * 16 + q8 * 4 + j) * HD + c0 + r] = S[dt][j];
    }
    __syncthreads();
}
__device__ __forceinline__ void onorm_pass(const float* obuf, const bf16_t* z, const float* ong, bf16_t* ycat, int gw, int NGW, int lane) {
    const int cl = (lane & 7) * 16;
    f32x4 g[4];
#pragma unroll
    for (int i = 0; i < 4; ++i) g[i] = *(const f32x4*)(ong + cl + 4 * i);
#pragma unroll 2
    for (int row = gw; row < MP; row += NGW) {
        const float* op = obuf + (size_t)row * 1024 + lane * 16; const bf16_t* zp = z + (size_t)row * NZ + 7168 + lane * 16;
        f32x4 v[4]; float ss = 0.f;
#pragma unroll
        for (int i = 0; i < 4; ++i) { v[i] = *(const f32x4*)(op + 4 * i); ss += (v[i].x * v[i].x + v[i].y * v[i].y) + (v[i].z * v[i].z + v[i].w * v[i].w); }
        const u32x4 g0 = *(const u32x4*)zp, g1 = *(const u32x4*)(zp + 8);
        ss += __builtin_bit_cast(float, __builtin_amdgcn_update_dpp(0, __builtin_bit_cast(int, ss), 0xB1, 0xF, 0xF, true));
        ss += __builtin_bit_cast(float, __builtin_amdgcn_update_dpp(0, __builtin_bit_cast(int, ss), 0x4E, 0xF, 0xF, true));
        ss += __builtin_bit_cast(float, __builtin_amdgcn_update_dpp(0, __builtin_bit_cast(int, ss), 0x141, 0xF, 0xF, true));
        const float rstd = rsq_f(ss * (1.f / HD) + EPS);
        float y[16];
        y[0] = v[0].x * rstd * g[0].x * silu_f(bflo(g0.x)); y[1] = v[0].y * rstd * g[0].y * silu_f(bfhi(g0.x)); y[2] = v[0].z * rstd * g[0].z * silu_f(bflo(g0.y)); y[3] = v[0].w * rstd * g[0].w * silu_f(bfhi(g0.y));
        y[4] = v[1].x * rstd * g[1].x * silu_f(bflo(g0.z)); y[5] = v[1].y * rstd * g[1].y * silu_f(bfhi(g0.z)); y[6] = v[1].z * rstd * g[1].z * silu_f(bflo(g0.w)); y[7] = v[1].w * rstd * g[1].w * silu_f(bfhi(g0.w));
        y[8] = v[2].x * rstd * g[2].x * silu_f(bflo(g1.x)); y[9] = v[2].y * rstd * g[2].y * silu_f(bfhi(g1.x)); y[10] = v[2].z * rstd * g[2].z * silu_f(bflo(g1.y)); y[11] = v[2].w * rstd * g[2].w * silu_f(bfhi(g1.y));
        y[12] = v[3].x * rstd * g[3].x * silu_f(bflo(g1.z)); y[13] = v[3].y * rstd * g[3].y * silu_f(bfhi(g1.z)); y[14] = v[3].z * rstd * g[3].z * silu_f(bflo(g1.w)); y[15] = v[3].w * rstd * g[3].w * silu_f(bfhi(g1.w));
        bf16_t* yp = ycat + (size_t)row * DM + 1024 + lane * 16;
        *(u32x4*)yp = pack8(y); *(u32x4*)(yp + 8) = pack8(y + 8);
    }
}
struct SampP { const float* zs; const float* sca; const float* scq; const float* s0; const float* caw; const float* cqw; const float* alog; const float* dtb; const float* ong;
               bf16_t* ycat; float* oca; float* ocq; float* oss; };
__device__ __forceinline__ void sample_task(LAS unsigned char* lds, const SampP& P, int task, int tid, int lane, int wave) {
    const int h = task & 7, bs = task >> 3;
    LAS float* qv = (LAS float*)lds; LAS float* kv = qv + 128; LAS float* vv = kv + 128; LAS float* part = vv + 128; LAS float* pks = part + 16; LAS float* pqs = pks + 1024;
    const float* s0 = P.s0 + (size_t)(bs * 8 + h) * 16384; float* so = P.oss + (size_t)(bs * 8 + h) * 16384;
    const int half = lane >> 5, c4 = (lane & 31) * 4;
    f32x4 sr[8];
#pragma unroll
    for (int i = 0; i < 8; ++i) sr[i] = *(const f32x4*)(s0 + (size_t)(wave * 16 + 2 * i + half) * 128 + c4);
    const float* zr = P.zs + (size_t)bs * DINP;
    const float zbeta = zr[8192 + h], zalpha = zr[8200 + h], alg = P.alog[h], dtbv = P.dtb[h];
    f32x4 ongv = {0.f, 0.f, 0.f, 0.f}, gbv = {0.f, 0.f, 0.f, 0.f};
    if (wave == 0 && lane < 32) { ongv = *(const f32x4*)(P.ong + c4); gbv = *(const f32x4*)(zr + 7168 + h * 128 + c4); }
    float qkv[3] = {0.f, 0.f, 0.f};
    if (tid < 128) {
        const int cc = h * 128 + tid;
        { const float ch = zr[1024 + cc] * zr[2048 + cc]; const float s0a = P.sca[(bs * 2 + 0) * 1024 + cc], s1a = P.sca[(bs * 2 + 1) * 1024 + cc];
          const float conv = P.caw[cc] * s0a + P.caw[1024 + cc] * s1a + P.caw[2048 + cc] * ch;
          P.ycat[(size_t)(MP + bs) * DM + cc] = f2bf(zr[cc] * conv * silu_f(zr[3072 + cc]));
          P.oca[(bs * 2 + 0) * 1024 + cc] = s1a; P.oca[(bs * 2 + 1) * 1024 + cc] = ch; }
#pragma unroll
        for (int m = 0; m < 3; ++m) { const int c3 = m * 1024 + cc; const float pre = zr[4096 + c3];
            const float a0 = P.scq[(bs * 3 + 0) * 3072 + c3], a1 = P.scq[(bs * 3 + 1) * 3072 + c3], a2 = P.scq[(bs * 3 + 2) * 3072 + c3];
            qkv[m] = silu_f(P.cqw[c3] * a0 + P.cqw[3072 + c3] * a1 + P.cqw[2 * 3072 + c3] * a2 + P.cqw[3 * 3072 + c3] * pre);
            P.ocq[(bs * 3 + 0) * 3072 + c3] = a1; P.ocq[(bs * 3 + 1) * 3072 + c3] = a2; P.ocq[(bs * 3 + 2) * 3072 + c3] = pre; }
        const float sq = wave_sum(qkv[0] * qkv[0]), sk = wave_sum(qkv[1] * qkv[1]);
        if (lane == 0) { part[wave * 2] = sq; part[wave * 2 + 1] = sk; }
    }
    __syncthreads();
    if (tid < 128) { const float sq = part[0] + part[2], sk = part[1] + part[3];
        qv[tid] = qkv[0] * rsq_f(sq + EPS) * 0.08838834764831845f; kv[tid] = qkv[1] * rsq_f(sk + EPS); vv[tid] = qkv[2]; }
    __syncthreads();
    f32x4 pk = {0.f, 0.f, 0.f, 0.f}, pq = {0.f, 0.f, 0.f, 0.f};
#pragma unroll
    for (int i = 0; i < 8; ++i) { const int row = wave * 16 + 2 * i + half; pk += kv[row] * sr[i]; pq += qv[row] * sr[i]; }
#pragma unroll
    for (int e = 0; e < 4; ++e) { pk[e] += __shfl_xor(pk[e], 32); pq[e] += __shfl_xor(pq[e], 32); }
    if (lane < 32) { *(LAS f32x4*)(pks + wave * 128 + c4) = pk; *(LAS f32x4*)(pqs + wave * 128 + c4) = pq; }
    const float qk = wave_sum(qv[lane] * kv[lane] + qv[lane + 64] * kv[lane + 64]);
    __syncthreads();
    f32x4 ks = {0.f, 0.f, 0.f, 0.f}, qs = {0.f, 0.f, 0.f, 0.f};
#pragma unroll
    for (int w = 0; w < 8; ++w) { ks += *(const LAS f32x4*)(pks + w * 128 + c4); qs += *(const LAS f32x4*)(pqs + w * 128 + c4); }
    const float beta = sigmoid_f(zbeta);
    const float eg = exp_f(-exp_f(alg) * softplus_f(zalpha + dtbv));
    const f32x4 v4 = *(const LAS f32x4*)(vv + c4);
    const f32x4 u = beta * (v4 - eg * ks);
    const f32x4 o = eg * qs + qk * u;
#pragma unroll
    for (int i = 0; i < 8; ++i) { const int row = wave * 16 + 2 * i + half; *(f32x4*)(so + (size_t)row * 128 + c4) = eg * sr[i] + kv[row] * u; }
    if (wave == 0) {
        float ss = (lane < 32) ? (o.x * o.x + o.y * o.y) + (o.z * o.z + o.w * o.w) : 0.f;
        const float rstd = rsq_f(wave_sum(ss) * (1.f / HD) + EPS);
        if (lane < 32) { const f32x4 g = ongv, gb = gbv;
            u32x2 w; w.x = pk2(o.x * rstd * g.x * silu_f(gb.x), o.y * rstd * g.y * silu_f(gb.y)); w.y = pk2(o.z * rstd * g.z * silu_f(gb.z), o.w * rstd * g.w * silu_f(gb.w));
            *(u32x2*)(P.ycat + (size_t)(MP + bs) * DM + 1024 + h * 128 + c4) = w; }
    }
    __syncthreads();
}

struct Args { const float* in[18]; float* out; unsigned char* ws; };
#define GAS __attribute__((address_space(1)))
struct ArgsG { const GAS float* in[18]; GAS float* out; GAS unsigned char* ws; };
__global__ void __launch_bounds__(512, 2) mega(Args a) {
    extern __shared__ __attribute__((aligned(16))) unsigned char lds_raw[];
    cg::grid_group grid = cg::this_grid();
    LAS unsigned char* lds = (LAS unsigned char*)lds_raw;
    constexpr int G = 256, NGW = G * 8, GT = G * 512;
    const int bx0 = blockIdx.x, wave0 = __builtin_amdgcn_readfirstlane(threadIdx.x >> 6);
    const ArgsG* ap0 = (const ArgsG*)__builtin_amdgcn_kernarg_segment_ptr();
#define FRESH() unsigned m_ = ~0u; asm volatile("" : "+s"(m_)); int tid = (wave0 << 6) | (int)__builtin_amdgcn_mbcnt_hi(m_, __builtin_amdgcn_mbcnt_lo(m_, 0u)); asm volatile("" : "+v"(tid)); FRESH_S(); const int lane = tid & 63, wave = __builtin_amdgcn_readfirstlane(tid >> 6), gw = bx * 8 + wave, gt = bx * 512 + tid; (void)lane; (void)gw; (void)gt
#define FRESH_S() int bx = bx0; const ArgsG* ap = ap0; asm volatile("" : "+s"(bx), "+s"(ap)); unsigned char* ws = (unsigned char*)ap->ws
#define GBAR() do { FRESH_S(); XcdBarrier xb_; xb_.bar = (unsigned*)(ws + WS_CTL); xb_.x = xb_xcc_id(); xb_.st = (volatile LAS unsigned*)(lds + 131072 + 32); xcd_barrier(xb_); } while (0)
#define WSP(T, off) ((T*)(ws + (off)))
    { volatile LAS unsigned* misc = (volatile LAS unsigned*)(lds + 131072); if (threadIdx.x < 32) misc[threadIdx.x] = 0u; __syncthreads();
      (void)xcd_barrier_post((unsigned*)((unsigned char*)ap0->ws + WS_CTL), misc + 8); }
    constexpr int I_IN = 32 * 257, I_OUT = 32 * 64, I_ADA = 32 * 192;
    {
        FRESH();
        LAS float* scr = (LAS float*)(lds + wave * 16384);
#pragma unroll 1
        for (int it = gw; it < 4 * I_ADA; it += NGW) { const int l = it / I_ADA, r = it - l * I_ADA;
            transpose_item(((const float*)ap->in[8]) + (size_t)l * DM * 3 * DM, DM, 3 * DM, WSP(bf16_t, WS_WADA) + (size_t)l * 3 * DM * DM, scr, r, lane); }
        const float* c_prompt = ((const float*)ap->in[5]); const float* c_sample = ((const float*)ap->in[6]); bf16_t* ca = WSP(bf16_t, WS_CA);
        for (int idx = gt; idx < (NB + DECB) * DM; idx += GT) { const int row = idx >> 11, c = idx & 2047;
            const float v = row < NB ? c_prompt[row * DM + c] : c_sample[(row - NB) * DM + c]; ca[idx] = f2bf(silu_f(v)); }
    }
    if (ap0->out == nullptr) grid.sync();
    GBAR();
    {
        FRESH();
        constexpr int NGEMM = MODLD / 256, NIT2 = 4 * (I_IN + I_OUT), N1 = 35000;
        if (bx < NGEMM) {
            pg8::Gemm g{WSP(bf16_t, WS_CA), WSP(bf16_t, WS_WADA), 256, MODLD, DM}; pg8::StaticOrder S; S.init(256, MODLD, G, bx);
            EpiF32Bias E{WSP(float, WS_MOD), MODLD, ((const float*)ap->in[9])};
            pg8::gemm_phase<EpiF32Bias, pg8::StaticOrder, true, true>(lds, g, S, E, tid);
        }
        LAS float* scr = (LAS float*)(lds + wave * 16384);
        const int it0 = bx < NGEMM ? N1 + bx * 8 + wave : (bx - NGEMM) * 8 + wave, itN = bx < NGEMM ? NIT2 : N1, its = bx < NGEMM ? NGEMM * 8 : (G - NGEMM) * 8;
#pragma unroll 1
        for (int it = it0; it < itN; it += its) {
            int r = it;
            if (r < 4 * I_IN) { const int l = r / I_IN; r -= l * I_IN; transpose_item(((const float*)ap->in[10]) + (size_t)l * DM * DIN, DM, DIN, WSP(bf16_t, WS_WIN) + (size_t)l * DINP * DM, scr, r, lane); }
            else { r -= 4 * I_IN; const int l = r / I_OUT; r -= l * I_OUT; transpose_item(((const float*)ap->in[16]) + (size_t)l * DM * DM, DM, DM, WSP(bf16_t, WS_WOUT) + (size_t)l * DM * DM, scr, r, lane); }
        }
    }
    GBAR();
#pragma unroll 1
    for (int l = 0; l < DEPTH; ++l) {
        {
            FRESH();
            float* xcur = WSP(float, WS_X);
            phase_norm(l == 0 ? ((const float*)ap->in[0]) : xcur, l == 0 ? ((const float*)ap->in[1]) : xcur + (size_t)MP * DM, ((const float*)ap->in[7]) + l * DM, WSP(float, WS_MOD) + (size_t)l * 3 * DM, WSP(bf16_t, WS_HB), gw, NGW, lane);
        }
        GBAR();
        {
            FRESH();
            const bf16_t* Wi = WSP(bf16_t, WS_WIN) + (size_t)l * DINP * DM; const bf16_t* hb = WSP(bf16_t, WS_HB);
            {
                pg8::Gemm g{hb, Wi, MP, NZ, DM}; pg8::StaticOrder S; S.init(MP, NZ, G, bx);
                pg8::EpiBf16<0> E{WSP(bf16_t, WS_Z), NZ, nullptr, 0, 0, 1.f};
                pg8::gemm_phase<pg8::EpiBf16<0>, pg8::StaticOrder, true, true>(lds, g, S, E, tid);
            }
            float* zs = WSP(float, WS_ZS); float* ba = WSP(float, WS_BA);
            const int r = lane & 15, q8 = lane >> 4;
#pragma unroll 1
            for (int task = bx; task < NZ / 32; task += G) sample_gemm32(lds, hb + (size_t)MP * DM, Wi + (size_t)task * 32 * DM, zs, DINP, task * 32, tid, lane, wave);
            for (int task = wave * G + bx; task < 8 + MP / 16; task += NGW) {
                if (task < 8) { const int mt = task;
                    const f32x4 acc = skinny16(hb + (size_t)(MP + mt * 16) * DM, DM, Wi + (size_t)NZ * DM, DM, DM, lane);
#pragma unroll
                    for (int j = 0; j < 4; ++j) zs[(size_t)(mt * 16 + q8 * 4 + j) * DINP + NZ + r] = acc[j];
                } else { const int pt = task - 8;
                    const f32x4 acc = skinny16(hb + (size_t)pt * 16 * DM, DM, Wi + (size_t)NZ * DM, DM, DM, lane);
#pragma unroll
                    for (int j = 0; j < 4; ++j) ba[(size_t)(pt * 16 + q8 * 4 + j) * 16 + r] = acc[j];
                }
            }
        }
        GBAR();
        {
            FRESH();
            const bf16_t* z = WSP(bf16_t, WS_Z);
            PrepP P{z, WSP(float, WS_BA), ((const float*)ap->in[12]) + (size_t)l * 4 * 3072, ((const float*)ap->in[13]) + l * NH, ((const float*)ap->in[14]) + l * NH, WSP(unsigned char, WS_TR), WSP(float, WS_GL)};
            prep_weights(lds, P.cw, bx & 7, tid);
#pragma unroll 1
            for (int task = bx; task < NB * 32 * NH; task += G) prep_task(lds, P, task, tid, lane, wave);
        }
        GBAR();
        if (bx0 < 2 * NB * NH) {
            FRESH();
            const int b = bx >> 4, h = (bx >> 1) & 7, half = bx & 1;
            ScanP P{WSP(unsigned char, WS_TR), WSP(float, WS_GL), WSP(float, WS_OB), ((float*)ap->out) + O_SP + ((size_t)(l * NB + b) * NH + h) * HD * HD};
            scan_bh(lds, P, b, h, half, tid, lane, wave);
        } else {
            FRESH();
            SampP P{WSP(float, WS_ZS), ((const float*)ap->in[2]) + (size_t)l * DECB * 2 * 1024, ((const float*)ap->in[3]) + (size_t)l * DECB * 3 * 3072, ((const float*)ap->in[4]) + (size_t)l * DECB * NH * HD * HD, ((const float*)ap->in[11]) + (size_t)l * 3 * 1024,
                    ((const float*)ap->in[12]) + (size_t)l * 4 * 3072, ((const float*)ap->in[13]) + l * NH, ((const float*)ap->in[14]) + l * NH, ((const float*)ap->in[15]) + l * HD, WSP(bf16_t, WS_YCAT), ((float*)ap->out) + O_CAS + (size_t)l * DECB * 2 * 1024,
                    ((float*)ap->out) + O_CQS + (size_t)l * DECB * 3 * 3072, ((float*)ap->out) + O_SS + (size_t)l * DECB * NH * HD * HD};
#pragma unroll 1
            for (int task = bx - 2 * NB * NH; task < DECB * NH; task += G - 2 * NB * NH) sample_task(lds, P, task, tid, lane, wave);
            { constexpr int GT2 = (G - 2 * NB * NH) * 512; const int gt2 = (bx - 2 * NB * NH) * 512 + tid; const bf16_t* z = WSP(bf16_t, WS_Z);
              conva_prompt(z, ((const float*)ap->in[11]) + (size_t)l * 3 * 1024, WSP(bf16_t, WS_YCAT), gt2, GT2);
              conv_states_prompt(z, ((float*)ap->out) + O_CAP + (size_t)l * NB * 2 * 1024, ((float*)ap->out) + O_CQP + (size_t)l * NB * 3 * 3072, gt2, GT2); }
        }
        GBAR();
        {
            FRESH();
            if (wave >= 4) onorm_pass(WSP(float, WS_OB), WSP(bf16_t, WS_Z), ((const float*)ap->in[15]) + l * HD, WSP(bf16_t, WS_YCAT), bx * 4 + (wave - 4), G * 4, lane);
            else {
                const bf16_t* Wo = WSP(bf16_t, WS_WOUT) + (size_t)l * DM * DM; const bf16_t* ycat = WSP(bf16_t, WS_YCAT); float* xcur = WSP(float, WS_X);
                const float* modg = WSP(float, WS_MOD) + (size_t)l * 3 * DM + 2 * DM;
                const int r = lane & 15, q8 = lane >> 4;
                const float* xb = l == 0 ? ((const float*)ap->in[1]) : xcur + (size_t)MP * DM;
                const int task = wave * G + bx, mt = task & 7, nt = task >> 3;
                const f32x4 acc = skinny16(ycat + (size_t)(MP + mt * 16) * DM, DM, Wo + (size_t)nt * 16 * DM, DM, DM, lane);
#pragma unroll
                for (int j = 0; j < 4; ++j) { const int row = mt * 16 + q8 * 4 + j, col = nt * 16 + r;
                    xcur[(size_t)(MP + row) * DM + col] = xb[(size_t)row * DM + col] + modg[(size_t)(NB + row) * MODLD + col] * acc[j]; }
            }
        }
        GBAR();
        {
            FRESH();
            const bf16_t* Wo = WSP(bf16_t, WS_WOUT) + (size_t)l * DM * DM; const bf16_t* ycat = WSP(bf16_t, WS_YCAT); float* xcur = WSP(float, WS_X);
            const float* modg = WSP(float, WS_MOD) + (size_t)l * 3 * DM + 2 * DM;
            {
                pg8::Gemm g{ycat, Wo, MP, DM, DM}; pg8::StaticOrder S; S.init(MP, DM, G, bx);
                EpiResGate E{l == 0 ? ((const float*)ap->in[0]) : xcur, xcur, modg, DM};
                pg8::gemm_phase<EpiResGate, pg8::StaticOrder, true, true>(lds, g, S, E, tid);
            }
        }
        GBAR();
    }
    { FRESH(); phase_final(WSP(float, WS_X), ((const float*)ap->in[17]), ((float*)ap->out), gw, NGW, lane); }
#undef FRESH
#undef GBAR
#undef WSP
}

extern "C" void kernel_launch(void* const* d_in, const int* in_sizes, int n_in, void* d_out, int out_size, void* d_ws, size_t ws_size, hipStream_t stream) {
    static int grid = 0;
    if (!grid) {
        if (n_in != 18 || (size_t)out_size != O_END || ws_size < WS_END) { fprintf(stderr, "kernel_launch: unexpected shapes (n_in %d out %d ws %zu)\n", n_in, out_size, ws_size); grid = -1; return; }
        int dev = 0, cus = 0, per_cu = 0;
        (void)hipGetDevice(&dev);
        (void)hipDeviceGetAttribute(&cus, hipDeviceAttributeMultiprocessorCount, dev);
        (void)hipFuncSetAttribute((const void*)mega, hipFuncAttributeMaxDynamicSharedMemorySize, LDS_BYTES);
        (void)hipOccupancyMaxActiveBlocksPerMultiprocessor(&per_cu, (const void*)mega, 512, LDS_BYTES);
        if (per_cu < 1) per_cu = 1;
        grid = cus * per_cu;
        if (grid != 256) { fprintf(stderr, "kernel_launch: this kernel is built for a 256-workgroup grid (256 CUs x 1), got %d\n", grid); grid = -1; return; }
        fprintf(stderr, "kernel_launch: grid %d (cus %d per_cu %d)\n", grid, cus, per_cu);
    }
    if (grid < 0) return;
    if (hipMemsetAsync((char*)d_ws + WS_CTL, 0, 16384, stream) != hipSuccess) { fprintf(stderr, "kernel_launch: memset of the barrier words failed\n"); return; }
    Args a{};
    for (int i = 0; i < 18; ++i) a.in[i] = (const float*)d_in[i];
    a.out = (float*)d_out; a.ws = (unsigned char*)d_ws;
    void* args[] = {&a};
    hipError_t e = hipLaunchCooperativeKernel((void*)mega, dim3(grid), dim3(512), args, LDS_BYTES, stream);
    if (e != hipSuccess) fprintf(stderr, "cooperative launch failed: %s (grid %d)\n", hipGetErrorString(e), grid);
}
```

```cpp
#include <hip/hip_runtime.h>
#include <hip/hip_cooperative_groups.h>
#include <cstdio>
#include <cstdint>
namespace cg = cooperative_groups;
namespace pg8 {
#define PG8_LAS __attribute__((address_space(3)))
typedef unsigned short bf16_t;
typedef short bf16x8 __attribute__((ext_vector_type(8)));
typedef float f32x4 __attribute__((ext_vector_type(4)));
typedef unsigned u32x4 __attribute__((ext_vector_type(4)));
constexpr int BM = 256, BK = 64, HALF = 128, HTB = HALF * BK * 2  , STAGE_BYTES = 8 * HTB, NXCD = 8, WGM = 8;

__host__ __device__ __forceinline__ int lds_byte(int r, int c) { const int st = (r >> 4) * 2 + (c >> 5), rr = r & 15, cc = c & 31, ob = rr * 64 + cc * 2; return st * 1024 + (ob ^ (((ob >> 9) & 1) << 5)); }
__host__ __device__ __forceinline__ void stage_rc(int b, int& R, int& C) { const int st = b / 1024, sb = b % 1024, swz = sb ^ (((sb >> 9) & 1) << 5); R = (st >> 1) * 16 + swz / 64; C = (st & 1) * 32 + (swz % 64) / 2; }
__host__ __device__ __forceinline__ int perm32(int rho) { const int n = rho >> 4, i = rho & 15; return 8 * (i >> 2) + 4 * n + (i & 3); }

struct Unit { int pm, pn; };
struct Gemm { const bf16_t* A; const bf16_t* Bt; int M, N, K; };

struct StaticOrder {
    int nM, nN, nwg, G, c;
    __host__ __device__ void init(int M, int N, int G_, int c_) { nM = M / BM; nN = N / BM; nwg = nM * nN; G = G_; c = c_; }
    __host__ __device__ bool next(int i, Unit& u) const {
        const long L = (long)i * G + c; if (L >= nwg) return false;
        int wgid = (int)L; { const int q = nwg / NXCD, r = nwg % NXCD, xcd = wgid % NXCD, off = wgid / NXCD; wgid = (xcd < r ? xcd * (q + 1) : r * (q + 1) + (xcd - r) * q) + off; }
        const int nig = WGM * nN, gid = wgid / nig, fm = gid * WGM, gsz = (nM - fm) < WGM ? (nM - fm) : WGM;
        u.pm = fm + ((wgid % nig) % gsz); u.pn = (wgid % nig) / gsz; return true;
    }
    __device__ __forceinline__ void a_ready(const Unit&) const {}
    __device__ __forceinline__ void done(const Unit&) const {}
};

__device__ __forceinline__ unsigned cvt_pk_bf16(float lo, float hi) { unsigned r; asm("v_cvt_pk_bf16_f32 %0, %1, %2" : "=v"(r) : "v"(lo), "v"(hi)); return r; }
typedef float f32x2 __attribute__((ext_vector_type(2)));
__device__ __forceinline__ f32x2 gelu_pk(f32x2 v) {
    const f32x2 av = __builtin_elementwise_abs(v), d = av * 0.2316418882f + 1.0f;
    f32x2 t; t.x = __builtin_amdgcn_rcpf(d.x); t.y = __builtin_amdgcn_rcpf(d.y);
    f32x2 q = t * 0.5307027145f + (-0.7265760135f); q = q * t + 0.7107068705f; q = q * t + (-0.142248368f); q = q * t + 0.127414796f; q = q * t;
    const f32x2 s = (v * v) * (-0.72134752044f);
    f32x2 e; e.x = __builtin_amdgcn_exp2f(s.x); e.y = __builtin_amdgcn_exp2f(s.y);
    const f32x2 m = v * (q * e), r = v - m;
    f32x2 o; o.x = v.x < 0.f ? m.x : r.x; o.y = v.y < 0.f ? m.y : r.y; return o;
}

template <int ACT  > struct EpiBf16 {
    static constexpr bool PERM = true, AFTER_DRAIN = false; static_assert(ACT == 0 || ACT == 1, "EpiBf16: ACT is 0 (none) or 1 (gelu_pk)");
    bf16_t* O; int ldc; const float* bias; int split_cols; size_t split_stride; float scale0;
    __device__ __forceinline__ void operator()(const f32x4 (&acc)[2][2][4][2], const Unit& u, int wr, int wc, int fr, int fq) const {
        const int row0 = u.pm * BM + wr * 64 + fr; int colt = u.pn * BM; bf16_t* base = O;
        float sc = 1.f; if (split_cols) { const int t = colt / split_cols; base += (size_t)t * split_stride; colt -= t * split_cols; if (t == 0) sc = scale0; }
        const int col0 = colt + wc * 32 + 8 * fq, bcol0 = u.pn * BM + wc * 32 + 8 * fq;
        f32x4 bv[2][2];
#pragma unroll
        for (int bj = 0; bj < 2; ++bj)
#pragma unroll
            for (int n = 0; n < 2; ++n) bv[bj][n] = bias ? *(const f32x4*)(bias + bcol0 + bj * HALF + 4 * n) : (f32x4){0.f, 0.f, 0.f, 0.f};
#pragma unroll
        for (int ai = 0; ai < 2; ++ai)
#pragma unroll
            for (int m = 0; m < 4; ++m) { bf16_t* rowp = base + (size_t)(row0 + ai * HALF + m * 16) * ldc + col0;
#pragma unroll
                for (int bj = 0; bj < 2; ++bj) { f32x4 v0 = acc[ai][bj][m][0] + bv[bj][0], v1 = acc[ai][bj][m][1] + bv[bj][1];
                    if (ACT == 1) { f32x2 a = gelu_pk((f32x2){v0[0], v0[1]}), b = gelu_pk((f32x2){v0[2], v0[3]}), c = gelu_pk((f32x2){v1[0], v1[1]}), d = gelu_pk((f32x2){v1[2], v1[3]});
                        v0 = (f32x4){a.x, a.y, b.x, b.y}; v1 = (f32x4){c.x, c.y, d.x, d.y}; }
                    v0 = v0 * sc; v1 = v1 * sc; u32x4 w; w.x = cvt_pk_bf16(v0[0], v0[1]); w.y = cvt_pk_bf16(v0[2], v0[3]); w.z = cvt_pk_bf16(v1[0], v1[1]); w.w = cvt_pk_bf16(v1[2], v1[3]);
                    *(u32x4*)(rowp + bj * HALF) = w; } }
    }
};
template <class Epi, class Sched, bool ALIGN_EPI = false, bool SP2 = false>
__device__ __forceinline__ void gemm_phase(PG8_LAS unsigned char* lds, const Gemm g, const Sched& S, const Epi& E, int tid_in) {
    int tid_ = tid_in; asm volatile("" : "+v"(tid_));
    const int tid = tid_, wid = __builtin_amdgcn_readfirstlane(tid >> 6), lane = tid & 63, wr = wid >> 2, wc = wid & 3, fr = lane & 15, fq = lane >> 4;
    const int K = g.K, nt = K / BK;
    unsigned voffA[2], voffB[2];
#pragma unroll
    for (int i = 0; i < 2; ++i) { int R, C; stage_rc(tid * 16 + i * 8192, R, C); const int Rb = Epi::PERM ? ((R & ~31) + perm32(R & 31)) : R;
        voffA[i] = (unsigned)(R * K + C) * 2u; voffB[i] = (unsigned)(Rb * K + C) * 2u; }
    const size_t kstep = (size_t)(BK * 2);
    const size_t hstep = (size_t)HALF * K * 2;
    const size_t tstep = 2 * hstep;
    const unsigned ldsw = (unsigned)wid * 1024u;
    const int aoff = lds_byte(wr * 64 + fr, fq * 8), boff = lds_byte(wc * 32 + fr, fq * 8);
#define PG8_SA(b, h) (((b) * 2 + (h)) * HTB)
#define PG8_SB(b, h) ((4 + (b) * 2 + (h)) * HTB)
#define PG8_STAGE(bufoff, gbase, voff) do { _Pragma("unroll") for (int _i = 0; _i < 2; ++_i) \
        __builtin_amdgcn_global_load_lds((const unsigned*)((const char*)(gbase) + (voff)[_i]), (PG8_LAS unsigned*)(lds + (bufoff) + ldsw + _i * 8192), 16, 0, 0); } while (0)
#define PG8_LDA(dst, b, h) do { _Pragma("unroll") for (int m = 0; m < 4; ++m) _Pragma("unroll") for (int k = 0; k < 2; ++k) dst[m][k] = *(const PG8_LAS bf16x8*)(lds + PG8_SA(b, h) + aoff + m * 2048 + k * 1024); } while (0)
#define PG8_LDB(dst, b, h) do { _Pragma("unroll") for (int n = 0; n < 2; ++n) _Pragma("unroll") for (int k = 0; k < 2; ++k) dst[n][k] = *(const PG8_LAS bf16x8*)(lds + PG8_SB(b, h) + boff + n * 2048 + k * 1024); } while (0)
#define PG8_MMA(ai, bj, At, Bt) do { __builtin_amdgcn_s_setprio(1); _Pragma("unroll") for (int m = 0; m < 4; ++m) _Pragma("unroll") for (int n = 0; n < 2; ++n) _Pragma("unroll") for (int k = 0; k < 2; ++k) \
        acc[ai][bj][m][n] = __builtin_amdgcn_mfma_f32_16x16x32_bf16(Bt[n][k], At[m][k], acc[ai][bj][m][n], 0, 0, 0); __builtin_amdgcn_s_setprio(0); } while (0)
#define PG8_WAIT_V(n) asm volatile("s_waitcnt vmcnt(" #n ")" ::: "memory")
#define PG8_WAIT_L(n) asm volatile("s_waitcnt lgkmcnt(" #n ")" ::: "memory")
#define PG8_BAR __builtin_amdgcn_s_barrier()
#define PG8_SCHED __builtin_amdgcn_sched_barrier(0)
    Unit cur, nxt; int ui = 0;
    if (!S.next(0, cur)) return;
    f32x4 acc[2][2][4][2];
#pragma unroll
    for (int a = 0; a < 2; ++a)
#pragma unroll
        for (int b = 0; b < 2; ++b)
#pragma unroll
            for (int m = 0; m < 4; ++m)
#pragma unroll
                for (int n = 0; n < 2; ++n) acc[a][b][m][n] = (f32x4){0.f, 0.f, 0.f, 0.f};
    bf16x8 At[4][2], B0[2][2], B1[2][2];
    const char* cA = (const char*)g.A + (size_t)cur.pm * tstep; const char* cB = (const char*)g.Bt + (size_t)cur.pn * tstep;
    S.a_ready(cur);
    if constexpr (SP2) {
        PG8_STAGE(PG8_SB(0, 0), cB, voffB); PG8_STAGE(PG8_SB(0, 1), cB + hstep, voffB); PG8_STAGE(PG8_SA(0, 0), cA, voffA); PG8_STAGE(PG8_SA(0, 1), cA + hstep, voffA);
        if (wr == 1) PG8_BAR;
        PG8_WAIT_V(2); PG8_BAR;
        PG8_STAGE(PG8_SB(1, 0), cB + kstep, voffB); PG8_STAGE(PG8_SA(1, 0), cA + kstep, voffA); PG8_STAGE(PG8_SB(1, 1), cB + hstep + kstep, voffB);
        PG8_WAIT_V(6); PG8_BAR;
    } else {
        PG8_STAGE(PG8_SB(0, 0), cB, voffB); PG8_STAGE(PG8_SA(0, 0), cA, voffA); PG8_STAGE(PG8_SB(0, 1), cB + hstep, voffB); PG8_STAGE(PG8_SA(0, 1), cA + hstep, voffA);
        if (wr == 1) PG8_BAR;
        PG8_WAIT_V(4); PG8_BAR;
        PG8_STAGE(PG8_SB(1, 0), cB + kstep, voffB); PG8_STAGE(PG8_SA(1, 0), cA + kstep, voffA); PG8_STAGE(PG8_SB(1, 1), cB + hstep + kstep, voffB);
        PG8_WAIT_V(6); PG8_BAR;
    }
    for (;;) {
        const bool has_next = S.next(ui + 1, nxt);
        const char* nA = has_next ? (const char*)g.A + (size_t)nxt.pm * tstep : cA; const char* nB = has_next ? (const char*)g.Bt + (size_t)nxt.pn * tstep : cB;
        for (int t = 0; t < nt; t += 2) {
            const bool last = (t == nt - 2);
            const char* a1 = cA + (size_t)(t + 1) * kstep;
            const char* a2 = last ? nA : cA + (size_t)(t + 2) * kstep; const char* b2 = last ? nB : cB + (size_t)(t + 2) * kstep;
            const char* a3 = a2 + kstep; const char* b3 = b2 + kstep;
            if (last && has_next) S.a_ready(nxt);
            if constexpr (SP2) {
            PG8_LDB(B0, 0, 0); PG8_LDB(B1, 0, 1); PG8_SCHED; PG8_LDA(At, 0, 0); PG8_STAGE(PG8_SA(1, 1), a1 + hstep, voffA);
            PG8_WAIT_V(8); PG8_WAIT_L(0); PG8_BAR; PG8_MMA(0, 0, At, B0); PG8_MMA(0, 1, At, B1); PG8_BAR; PG8_SCHED;
            PG8_LDA(At, 0, 1); PG8_STAGE(PG8_SB(0, 0), b2, voffB); PG8_STAGE(PG8_SB(0, 1), b2 + hstep, voffB); PG8_STAGE(PG8_SA(0, 0), a2, voffA);
            PG8_WAIT_V(8); PG8_WAIT_L(0); PG8_BAR; PG8_MMA(1, 0, At, B0); PG8_MMA(1, 1, At, B1); PG8_BAR; PG8_SCHED;
            PG8_LDB(B0, 1, 0); PG8_LDB(B1, 1, 1); PG8_SCHED; PG8_LDA(At, 1, 0); PG8_STAGE(PG8_SA(0, 1), a2 + hstep, voffA);
            PG8_WAIT_V(8); PG8_WAIT_L(0); PG8_BAR; PG8_MMA(0, 0, At, B0); PG8_MMA(0, 1, At, B1); PG8_BAR; PG8_SCHED;
            PG8_LDA(At, 1, 1); PG8_STAGE(PG8_SB(1, 0), b3, voffB); PG8_STAGE(PG8_SB(1, 1), b3 + hstep, voffB); PG8_STAGE(PG8_SA(1, 0), a3, voffA);
            PG8_WAIT_V(8); PG8_WAIT_L(0); PG8_BAR; PG8_MMA(1, 0, At, B0); PG8_MMA(1, 1, At, B1); PG8_BAR; PG8_SCHED;
            } else {
            PG8_LDB(B0, 0, 0); PG8_SCHED; PG8_LDA(At, 0, 0); PG8_STAGE(PG8_SA(1, 1), a1 + hstep, voffA);
            PG8_WAIT_L(8); PG8_BAR; PG8_WAIT_L(0); PG8_MMA(0, 0, At, B0); PG8_BAR; PG8_SCHED;
            PG8_LDB(B1, 0, 1); PG8_STAGE(PG8_SB(0, 0), b2, voffB);
            PG8_BAR; PG8_WAIT_L(0); PG8_MMA(0, 1, At, B1); PG8_BAR;
            PG8_LDA(At, 0, 1); PG8_STAGE(PG8_SA(0, 0), a2, voffA);
            PG8_BAR; PG8_WAIT_L(0); PG8_MMA(1, 0, At, B0); PG8_BAR; PG8_SCHED;
            PG8_STAGE(PG8_SB(0, 1), b2 + hstep, voffB);
            PG8_WAIT_V(6); PG8_BAR; PG8_MMA(1, 1, At, B1); PG8_BAR;
            PG8_LDB(B0, 1, 0); PG8_SCHED; PG8_LDA(At, 1, 0); PG8_STAGE(PG8_SA(0, 1), a2 + hstep, voffA);
            PG8_WAIT_L(8); PG8_BAR; PG8_WAIT_L(0); PG8_MMA(0, 0, At, B0); PG8_BAR; PG8_SCHED;
            PG8_LDB(B1, 1, 1); PG8_STAGE(PG8_SB(1, 0), b3, voffB);
            PG8_BAR; PG8_WAIT_L(0); PG8_MMA(0, 1, At, B1); PG8_BAR;
            PG8_LDA(At, 1, 1); PG8_STAGE(PG8_SA(1, 0), a3, voffA);
            PG8_BAR; PG8_WAIT_L(0); PG8_MMA(1, 0, At, B0); PG8_BAR; PG8_SCHED;
            PG8_STAGE(PG8_SB(1, 1), b3 + hstep, voffB);
            PG8_WAIT_V(6); PG8_BAR; PG8_MMA(1, 1, At, B1); PG8_BAR;
            }
        }
        if constexpr (ALIGN_EPI) { if (wr == 0) PG8_BAR; }
        if constexpr (!Epi::AFTER_DRAIN) { E(acc, cur, wr, wc, fr, fq); S.done(cur); }
        if (!has_next) break;
#pragma unroll
        for (int a = 0; a < 2; ++a)
#pragma unroll
            for (int b = 0; b < 2; ++b)
#pragma unroll
                for (int m = 0; m < 4; ++m)
#pragma unroll
                    for (int n = 0; n < 2; ++n) acc[a][b][m][n] = (f32x4){0.f, 0.f, 0.f, 0.f};
        cur = nxt; cA = nA; cB = nB; ++ui;
        if constexpr (ALIGN_EPI) { if (wr == 1) PG8_BAR; }
    }
    PG8_WAIT_V(0);
    if constexpr (!ALIGN_EPI) { if (wr == 0) PG8_BAR; }
    PG8_BAR;
    if constexpr (Epi::AFTER_DRAIN) { E.fused(acc, cur, wr, wc, fr, fq, lds, wid, lane); S.done(cur); }
#undef PG8_SA
#undef PG8_SB
#undef PG8_STAGE
#undef PG8_LDA
#undef PG8_LDB
#undef PG8_MMA
#undef PG8_WAIT_V
#undef PG8_WAIT_L
#undef PG8_BAR
#undef PG8_SCHED
}
}
#define LAS __attribute__((address_space(3)))
typedef unsigned short bf16_t;
typedef short bf16x8 __attribute__((ext_vector_type(8)));
typedef float f32x4 __attribute__((ext_vector_type(4)));
typedef unsigned u32x4 __attribute__((ext_vector_type(4)));
typedef unsigned u32x2 __attribute__((ext_vector_type(2)));

constexpr int DM = 2048, NB = 4, SEQ = 2048, DEPTH = 4, DECB = 128, MP = NB * SEQ, MT = MP + DECB;
constexpr int NH = 8, HD = 128, DIN = 8208, DINP = 8224, NZ = 8192, MODLD = DEPTH * 3 * DM;
constexpr float EPS = 1e-6f;
constexpr size_t MiB = 1u << 20;
constexpr size_t WS_WIN = 0, WS_WOUT = 130 * MiB, WS_WADA = 162 * MiB, WS_CA = 258 * MiB, WS_MOD = 259 * MiB, WS_HB = 283 * MiB, WS_Z = 316 * MiB,
                 WS_ZS = 444 * MiB, WS_BA = 449 * MiB, WS_X = 450 * MiB, WS_YCAT = 515 * MiB, WS_TR = 548 * MiB, WS_GL = 652 * MiB, WS_CTL = 653 * MiB, WS_OB = 654 * MiB, WS_END = 686 * MiB;
constexpr size_t TR_W = 0, TR_Q = 16384, TR_A = 32768, TR_K = 40960, TR_G = 57344, TR_U = 73728, TR_SZ = 106496;
constexpr int LDS_BYTES = 147456;
constexpr size_t O_YP = 0, O_YS = O_YP + (size_t)MP * DM, O_CAP = O_YS + (size_t)DECB * DM, O_CQP = O_CAP + (size_t)DEPTH * NB * 2 * 1024,
                 O_SP = O_CQP + (size_t)DEPTH * NB * 3 * 3072, O_CAS = O_SP + (size_t)DEPTH * NB * NH * HD * HD, O_CQS = O_CAS + (size_t)DEPTH * DECB * 2 * 1024,
                 O_SS = O_CQS + (size_t)DEPTH * DECB * 3 * 3072, O_END = O_SS + (size_t)DEPTH * DECB * NH * HD * HD;

__device__ __forceinline__ float bflo(unsigned w) { return __uint_as_float(w << 16); }
__device__ __forceinline__ float bfhi(unsigned w) { return __uint_as_float(w & 0xffff0000u); }
__device__ __forceinline__ float bf2f(bf16_t h) { return __uint_as_float((unsigned)h << 16); }
__device__ __forceinline__ unsigned pk2(float lo, float hi) { return pg8::cvt_pk_bf16(lo, hi); }
__device__ __forceinline__ bf16_t f2bf(float f) { return (bf16_t)(pk2(f, 0.f) & 0xffffu); }
__device__ __forceinline__ float rcp_f(float x) { return __builtin_amdgcn_rcpf(x); }
__device__ __forceinline__ float rsq_f(float x) { return __builtin_amdgcn_rsqf(x); }
__device__ __forceinline__ float exp_f(float x) { return __builtin_amdgcn_exp2f(x * 1.4426950408889634f); }
__device__ __forceinline__ float silu_f(float x) { return x * rcp_f(1.f + exp_f(-x)); }
__device__ __forceinline__ float sigmoid_f(float x) { return rcp_f(1.f + exp_f(-x)); }
__device__ __forceinline__ float softplus_f(float x) { return fmaxf(x, 0.f) + __logf(1.f + exp_f(-fabsf(x))); }
__device__ __forceinline__ float wave_sum(float v) {
#pragma unroll
    for (int o = 1; o < 64; o <<= 1) v += __shfl_xor(v, o);
    return v;
}
__device__ __forceinline__ float wave_sum2(float v, int lane) {
    v += __builtin_bit_cast(float, __builtin_amdgcn_update_dpp(0, __builtin_bit_cast(int, v), 0xB1, 0xF, 0xF, true));
    v += __builtin_bit_cast(float, __builtin_amdgcn_update_dpp(0, __builtin_bit_cast(int, v), 0x4E, 0xF, 0xF, true));
    v += __builtin_bit_cast(float, __builtin_amdgcn_update_dpp(0, __builtin_bit_cast(int, v), 0x141, 0xF, 0xF, true));
    v += __builtin_bit_cast(float, __builtin_amdgcn_update_dpp(0, __builtin_bit_cast(int, v), 0x140, 0xF, 0xF, true));
    v += __builtin_bit_cast(float, __builtin_amdgcn_ds_bpermute((lane ^ 16) << 2, __builtin_bit_cast(int, v)));
    v += __builtin_bit_cast(float, __builtin_amdgcn_ds_bpermute((lane ^ 32) << 2, __builtin_bit_cast(int, v)));
    return v;
}
#define LBAR() do { asm volatile("s_waitcnt lgkmcnt(0)" ::: "memory"); __builtin_amdgcn_s_barrier(); asm volatile("" ::: "memory"); } while (0)
#define LDS_WAIT() asm volatile("s_waitcnt lgkmcnt(0)" ::: "memory")

struct EpiF32Bias {
    static constexpr bool PERM = false, AFTER_DRAIN = false;
    float* out; int ldc; const float* bias;
    __device__ __forceinline__ void operator()(const f32x4 (&acc)[2][2][4][2], const pg8::Unit& u, int wr, int wc, int fr, int fq) const {
        const int row0 = u.pm * 256 + wr * 64 + fr, col0 = u.pn * 256 + wc * 32 + 4 * fq;
#pragma unroll
        for (int ai = 0; ai < 2; ++ai)
#pragma unroll
            for (int m = 0; m < 4; ++m) { const size_t off = (size_t)(row0 + ai * 128 + m * 16) * ldc + col0;
#pragma unroll
                for (int bj = 0; bj < 2; ++bj)
#pragma unroll
                    for (int n = 0; n < 2; ++n) { const f32x4 bv = *(const f32x4*)(bias + col0 + bj * 128 + n * 16); *(f32x4*)(out + off + bj * 128 + n * 16) = acc[ai][bj][m][n] + bv; }
                asm volatile("" ::: "memory"); }
    }
};
struct EpiResGate {
    static constexpr bool PERM = false, AFTER_DRAIN = false;
    const float* base; float* out; const float* gate; int ldc;
    __device__ __forceinline__ void operator()(const f32x4 (&acc)[2][2][4][2], const pg8::Unit& u, int wr, int wc, int fr, int fq) const {
        const int row0 = u.pm * 256 + wr * 64 + fr, col0 = u.pn * 256 + wc * 32 + 4 * fq;
        const float* gp = gate + (size_t)((u.pm * 256) / SEQ) * MODLD + col0;
        f32x4 gv[2][2];
#pragma unroll
        for (int bj = 0; bj < 2; ++bj)
#pragma unroll
            for (int n = 0; n < 2; ++n) gv[bj][n] = *(const f32x4*)(gp + bj * 128 + n * 16);
#pragma unroll
        for (int ai = 0; ai < 2; ++ai)
#pragma unroll
            for (int m = 0; m < 4; ++m) { const size_t off = (size_t)(row0 + ai * 128 + m * 16) * ldc + col0;
#pragma unroll
                for (int bj = 0; bj < 2; ++bj)
#pragma unroll
                    for (int n = 0; n < 2; ++n) { const f32x4 b = *(const f32x4*)(base + off + bj * 128 + n * 16); *(f32x4*)(out + off + bj * 128 + n * 16) = b + gv[bj][n] * acc[ai][bj][m][n]; }
                asm volatile("" ::: "memory"); }
    }
};

__device__ __forceinline__ f32x4 skinny16(const bf16_t* A, int lda, const bf16_t* Bt, int ldb, int K, int lane) {
    const int r = lane & 15, q = lane >> 4;
    const bf16x8* ap = (const bf16x8*)(A + (size_t)r * lda + q * 8);
    const bf16x8* bp = (const bf16x8*)(Bt + (size_t)r * ldb + q * 8);
    f32x4 acc0 = {0.f, 0.f, 0.f, 0.f}, acc1 = {0.f, 0.f, 0.f, 0.f};
#pragma unroll 1
    for (int k = 0; k < K / 32; k += 16) {
        bf16x8 a[16], b[16];
#pragma unroll
        for (int i = 0; i < 16; ++i) { a[i] = ap[(k + i) * 4]; b[i] = bp[(k + i) * 4]; }
#pragma unroll
        for (int i = 0; i < 16; i += 2) { acc0 = __builtin_amdgcn_mfma_f32_16x16x32_bf16(a[i], b[i], acc0, 0, 0, 0); acc1 = __builtin_amdgcn_mfma_f32_16x16x32_bf16(a[i + 1], b[i + 1], acc1, 0, 0, 0); }
    }
    return acc0 + acc1;
}


__device__ __forceinline__ void sample_gemm32(LAS unsigned char* lds, const bf16_t* A, const bf16_t* Bt, float* out, int ldo, int n0, int tid, int lane, int wave) {
    constexpr int CK = 512, BS = CK + 8, BUFB = 32 * BS * 2, NC = DM / CK;
    const int r = lane & 15, q8 = lane >> 4;
    const bf16_t* ap = A + (size_t)(wave * 16 + r) * DM + q8 * 8;
    const bf16_t* bp = Bt + (size_t)(tid >> 6) * DM + (tid & 63) * 8;
    const unsigned bw = (unsigned)((tid >> 6) * BS + (tid & 63) * 8) * 2u;
    f32x4 acc[2] = {{0.f, 0.f, 0.f, 0.f}, {0.f, 0.f, 0.f, 0.f}};
    bf16x8 fa[16], fn[16]; u32x4 sb[4];
#define SG_LA(c, d) do { _Pragma("unroll") for (int ks = 0; ks < 16; ++ks) d[ks] = *(const bf16x8*)(ap + (c) * CK + ks * 32); } while (0)
#define SG_LB(c) do { _Pragma("unroll") for (int i = 0; i < 4; ++i) sb[i] = *(const u32x4*)(bp + (size_t)(8 * i) * DM + (c) * CK); } while (0)
#define SG_SB(bufp) do { _Pragma("unroll") for (int i = 0; i < 4; ++i) *(LAS u32x4*)((bufp) + bw + (unsigned)(8 * i * BS * 2)) = sb[i]; } while (0)
    SG_LB(0); SG_LA(0, fa);
    SG_SB(lds);
    SG_LB(1);
    __syncthreads();
#define SG_MM(f_, c_) do { const LAS bf16_t* Bl = (const LAS bf16_t*)(lds + ((c_) & 1) * BUFB); \
        _Pragma("unroll") for (int ks = 0; ks < 16; ++ks) { \
            const bf16x8 b0 = *(const LAS bf16x8*)(Bl + r * BS + ks * 32 + q8 * 8), b1 = *(const LAS bf16x8*)(Bl + (16 + r) * BS + ks * 32 + q8 * 8); \
            acc[0] = __builtin_amdgcn_mfma_f32_16x16x32_bf16(f_[ks], b0, acc[0], 0, 0, 0); acc[1] = __builtin_amdgcn_mfma_f32_16x16x32_bf16(f_[ks], b1, acc[1], 0, 0, 0); } } while (0)
#pragma unroll 1
    for (int c = 0; c < NC; c += 2) {
        SG_LA(c + 1, fn);
        SG_MM(fa, c);
        SG_SB(lds + ((c + 1) & 1) * BUFB);
        if (c + 2 < NC) SG_LB(c + 2);
        LBAR();
        if (c + 2 < NC) SG_LA(c + 2, fa);
        SG_MM(fn, c + 1);
        if (c + 2 < NC) SG_SB(lds + ((c + 2) & 1) * BUFB);
        if (c + 3 < NC) SG_LB(c + 3);
        LBAR();
    }
#undef SG_MM
#undef SG_LA
#undef SG_LB
#undef SG_SB
#pragma unroll
    for (int nt = 0; nt < 2; ++nt)
#pragma unroll
        for (int j = 0; j < 4; ++j) out[(size_t)(wave * 16 + q8 * 4 + j) * ldo + n0 + nt * 16 + r] = acc[nt][j];
}

__device__ __forceinline__ void transpose_item(const float* W, int K, int N, bf16_t* WT, LAS float* scr, int item, int lane) {
    const int nblk = (N + 31) / 32, kb = item / nblk, nb = item % nblk, k0 = 64 * kb, n0 = 32 * nb;
    const int nn = n0 + (lane & 31); const bool ok = nn < N;
    float v[32];
#pragma unroll
    for (int i = 0; i < 32; ++i) { const int kk = 2 * i + (lane >> 5); v[i] = ok ? W[(size_t)(k0 + kk) * N + nn] : 0.f; }
#pragma unroll
    for (int i = 0; i < 32; ++i) { const int kk = 2 * i + (lane >> 5); scr[kk * 33 + (lane & 31)] = v[i]; }
    LDS_WAIT(); asm volatile("" ::: "memory");
    const int c = lane & 7;
#pragma unroll
    for (int j = 0; j < 4; ++j) { const int n = (lane >> 3) + 8 * j; const LAS float* s = scr + (8 * c) * 33 + n;
        u32x4 o; o.x = pk2(s[0 * 33], s[1 * 33]); o.y = pk2(s[2 * 33], s[3 * 33]); o.z = pk2(s[4 * 33], s[5 * 33]); o.w = pk2(s[6 * 33], s[7 * 33]);
        *(u32x4*)(WT + (size_t)(n0 + n) * K + k0 + 8 * c) = o; }
    LDS_WAIT(); asm volatile("" ::: "memory");
}

#define RLX_AGENT __ATOMIC_RELAXED, __HIP_MEMORY_SCOPE_AGENT
#define XB_TMO      128
#define XB_XCNT(j)  (256  + 64 * (j))
#define XB_XSUB(j)  (1280 + 64 * (j))
#define XB_XGEN(j)  (2304 + 64 * (j))
#define XB_TOP      3328
#define XB_TOPGEN   3392
#define XCD_BAR_WORDS 3456
#define XB_SPIN_CAP (1u << 17)

__device__ __forceinline__ unsigned xb_ld(unsigned* p)              { return __hip_atomic_load(p, __ATOMIC_RELAXED, __HIP_MEMORY_SCOPE_AGENT); }
__device__ __forceinline__ unsigned xb_add(unsigned* p, unsigned v) { return __hip_atomic_fetch_add(p, v, __ATOMIC_RELAXED, __HIP_MEMORY_SCOPE_AGENT); }
__device__ __forceinline__ unsigned xb_xcc_id() { return (unsigned)__builtin_amdgcn_s_getreg((3 << 11) | 20) & 0xFu; }
#define XB_SPIN(cond, bar) do { unsigned _sp = 0; while (cond) { __builtin_amdgcn_s_sleep(6); \
    if ((++_sp & 255u) == 0u) { if (xb_ld(&(bar)[XB_TMO])) break; if (_sp > XB_SPIN_CAP) { atomicAdd(&(bar)[XB_TMO], 1u); break; } } } } while (0)

struct XcdBarrier {
    unsigned* bar; unsigned x;
    volatile LAS unsigned* st;
};

__device__ __forceinline__ XcdBarrier xcd_barrier_post(unsigned* bar, volatile LAS unsigned* st) {
    XcdBarrier b; b.bar = bar; b.x = xb_xcc_id(); b.st = st;
    if (threadIdx.x == 0) (void)xb_add(&bar[XB_XCNT(b.x)], 1u);
    return b;
}
__device__ __forceinline__ void xcd_barrier_complete(unsigned* bar, unsigned x, unsigned& nloc, unsigned& nx) {
    const unsigned G = gridDim.x * gridDim.y * gridDim.z;
    unsigned sum, cnt, mine, sp = 0u;
    for (;;) {
        sum = 0u; cnt = 0u; mine = 0u;
#pragma unroll
        for (unsigned j = 0; j < 16; ++j) { const unsigned c = xb_ld(&bar[XB_XCNT(j)]); sum += c; cnt += (c > 0u) ? 1u : 0u; mine = (j == x) ? c : mine; }
        if (sum == G) break;
        __builtin_amdgcn_s_sleep(6);
        if ((++sp & 255u) == 0u) { if (xb_ld(&bar[XB_TMO])) break; if (sp > XB_SPIN_CAP) { atomicAdd(&bar[XB_TMO], 1u); break; } }
    }
    nloc = mine > 0u ? mine : 1u; nx = cnt > 0u ? cnt : 1u;
}

__device__ __forceinline__ void xcd_barrier(const XcdBarrier& b) {
    asm volatile("s_waitcnt vmcnt(0)" ::: "memory");
    __syncthreads();
    if (threadIdx.x == 0) {
        unsigned* bar = b.bar;
        __builtin_amdgcn_s_waitcnt(0);
        unsigned nloc = b.st[0], nx = b.st[1];
        if (nloc == 0u) { xcd_barrier_complete(bar, b.x, nloc, nx); b.st[0] = nloc; b.st[1] = nx; }
        const unsigned old = xb_add(&bar[XB_XSUB(b.x)], 1u);
        const unsigned gen = old / nloc;
        if (old + 1u == (gen + 1u) * nloc) {
            __builtin_amdgcn_fence(__ATOMIC_RELEASE, "agent");
            asm volatile("s_waitcnt vmcnt(0)" ::: "memory");
            const unsigned og = xb_add(&bar[XB_TOP], 1u);
            const unsigned tg = og / nx;
            if (og + 1u == (tg + 1u) * nx) xb_add(&bar[XB_TOPGEN], 1u);
            else XB_SPIN(xb_ld(&bar[XB_TOPGEN]) == tg, bar);
            __builtin_amdgcn_fence(__ATOMIC_ACQUIRE, "agent");
            xb_add(&bar[XB_XGEN(b.x)], 1u);
            asm volatile("s_waitcnt vmcnt(0)" ::: "memory");
        } else {
            XB_SPIN(xb_ld(&bar[XB_XGEN(b.x)]) == gen, bar);
            __builtin_amdgcn_fence(__ATOMIC_ACQUIRE, "agent");
            asm volatile("s_waitcnt vmcnt(0)" ::: "memory");
        }
    }
    __syncthreads();
}

__device__ __forceinline__ void phase_norm(const float* xp, const float* xs, const float* ng, const float* modl, bf16_t* hb, int gw, int NGW, int lane) {
    {
        const int row0 = gw * 4, mrow = row0 / SEQ;
        const float* sh = modl + (size_t)mrow * MODLD; const float* sc = sh + DM;
        f32x4 gg[8], ss0[8];
#pragma unroll
        for (int j = 0; j < 8; ++j) { const int c4 = lane + 64 * j; gg[j] = ((const f32x4*)ng)[c4] * (1.f + ((const f32x4*)sc)[c4]); ss0[j] = ((const f32x4*)sh)[c4]; }
#pragma unroll
        for (int k = 0; k < 4; ++k) {
            f32x4 v[8]; float ss = 0.f;
#pragma unroll
            for (int j = 0; j < 8; ++j) { v[j] = ((const f32x4*)(xp + (size_t)(row0 + k) * DM))[lane + 64 * j]; ss += (v[j].x * v[j].x + v[j].y * v[j].y) + (v[j].z * v[j].z + v[j].w * v[j].w); }
            const float rstd = rsq_f(wave_sum2(ss, lane) * (1.f / DM) + EPS);
#pragma unroll
            for (int j = 0; j < 8; ++j) { const int c4 = lane + 64 * j; const f32x4 h = v[j] * rstd * gg[j] + ss0[j]; u32x2 o; o.x = pk2(h.x, h.y); o.y = pk2(h.z, h.w); *(u32x2*)(hb + (size_t)(row0 + k) * DM + c4 * 4) = o; }
        }
    }
    for (int rs = gw; rs < DECB; rs += NGW) {
        const int row = MP + rs; const float* xr = xs + (size_t)rs * DM;
        const float* sh = modl + (size_t)(NB + rs) * MODLD; const float* sc = sh + DM;
        f32x4 v[8]; float ss = 0.f;
#pragma unroll
        for (int j = 0; j < 8; ++j) { v[j] = ((const f32x4*)xr)[lane + 64 * j]; ss += (v[j].x * v[j].x + v[j].y * v[j].y) + (v[j].z * v[j].z + v[j].w * v[j].w); }
        const float rstd = rsq_f(wave_sum2(ss, lane) * (1.f / DM) + EPS);
#pragma unroll
        for (int j = 0; j < 8; ++j) { const int c4 = lane + 64 * j; const f32x4 g = ((const f32x4*)ng)[c4], s1 = ((const f32x4*)sc)[c4], s0 = ((const f32x4*)sh)[c4];
            const f32x4 h = v[j] * rstd * g * (1.f + s1) + s0; u32x2 o; o.x = pk2(h.x, h.y); o.y = pk2(h.z, h.w); *(u32x2*)(hb + (size_t)row * DM + c4 * 4) = o; }
    }
}
__device__ __forceinline__ void final_row(const f32x4 (&v)[8], const f32x4 (&g)[8], float* orow, int lane) {
    float ss = 0.f;
#pragma unroll
    for (int j = 0; j < 8; ++j) ss += (v[j].x * v[j].x + v[j].y * v[j].y) + (v[j].z * v[j].z + v[j].w * v[j].w);
    const float rstd = rsq_f(wave_sum(ss) * (1.f / DM) + EPS);
#pragma unroll
    for (int j = 0; j < 8; ++j) ((f32x4*)orow)[lane + 64 * j] = v[j] * rstd * g[j];
}
__device__ __forceinline__ void phase_final(const float* x, const float* g, float* out, int gw, int NGW, int lane) {
    f32x4 gg[8];
#pragma unroll
    for (int j = 0; j < 8; ++j) gg[j] = ((const f32x4*)g)[lane + 64 * j];
    const int row0 = gw * 4;
    f32x4 v[8], w[8];
#pragma unroll
    for (int j = 0; j < 8; ++j) v[j] = ((const f32x4*)(x + (size_t)row0 * DM))[lane + 64 * j];
#pragma unroll
    for (int k = 0; k < 4; ++k) {
        if (k < 3) {
#pragma unroll
            for (int j = 0; j < 8; ++j) w[j] = ((const f32x4*)(x + (size_t)(row0 + k + 1) * DM))[lane + 64 * j];
        }
        final_row(v, gg, out + (size_t)(row0 + k) * DM, lane);
#pragma unroll
        for (int j = 0; j < 8; ++j) v[j] = w[j];
    }
    for (int row = MP + gw; row < MT; row += NGW) {
#pragma unroll
        for (int j = 0; j < 8; ++j) v[j] = ((const f32x4*)(x + (size_t)row * DM))[lane + 64 * j];
        final_row(v, gg, out + (size_t)row * DM, lane);
    }
}

template <int I, int C> __device__ __forceinline__ void s2_load(const LAS float* Ll, f32x4 (&lr)[16]) {
    if constexpr (4 * C < I) { lr[C] = *(const LAS f32x4*)(Ll + I * 64 + 4 * C); s2_load<I, C + 1>(Ll, lr); }
}
template <int I, int C> __device__ __forceinline__ void s2_fma(const f32x4 (&lr)[16], const float (&Xc)[64], float& a0, float& a1, float& a2, float& a3) {
    if constexpr (4 * C < I) {
        a0 += lr[C].x * Xc[4 * C];
        if constexpr (4 * C + 1 < I) a1 += lr[C].y * Xc[4 * C + 1];
        if constexpr (4 * C + 2 < I) a2 += lr[C].z * Xc[4 * C + 2];
        if constexpr (4 * C + 3 < I) a3 += lr[C].w * Xc[4 * C + 3];
        s2_fma<I, C + 1>(lr, Xc, a0, a1, a2, a3);
    }
}
template <int I> __device__ __forceinline__ void s2_row(const LAS float* Ll, float (&Xc)[64], int lane) {
    if constexpr (I < 64) {
        float a0 = Ll[I * 64 + lane], a1 = 0.f, a2 = 0.f, a3 = 0.f;
        f32x4 lr[16];
        s2_load<I, 0>(Ll, lr);
        s2_fma<I, 0>(lr, Xc, a0, a1, a2, a3);
        Xc[I] = -((a0 + a1) + (a2 + a3));
        asm volatile("" ::: "memory");
        s2_row<I + 1>(Ll, Xc, lane);
    }
}
struct PrepP { const bf16_t* z; const float* ba; const float* cw; const float* alog; const float* dtb; unsigned char* tr; float* gl; };
constexpr int PS = 136, TS = 72;
__device__ __forceinline__ void conv8(const u32x4 (&x)[4], const LAS float* w, float (&o)[8]) {
    f32x4 wa[4], wb[4];
#pragma unroll
    for (int j = 0; j < 4; ++j) { wa[j] = *(const LAS f32x4*)(w + j * 384); wb[j] = *(const LAS f32x4*)(w + j * 384 + 4); }
#pragma unroll
    for (int i = 0; i < 8; ++i) o[i] = 0.f;
#pragma unroll
    for (int j = 0; j < 4; ++j) {
        o[0] += wa[j].x * bflo(x[j].x); o[1] += wa[j].y * bfhi(x[j].x); o[2] += wa[j].z * bflo(x[j].y); o[3] += wa[j].w * bfhi(x[j].y);
        o[4] += wb[j].x * bflo(x[j].z); o[5] += wb[j].y * bfhi(x[j].z); o[6] += wb[j].z * bflo(x[j].w); o[7] += wb[j].w * bfhi(x[j].w); }
#pragma unroll
    for (int i = 0; i < 8; ++i) o[i] = silu_f(o[i]);
}
__device__ __forceinline__ u32x4 pack8(const float* v) { u32x4 o; o.x = pk2(v[0], v[1]); o.y = pk2(v[2], v[3]); o.z = pk2(v[4], v[5]); o.w = pk2(v[6], v[7]); return o; }
__device__ __forceinline__ void prep_weights(LAS unsigned char* lds, const float* cqw, int h, int tid) {
    LAS float* wl = (LAS float*)(lds + 114688);
#pragma unroll
    for (int i = 0; i < 3; ++i) { const int idx = tid + 512 * i, j = idx / 384, rem = idx - j * 384, m = rem >> 7, c = rem & 127; wl[idx] = cqw[j * 3072 + m * 1024 + h * 128 + c]; }
}
__device__ __forceinline__ void prep_task(LAS unsigned char* lds, const PrepP& P, int task, int tid, int lane, int wave) {
    asm volatile("" : "+v"(tid));
    lane = tid & 63;
    unsigned lb = 0; asm volatile("" : "+v"(lb)); lds += (lb & ~15u);
    const int h = task & 7, n = (task >> 3) & 31, b = task >> 8;
    const int row0 = b * SEQ + n * 64;
    unsigned char* trp = P.tr + (size_t)task * TR_SZ;
    LAS bf16_t* Kl = (LAS bf16_t*)lds; LAS bf16_t* Ql = Kl + 64 * PS; LAS bf16_t* Vl = Ql + 64 * PS; LAS bf16_t* KBl = Vl + 64 * PS; LAS bf16_t* KTl = KBl + 64 * PS;
    LAS float* Ll = (LAS float*)(lds + 5 * 64 * PS * 2);
    LAS bf16_t* Tl = (LAS bf16_t*)(lds + 5 * 64 * PS * 2 + 16384);
    LAS float* gcl = (LAS float*)(lds + 5 * 64 * PS * 2 + 16384 + 64 * TS * 2);
    const int r = lane & 15, q8 = lane >> 4;
    if (wave == 0) {
        const float* bar = P.ba + (size_t)(row0 + lane) * 16;
        float g = -exp_f(P.alog[h]) * softplus_f(bar[8 + h] + P.dtb[h]);
#pragma unroll
        for (int o = 1; o < 64; o <<= 1) { const float v = __shfl_up(g, o); if (lane >= o) g += v; }
        gcl[lane] = g; gcl[64 + lane] = sigmoid_f(bar[h]);
        if (lane == 63) P.gl[task] = exp_f(g);
    }
    LBAR();
    {
        const int t = tid >> 3, seg = tid & 7;
        const float beta = gcl[64 + t], gc = gcl[t], glc = gcl[63];
        const float eg = exp_f(gc), et = exp_f(glc - gc);
        const int tt = n * 64 + t;
        const bf16_t* zr = P.z + (size_t)(row0 + t) * NZ + 4096 + h * 128 + seg * 16;
        const LAS float* cw = (const LAS float*)(lds + 114688) + seg * 16;
        u32x4 xz[3][2][4];
#pragma unroll
        for (int m = 0; m < 3; ++m)
#pragma unroll
            for (int hf = 0; hf < 2; ++hf)
#pragma unroll
                for (int j = 0; j < 4; ++j) { const bool ok = tt - 3 + j >= 0; xz[m][hf][j] = *(const u32x4*)(zr + m * 1024 + hf * 8 + (ptrdiff_t)(ok ? j - 3 : 0) * NZ); if (!ok) xz[m][hf][j] = (u32x4){0u, 0u, 0u, 0u}; }
        const int lo = t * PS + seg * 16;
        float x[16], y[16];
        { float o[8]; conv8(xz[2][0], cw + 256, o);
#pragma unroll
          for (int i = 0; i < 8; ++i) x[i] = o[i] * beta;
          conv8(xz[2][1], cw + 256 + 8, o);
#pragma unroll
          for (int i = 0; i < 8; ++i) x[8 + i] = o[i] * beta; }
        *(LAS u32x4*)(Vl + lo) = pack8(x); *(LAS u32x4*)(Vl + lo + 8) = pack8(x + 8);
        asm volatile("" ::: "memory");
        { float o[8]; conv8(xz[1][0], cw + 128, o);
#pragma unroll
          for (int i = 0; i < 8; ++i) x[i] = o[i];
          conv8(xz[1][1], cw + 128 + 8, o);
#pragma unroll
          for (int i = 0; i < 8; ++i) x[8 + i] = o[i]; }
        { float sk = 0.f;
#pragma unroll
          for (int i = 0; i < 16; ++i) sk += x[i] * x[i];
          sk += __shfl_xor(sk, 1); sk += __shfl_xor(sk, 2); sk += __shfl_xor(sk, 4);
          const float rk = rsq_f(sk + EPS);
#pragma unroll
          for (int i = 0; i < 16; ++i) x[i] *= rk; }
        *(LAS u32x4*)(Kl + lo) = pack8(x); *(LAS u32x4*)(Kl + lo + 8) = pack8(x + 8);
#pragma unroll
        for (int i = 0; i < 16; ++i) y[i] = x[i] * (beta * eg);
        *(LAS u32x4*)(KBl + lo) = pack8(y); *(LAS u32x4*)(KBl + lo + 8) = pack8(y + 8);
#pragma unroll
        for (int i = 0; i < 16; ++i) y[i] = x[i] * et;
        *(LAS u32x4*)(KTl + lo) = pack8(y); *(LAS u32x4*)(KTl + lo + 8) = pack8(y + 8);
        asm volatile("" ::: "memory");
        { float o[8]; conv8(xz[0][0], cw, o);
#pragma unroll
          for (int i = 0; i < 8; ++i) x[i] = o[i];
          conv8(xz[0][1], cw + 8, o);
#pragma unroll
          for (int i = 0; i < 8; ++i) x[8 + i] = o[i]; }
        { float sq = 0.f;
#pragma unroll
          for (int i = 0; i < 16; ++i) sq += x[i] * x[i];
          sq += __shfl_xor(sq, 1); sq += __shfl_xor(sq, 2); sq += __shfl_xor(sq, 4);
          const float rq = rsq_f(sq + EPS) * 0.08838834764831845f;
#pragma unroll
          for (int i = 0; i < 16; ++i) x[i] *= rq; }
        *(LAS u32x4*)(Ql + lo) = pack8(x); *(LAS u32x4*)(Ql + lo + 8) = pack8(x + 8);
#pragma unroll
        for (int i = 0; i < 16; ++i) y[i] = x[i] * eg;
        bf16_t* qo = (bf16_t*)(trp + TR_Q) + t * 128 + seg * 16;
        *(u32x4*)qo = pack8(y); *(u32x4*)(qo + 8) = pack8(y + 8);
    }
    LBAR();
    {
        const int it = wave >> 1, jt0 = (wave & 1) * 2;
        bf16x8 aK[4], aQ[4];
#pragma unroll
        for (int ks = 0; ks < 4; ++ks) { aK[ks] = *(const LAS bf16x8*)(Kl + (it * 16 + r) * PS + ks * 32 + q8 * 8); aQ[ks] = *(const LAS bf16x8*)(Ql + (it * 16 + r) * PS + ks * 32 + q8 * 8); }
#pragma unroll
        for (int jj = 0; jj < 2; ++jj) {
            const int jt = jt0 + jj;
            bf16_t* ap = (bf16_t*)(trp + TR_A) + (it * 16 + r) * 64 + jt * 16 + q8 * 4;
            if (jt > it) { *(u32x2*)ap = (u32x2){lb, lb};
#pragma unroll
                for (int j = 0; j < 4; ++j) Ll[(it * 16 + q8 * 4 + j) * 64 + jt * 16 + r] = 0.f;
                continue; }
            f32x4 accL = {0.f, 0.f, 0.f, 0.f}, accA = {0.f, 0.f, 0.f, 0.f};
#pragma unroll
            for (int ks = 0; ks < 4; ++ks) { const bf16x8 bK = *(const LAS bf16x8*)(Kl + (jt * 16 + r) * PS + ks * 32 + q8 * 8);
                accL = __builtin_amdgcn_mfma_f32_16x16x32_bf16(aK[ks], bK, accL, 0, 0, 0);
                accA = __builtin_amdgcn_mfma_f32_16x16x32_bf16(bK, aQ[ks], accA, 0, 0, 0); }
            float av[4];
#pragma unroll
            for (int j = 0; j < 4; ++j) {
                { const int i = it * 16 + q8 * 4 + j, jx = jt * 16 + r; const float e = exp_f(gcl[i] - gcl[jx]) * gcl[64 + i] * accL[j]; Ll[i * 64 + jx] = (i > jx) ? e : 0.f; }
                { const int i = it * 16 + r, jx = jt * 16 + q8 * 4 + j; const float e = exp_f(gcl[i] - gcl[jx]) * accA[j]; av[j] = (i >= jx) ? e : 0.f; } }
            u32x2 o; o.x = pk2(av[0], av[1]); o.y = pk2(av[2], av[3]); *(u32x2*)ap = o;
        }
    }
    LBAR();
    if (wave == 0) {
        float Xc[64];
        s2_row<0>(Ll, Xc, lane);
#pragma unroll
        for (int i = 0; i < 64; ++i) Tl[i * TS + lane] = f2bf(Xc[i]);
        asm volatile("s_waitcnt lgkmcnt(0)" ::: "memory");
        Tl[lane * TS + lane] = (bf16_t)0x3F80u;
    }
    LBAR();
    {
        const int c0 = wave * 16;
        bf16x8 bv[2], bk[2];
#pragma unroll
        for (int ks = 0; ks < 2; ++ks)
#pragma unroll
            for (int j = 0; j < 8; ++j) { const int tok = ks * 32 + q8 * 8 + j; bv[ks][j] = (short)Vl[tok * PS + c0 + r]; bk[ks][j] = (short)KBl[tok * PS + c0 + r]; }
#pragma unroll
        for (int mt = 0; mt < 4; ++mt) {
            f32x4 aU = {0.f, 0.f, 0.f, 0.f}, aW = {0.f, 0.f, 0.f, 0.f};
#pragma unroll
            for (int ks = 0; ks < 2; ++ks) { if (ks == 1 && mt < 2) continue;
                const bf16x8 aT = *(const LAS bf16x8*)(Tl + (mt * 16 + r) * TS + ks * 32 + q8 * 8);
                aU = __builtin_amdgcn_mfma_f32_16x16x32_bf16(aT, bv[ks], aU, 0, 0, 0);
                aW = __builtin_amdgcn_mfma_f32_16x16x32_bf16(bk[ks], aT, aW, 0, 0, 0); }
            *(f32x4*)((float*)(trp + TR_U) + ((wave * 4 + mt) * 64 + lane) * 4) = aU;
            u32x2 o; o.x = pk2(-aW[0], -aW[1]); o.y = pk2(-aW[2], -aW[3]);
            *(u32x2*)((bf16_t*)(trp + TR_W) + (mt * 16 + r) * 128 + c0 + q8 * 4) = o;
        }
#pragma unroll
        for (int ii = 0; ii < 2; ++ii) { const int item = tid + 512 * ii, dk = item & 127, oct = item >> 7; float kv[8];
#pragma unroll
            for (int j = 0; j < 8; ++j) kv[j] = bf2f(KTl[(oct * 8 + j) * PS + dk]);
            *(u32x4*)((bf16_t*)(trp + TR_K) + dk * 64 + oct * 8) = pack8(kv); }
    }
    LBAR();
}
__device__ __forceinline__ void conva_prompt(const bf16_t* z, const float* caw, bf16_t* ycat, int gt, int GT) {
#pragma unroll 2
    for (int idx = gt; idx < MP * 128; idx += GT) {
        const int row = idx >> 7, c8 = (idx & 127) * 8, t = row & (SEQ - 1);
        const bf16_t* zr = z + (size_t)row * NZ + c8;
        float conv[8];
#pragma unroll
        for (int i = 0; i < 8; ++i) conv[i] = 0.f;
#pragma unroll
        for (int j = 0; j < 3; ++j) {
            const bool ok = t - 2 + j >= 0; const ptrdiff_t ro = (ptrdiff_t)(ok ? j - 2 : 0) * NZ;
            u32x4 c = *(const u32x4*)(zr + ro + 1024); const u32x4 hh = *(const u32x4*)(zr + ro + 2048);
            if (!ok) c = (u32x4){0u, 0u, 0u, 0u};
            const f32x4 w0 = *(const f32x4*)(caw + j * 1024 + c8), w1 = *(const f32x4*)(caw + j * 1024 + c8 + 4);
            conv[0] += w0.x * (bflo(c.x) * bflo(hh.x)); conv[1] += w0.y * (bfhi(c.x) * bfhi(hh.x)); conv[2] += w0.z * (bflo(c.y) * bflo(hh.y)); conv[3] += w0.w * (bfhi(c.y) * bfhi(hh.y));
            conv[4] += w1.x * (bflo(c.z) * bflo(hh.z)); conv[5] += w1.y * (bfhi(c.z) * bfhi(hh.z)); conv[6] += w1.z * (bflo(c.w) * bflo(hh.w)); conv[7] += w1.w * (bfhi(c.w) * bfhi(hh.w));
        }
        const u32x4 bb = *(const u32x4*)zr, gg = *(const u32x4*)(zr + 3072);
        float y[8];
        y[0] = bflo(bb.x) * conv[0] * silu_f(bflo(gg.x)); y[1] = bfhi(bb.x) * conv[1] * silu_f(bfhi(gg.x)); y[2] = bflo(bb.y) * conv[2] * silu_f(bflo(gg.y)); y[3] = bfhi(bb.y) * conv[3] * silu_f(bfhi(gg.y));
        y[4] = bflo(bb.z) * conv[4] * silu_f(bflo(gg.z)); y[5] = bfhi(bb.z) * conv[5] * silu_f(bfhi(gg.z)); y[6] = bflo(bb.w) * conv[6] * silu_f(bflo(gg.w)); y[7] = bfhi(bb.w) * conv[7] * silu_f(bfhi(gg.w));
        *(u32x4*)(ycat + (size_t)row * DM + c8) = pack8(y);
    }
}
__device__ __forceinline__ void conv_states_prompt(const bf16_t* z, float* oca, float* ocq, int gt, int GT) {
    for (int idx = gt; idx < NB * 2 * 1024; idx += GT) { const int c = idx & 1023, j = (idx >> 10) & 1, b = idx >> 11;
        const bf16_t* zr = z + (size_t)(b * SEQ + SEQ - 2 + j) * NZ; oca[idx] = bf2f(zr[1024 + c]) * bf2f(zr[2048 + c]); }
    for (int idx = gt; idx < NB * 3 * 3072; idx += GT) { const int c = (int)((unsigned)idx % 3072u), j = (int)((unsigned)idx / 3072u) % 3, b = (int)((unsigned)idx / 9216u);
        ocq[idx] = bf2f(z[(size_t)(b * SEQ + SEQ - 3 + j) * NZ + 4096 + c]); }
}

struct ScanP { const unsigned char* tr; const float* gl; float* obuf; float* sout; };
constexpr int SB_W = 0, SB_Q = 64 * PS * 2, SB_A = 2 * 64 * PS * 2, SB_K = SB_A + 64 * TS * 2, SB_SZ = SB_K + 128 * TS * 2;
static_assert(2 * SB_SZ <= 131072, "scan LDS");
__device__ __forceinline__ bf16x8 frag1(const LAS bf16_t* p) { return *(const LAS bf16x8*)p; }
__device__ __forceinline__ bf16x8 packB(const f32x4& a, const f32x4& b) { u32x4 v = {pk2(a[0], a[1]), pk2(a[2], a[3]), pk2(b[0], b[1]), pk2(b[2], b[3])}; return __builtin_bit_cast(bf16x8, v); }
__device__ __forceinline__ void scan_bh(LAS unsigned char* lds, const ScanP& P, int b, int h, int half, int tid, int lane, int wave) {
    const bool cw = wave < 4;
    const int r = lane & 15, q8 = lane >> 4, ct = half * 4 + (wave & 3), c0 = ct * 16;
    if (!cw) {
        const int lt = tid - 256, wrow = lt >> 4, wc16 = lt & 15, arow = lt >> 3, ac16 = lt & 7;
        const int wperm = (wc16 >> 2) * 32 + ((((wc16 & 3) * 8) & 15) >> 2) * 8 + (((wc16 & 3) * 8) >> 4) * 4, aperm = (ac16 >> 2) * 32 + ((((ac16 & 3) * 8) & 15) >> 2) * 8 + (((ac16 & 3) * 8) >> 4) * 4;
        const unsigned oW = (unsigned)TR_W + (unsigned)(wrow * 128 + wc16 * 8) * 2u, oQ = oW + (unsigned)(TR_Q - TR_W), oA = (unsigned)TR_A + (unsigned)(arow * 64 + ac16 * 8) * 2u, oK = oA + (unsigned)(TR_K - TR_A);
        const unsigned lW = (unsigned)(wrow * PS + wperm) * 2u, lA = (unsigned)(arow * TS + aperm) * 2u;
        u32x4 sa[14], sb[14];
#define L_LOAD(nn, d) do { const unsigned char* tr_ = P.tr + (size_t)((b << 8) | ((nn) << 3) | h) * TR_SZ; \
            _Pragma("unroll") for (int i = 0; i < 4; ++i) { d[i] = *(const u32x4*)(tr_ + (oW + 4096u * i)); d[4 + i] = *(const u32x4*)(tr_ + (oQ + 4096u * i)); d[10 + i] = *(const u32x4*)(tr_ + (oK + 4096u * i)); } \
            d[8] = *(const u32x4*)(tr_ + oA); d[9] = *(const u32x4*)(tr_ + (oA + 4096u)); } while (0)
#define ST2(base, boff, v) do { *(LAS u32x2*)((base) + (boff)) = (u32x2){(v).x, (v).y}; *(LAS u32x2*)((base) + (boff) + 16u) = (u32x2){(v).z, (v).w}; } while (0)
#define L_STORE(bufp, s_) do { LAS unsigned char* bp_ = (bufp); \
            _Pragma("unroll") for (int i = 0; i < 4; ++i) { ST2(bp_ + SB_W, lW + (unsigned)(16 * PS * 2 * i), s_[i]); ST2(bp_ + SB_Q, lW + (unsigned)(16 * PS * 2 * i), s_[4 + i]); ST2(bp_ + SB_K, lA + (unsigned)(32 * TS * 2 * i), s_[10 + i]); } \
            ST2(bp_ + SB_A, lA, s_[8]); ST2(bp_ + SB_A, lA + (unsigned)(32 * TS * 2), s_[9]); } while (0)
        L_LOAD(0, sa); L_STORE(lds, sa); L_LOAD(1, sa);
        __syncthreads();
#pragma unroll 1
        for (int n = 0; n < 32; n += 2) {
            if (n + 2 < 32) L_LOAD(n + 2, sb);
            L_STORE(lds + ((n + 1) & 1) * SB_SZ, sa);
            LBAR();
            if (n + 3 < 32) L_LOAD(n + 3, sa);
            if (n + 2 < 32) L_STORE(lds + ((n + 2) & 1) * SB_SZ, sb);
            LBAR();
        }
#undef L_LOAD
#undef L_STORE
#undef ST2
    } else {
        f32x4 S[8];
#pragma unroll
        for (int i = 0; i < 8; ++i) S[i] = (f32x4){0.f, 0.f, 0.f, 0.f};
        const float glv = (lane < 32) ? P.gl[(b << 8) | (lane << 3) | h] : 0.f;
        f32x4 ubn[4];
        const unsigned oU = (unsigned)TR_U + (unsigned)(ct * 256 + lane) * 16u;
#define U_LOAD(nn) do { const unsigned char* tr_ = P.tr + (size_t)((b << 8) | ((nn) << 3) | h) * TR_SZ; \
            _Pragma("unroll") for (int mt_ = 0; mt_ < 4; ++mt_) ubn[mt_] = *(const f32x4*)(tr_ + (oU + (unsigned)mt_ * 1024u)); } while (0)
        U_LOAD(0);
        __syncthreads();
#pragma unroll 1
        for (int n = 0; n < 32; ++n) {
            LAS unsigned char* buf = lds + (n & 1) * SB_SZ;
            const LAS bf16_t* Wl = (const LAS bf16_t*)(buf + SB_W); const LAS bf16_t* Ql = (const LAS bf16_t*)(buf + SB_Q);
            const LAS bf16_t* Al = (const LAS bf16_t*)(buf + SB_A); const LAS bf16_t* Kl = (const LAS bf16_t*)(buf + SB_K);
            f32x4 u[4], o[4];
#pragma unroll
            for (int mt = 0; mt < 4; ++mt) { u[mt] = ubn[mt]; o[mt] = (f32x4){0.f, 0.f, 0.f, 0.f}; }
            if (n + 1 < 32) U_LOAD(n + 1);
        bf16x8 Sb[4];
#pragma unroll
        for (int ks = 0; ks < 4; ++ks) Sb[ks] = packB(S[2 * ks], S[2 * ks + 1]);
#define SBAR() __builtin_amdgcn_sched_barrier(0)
#define LD4(d, base, mt, stride) do { _Pragma("unroll") for (int ks = 0; ks < 4; ++ks) d[ks] = frag1((base) + ((mt) * 16 + r) * (stride) + ks * 32 + q8 * 8); } while (0)
#define MM4(acc, s_) do { _Pragma("unroll") for (int ks = 0; ks < 4; ++ks) acc = __builtin_amdgcn_mfma_f32_16x16x32_bf16(s_[ks], Sb[ks], acc, 0, 0, 0); } while (0)
        {
            bf16x8 fA[4], fB[4];
            LD4(fA, Wl, 0, PS); SBAR(); LD4(fB, Ql, 0, PS); SBAR();
            MM4(u[0], fA); SBAR(); LD4(fA, Wl, 1, PS); SBAR(); MM4(o[0], fB); SBAR(); LD4(fB, Ql, 1, PS); SBAR();
            MM4(u[1], fA); SBAR(); LD4(fA, Wl, 2, PS); SBAR(); MM4(o[1], fB); SBAR(); LD4(fB, Ql, 2, PS); SBAR();
            MM4(u[2], fA); SBAR(); LD4(fA, Wl, 3, PS); SBAR(); MM4(o[2], fB); SBAR(); LD4(fB, Ql, 3, PS); SBAR();
            MM4(u[3], fA); SBAR(); MM4(o[3], fB); SBAR();
        }
        bf16x8 Ub[2];
        Ub[0] = packB(u[0], u[1]); Ub[1] = packB(u[2], u[3]);
        const float gl = __shfl(glv, n);
#define LDK(d, dt0) do { d[0] = frag1(Kl + ((dt0) * 16 + r) * TS + q8 * 8); d[1] = frag1(Kl + ((dt0) * 16 + r) * TS + 32 + q8 * 8); d[2] = frag1(Kl + (((dt0) + 1) * 16 + r) * TS + q8 * 8); d[3] = frag1(Kl + (((dt0) + 1) * 16 + r) * TS + 32 + q8 * 8); } while (0)
#define MMK(s_, dt0) do { S[dt0] = S[dt0] * gl; S[(dt0) + 1] = S[(dt0) + 1] * gl; \
            S[dt0] = __builtin_amdgcn_mfma_f32_16x16x32_bf16(s_[0], Ub[0], S[dt0], 0, 0, 0); S[(dt0) + 1] = __builtin_amdgcn_mfma_f32_16x16x32_bf16(s_[2], Ub[0], S[(dt0) + 1], 0, 0, 0); \
            S[dt0] = __builtin_amdgcn_mfma_f32_16x16x32_bf16(s_[1], Ub[1], S[dt0], 0, 0, 0); S[(dt0) + 1] = __builtin_amdgcn_mfma_f32_16x16x32_bf16(s_[3], Ub[1], S[(dt0) + 1], 0, 0, 0); } while (0)
        {
            bf16x8 aA[6], kA[4], kB[4];
            aA[0] = frag1(Al + (0 * 16 + r) * TS + q8 * 8); aA[1] = frag1(Al + (1 * 16 + r) * TS + q8 * 8);
            aA[2] = frag1(Al + (2 * 16 + r) * TS + q8 * 8); aA[3] = frag1(Al + (2 * 16 + r) * TS + 32 + q8 * 8);
            aA[4] = frag1(Al + (3 * 16 + r) * TS + q8 * 8); aA[5] = frag1(Al + (3 * 16 + r) * TS + 32 + q8 * 8);
            SBAR(); LDK(kA, 0); SBAR();
            o[0] = __builtin_amdgcn_mfma_f32_16x16x32_bf16(aA[0], Ub[0], o[0], 0, 0, 0); o[1] = __builtin_amdgcn_mfma_f32_16x16x32_bf16(aA[1], Ub[0], o[1], 0, 0, 0);
            o[2] = __builtin_amdgcn_mfma_f32_16x16x32_bf16(aA[2], Ub[0], o[2], 0, 0, 0); o[3] = __builtin_amdgcn_mfma_f32_16x16x32_bf16(aA[4], Ub[0], o[3], 0, 0, 0);
            o[2] = __builtin_amdgcn_mfma_f32_16x16x32_bf16(aA[3], Ub[1], o[2], 0, 0, 0); o[3] = __builtin_amdgcn_mfma_f32_16x16x32_bf16(aA[5], Ub[1], o[3], 0, 0, 0);
            SBAR(); LDK(kB, 2); SBAR(); MMK(kA, 0); SBAR(); LDK(kA, 4); SBAR(); MMK(kB, 2); SBAR(); LDK(kB, 6); SBAR(); MMK(kA, 4); SBAR(); MMK(kB, 6); SBAR();
        }
#undef LD4
#undef MM4
#undef LDK
#undef MMK
#undef SBAR
        { unsigned oO = (unsigned)((q8 * 4) * 1024 + c0 + r) * 4u; asm volatile("" : "+v"(oO));
          unsigned char* ob = (unsigned char*)(P.obuf + (size_t)(b * SEQ + n * 64) * 1024 + h * 128);
#pragma unroll
          for (int mt = 0; mt < 4; ++mt)
#pragma unroll
              for (int j = 0; j < 4; ++j) *(float*)(ob + (oO + (unsigned)(mt * 16 + j) * 4096u)) = o[mt][j]; }
            LBAR();
        }
#undef U_LOAD
#pragma unroll
        for (int dt = 0; dt < 8; ++dt)
#pragma unroll
            for (int j = 0; j < 4; ++j) P.sout[(size_t)(dt * 16 + q8 * 4 + j) * HD + c0 + r] = S[dt][j];
    }
    __syncthreads();
}
__device__ __forceinline__ void onorm_pass(const float* obuf, const bf16_t* z, const float* ong, bf16_t* ycat, int gw, int NGW, int lane) {
    const int cl = (lane & 7) * 16;
    f32x4 g[4];
#pragma unroll
    for (int i = 0; i < 4; ++i) g[i] = *(const f32x4*)(ong + cl + 4 * i);
#pragma unroll 2
    for (int row = gw; row < MP; row += NGW) {
        const float* op = obuf + (size_t)row * 1024 + lane * 16; const bf16_t* zp = z + (size_t)row * NZ + 7168 + lane * 16;
        f32x4 v[4]; float ss = 0.f;
#pragma unroll
        for (int i = 0; i < 4; ++i) { v[i] = *(const f32x4*)(op + 4 * i); ss += (v[i].x * v[i].x + v[i].y * v[i].y) + (v[i].z * v[i].z + v[i].w * v[i].w); }
        const u32x4 g0 = *(const u32x4*)zp, g1 = *(const u32x4*)(zp + 8);
        ss += __builtin_bit_cast(float, __builtin_amdgcn_update_dpp(0, __builtin_bit_cast(int, ss), 0xB1, 0xF, 0xF, true));
        ss += __builtin_bit_cast(float, __builtin_amdgcn_update_dpp(0, __builtin_bit_cast(int, ss), 0x4E, 0xF, 0xF, true));
        ss += __builtin_bit_cast(float, __builtin_amdgcn_update_dpp(0, __builtin_bit_cast(int, ss), 0x141, 0xF, 0xF, true));
        const float rstd = rsq_f(ss * (1.f / HD) + EPS);
        float y[16];
        y[0] = v[0].x * rstd * g[0].x * silu_f(bflo(g0.x)); y[1] = v[0].y * rstd * g[0].y * silu_f(bfhi(g0.x)); y[2] = v[0].z * rstd * g[0].z * silu_f(bflo(g0.y)); y[3] = v[0].w * rstd * g[0].w * silu_f(bfhi(g0.y));
        y[4] = v[1].x * rstd * g[1].x * silu_f(bflo(g0.z)); y[5] = v[1].y * rstd * g[1].y * silu_f(bfhi(g0.z)); y[6] = v[1].z * rstd * g[1].z * silu_f(bflo(g0.w)); y[7] = v[1].w * rstd * g[1].w * silu_f(bfhi(g0.w));
        y[8] = v[2].x * rstd * g[2].x * silu_f(bflo(g1.x)); y[9] = v[2].y * rstd * g[2].y * silu_f(bfhi(g1.x)); y[10] = v[2].z * rstd * g[2].z * silu_f(bflo(g1.y)); y[11] = v[2].w * rstd * g[2].w * silu_f(bfhi(g1.y));
        y[12] = v[3].x * rstd * g[3].x * silu_f(bflo(g1.z)); y[13] = v[3].y * rstd * g[3].y * silu_f(bfhi(g1.z)); y[14] = v[3].z * rstd * g[3].z * silu_f(bflo(g1.w)); y[15] = v[3].w * rstd * g[3].w * silu_f(bfhi(g1.w));
        bf16_t* yp = ycat + (size_t)row * DM + 1024 + lane * 16;
        *(u32x4*)yp = pack8(y); *(u32x4*)(yp + 8) = pack8(y + 8);
    }
}
struct SampP { const float* zs; const float* sca; const float* scq; const float* s0; const float* caw; const float* cqw; const float* alog; const float* dtb; const float* ong;
               bf16_t* ycat; float* oca; float* ocq; float* oss; };
__device__ __forceinline__ void sample_task(LAS unsigned char* lds, const SampP& P, int task, int tid, int lane, int wave) {
    const int h = task & 7, bs = task >> 3;
    LAS float* qv = (LAS float*)lds; LAS float* kv = qv + 128; LAS float* vv = kv + 128; LAS float* part = vv + 128; LAS float* pks = part + 16; LAS float* pqs = pks + 1024;
    const float* s0 = P.s0 + (size_t)(bs * 8 + h) * 16384; float* so = P.oss + (size_t)(bs * 8 + h) * 16384;
    const int half = lane >> 5, c4 = (lane & 31) * 4;
    f32x4 sr[8];
#pragma unroll
    for (int i = 0; i < 8; ++i) sr[i] = *(const f32x4*)(s0 + (size_t)(wave * 16 + 2 * i + half) * 128 + c4);
    const float* zr = P.zs + (size_t)bs * DINP;
    const float zbeta = zr[8192 + h], zalpha = zr[8200 + h], alg = P.alog[h], dtbv = P.dtb[h];
    f32x4 ongv = {0.f, 0.f, 0.f, 0.f}, gbv = {0.f, 0.f, 0.f, 0.f};
    if (wave == 0 && lane < 32) { ongv = *(const f32x4*)(P.ong + c4); gbv = *(const f32x4*)(zr + 7168 + h * 128 + c4); }
    float qkv[3] = {0.f, 0.f, 0.f};
    if (tid < 128) {
        const int cc = h * 128 + tid;
        { const float ch = zr[1024 + cc] * zr[2048 + cc]; const float s0a = P.sca[(bs * 2 + 0) * 1024 + cc], s1a = P.sca[(bs * 2 + 1) * 1024 + cc];
          const float conv = P.caw[cc] * s0a + P.caw[1024 + cc] * s1a + P.caw[2048 + cc] * ch;
          P.ycat[(size_t)(MP + bs) * DM + cc] = f2bf(zr[cc] * conv * silu_f(zr[3072 + cc]));
          P.oca[(bs * 2 + 0) * 1024 + cc] = s1a; P.oca[(bs * 2 + 1) * 1024 + cc] = ch; }
#pragma unroll
        for (int m = 0; m < 3; ++m) { const int c3 = m * 1024 + cc; const float pre = zr[4096 + c3];
            const float a0 = P.scq[(bs * 3 + 0) * 3072 + c3], a1 = P.scq[(bs * 3 + 1) * 3072 + c3], a2 = P.scq[(bs * 3 + 2) * 3072 + c3];
            qkv[m] = silu_f(P.cqw[c3] * a0 + P.cqw[3072 + c3] * a1 + P.cqw[2 * 3072 + c3] * a2 + P.cqw[3 * 3072 + c3] * pre);
            P.ocq[(bs * 3 + 0) * 3072 + c3] = a1; P.ocq[(bs * 3 + 1) * 3072 + c3] = a2; P.ocq[(bs * 3 + 2) * 3072 + c3] = pre; }
        const float sq = wave_sum(qkv[0] * qkv[0]), sk = wave_sum(qkv[1] * qkv[1]);
        if (lane == 0) { part[wave * 2] = sq; part[wave * 2 + 1] = sk; }
    }
    __syncthreads();
    if (tid < 128) { const float sq = part[0] + part[2], sk = part[1] + part[3];
        qv[tid] = qkv[0] * rsq_f(sq + EPS) * 0.08838834764831845f; kv[tid] = qkv[1] * rsq_f(sk + EPS); vv[tid] = qkv[2]; }
    __syncthreads();
    f32x4 pk = {0.f, 0.f, 0.f, 0.f}, pq = {0.f, 0.f, 0.f, 0.f};
#pragma unroll
    for (int i = 0; i < 8; ++i) { const int row = wave * 16 + 2 * i + half; pk += kv[row] * sr[i]; pq += qv[row] * sr[i]; }
#pragma unroll
    for (int e = 0; e < 4; ++e) { pk[e] += __shfl_xor(pk[e], 32); pq[e] += __shfl_xor(pq[e], 32); }
    if (lane < 32) { *(LAS f32x4*)(pks + wave * 128 + c4) = pk; *(LAS f32x4*)(pqs + wave * 128 + c4) = pq; }
    const float qk = wave_sum(qv[lane] * kv[lane] + qv[lane + 64] * kv[lane + 64]);
    __syncthreads();
    f32x4 ks = {0.f, 0.f, 0.f, 0.f}, qs = {0.f, 0.f, 0.f, 0.f};
#pragma unroll
    for (int w = 0; w < 8; ++w) { ks += *(const LAS f32x4*)(pks + w * 128 + c4); qs += *(const LAS f32x4*)(pqs + w * 128 + c4); }
    const float beta = sigmoid_f(zbeta);
    const float eg = exp_f(-exp_f(alg) * softplus_f(zalpha + dtbv));
    const f32x4 v4 = *(const LAS f32x4*)(vv + c4);
    const f32x4 u = beta * (v4 - eg * ks);
    const f32x4 o = eg * qs + qk * u;
#pragma unroll
    for (int i = 0; i < 8; ++i) { const int row = wave * 16 + 2 * i + half; *(f32x4*)(so + (size_t)row * 128 + c4) = eg * sr[i] + kv[row] * u; }
    if (wave == 0) {
        float ss = (lane < 32) ? (o.x * o.x + o.y * o.y) + (o.z * o.z + o.w * o.w) : 0.f;
        const float rstd = rsq_f(wave_sum(ss) * (1.f / HD) + EPS);
        if (lane < 32) { const f32x4 g = ongv, gb = gbv;
            u32x2 w; w.x = pk2(o.x * rstd * g.x * silu_f(gb.x), o.y * rstd * g.y * silu_f(gb.y)); w.y = pk2(o.z * rstd * g.z * silu_f(gb.z), o.w * rstd * g.w * silu_f(gb.w));
            *(u32x2*)(P.ycat + (size_t)(MP + bs) * DM + 1024 + h * 128 + c4) = w; }
    }
    __syncthreads();
}

struct Args { const float* in[18]; float* out; unsigned char* ws; };
#define GAS __attribute__((address_space(1)))
struct ArgsG { const GAS float* in[18]; GAS float* out; GAS unsigned char* ws; };
__global__ void __launch_bounds__(512, 2) mega(Args a) {
    extern __shared__ __attribute__((aligned(16))) unsigned char lds_raw[];
    cg::grid_group grid = cg::this_grid();
    LAS unsigned char* lds = (LAS unsigned char*)lds_raw;
    constexpr int G = 256, NGW = G * 8, GT = G * 512;
    const int bx0 = blockIdx.x, wave0 = __builtin_amdgcn_readfirstlane(threadIdx.x >> 6);
    const ArgsG* ap0 = (const ArgsG*)__builtin_amdgcn_kernarg_segment_ptr();
#define FRESH() unsigned m_ = ~0u; asm volatile("" : "+s"(m_)); int tid = (wave0 << 6) | (int)__builtin_amdgcn_mbcnt_hi(m_, __builtin_amdgcn_mbcnt_lo(m_, 0u)); asm volatile("" : "+v"(tid)); FRESH_S(); const int lane = tid & 63, wave = __builtin_amdgcn_readfirstlane(tid >> 6), gw = bx * 8 + wave, gt = bx * 512 + tid; (void)lane; (void)gw; (void)gt
#define FRESH_S() int bx = bx0; const ArgsG* ap = ap0; asm volatile("" : "+s"(bx), "+s"(ap)); unsigned char* ws = (unsigned char*)ap->ws
#define GBAR() do { FRESH_S(); XcdBarrier xb_; xb_.bar = (unsigned*)(ws + WS_CTL); xb_.x = xb_xcc_id(); xb_.st = (volatile LAS unsigned*)(lds + 131072 + 32); xcd_barrier(xb_); } while (0)
#define WSP(T, off) ((T*)(ws + (off)))
    { volatile LAS unsigned* misc = (volatile LAS unsigned*)(lds + 131072); if (threadIdx.x < 32) misc[threadIdx.x] = 0u; __syncthreads();
      (void)xcd_barrier_post((unsigned*)((unsigned char*)ap0->ws + WS_CTL), misc + 8); }
    constexpr int I_IN = 32 * 257, I_OUT = 32 * 64, I_ADA = 32 * 192;
    {
        FRESH();
        LAS float* scr = (LAS float*)(lds + wave * 16384);
#pragma unroll 1
        for (int it = gw; it < 4 * I_ADA; it += NGW) { const int l = it / I_ADA, r = it - l * I_ADA;
            transpose_item(((const float*)ap->in[8]) + (size_t)l * DM * 3 * DM, DM, 3 * DM, WSP(bf16_t, WS_WADA) + (size_t)l * 3 * DM * DM, scr, r, lane); }
        const float* c_prompt = ((const float*)ap->in[5]); const float* c_sample = ((const float*)ap->in[6]); bf16_t* ca = WSP(bf16_t, WS_CA);
        for (int idx = gt; idx < (NB + DECB) * DM; idx += GT) { const int row = idx >> 11, c = idx & 2047;
            const float v = row < NB ? c_prompt[row * DM + c] : c_sample[(row - NB) * DM + c]; ca[idx] = f2bf(silu_f(v)); }
    }
    if (ap0->out == nullptr) grid.sync();
    GBAR();
    {
        FRESH();
        constexpr int NGEMM = MODLD / 256, NIT2 = 4 * (I_IN + I_OUT), N1 = 35000;
        if (bx < NGEMM) {
            pg8::Gemm g{WSP(bf16_t, WS_CA), WSP(bf16_t, WS_WADA), 256, MODLD, DM}; pg8::StaticOrder S; S.init(256, MODLD, G, bx);
            EpiF32Bias E{WSP(float, WS_MOD), MODLD, ((const float*)ap->in[9])};
            pg8::gemm_phase<EpiF32Bias, pg8::StaticOrder, true, true>(lds, g, S, E, tid);
        }
        LAS float* scr = (LAS float*)(lds + wave * 16384);
        const int it0 = bx < NGEMM ? N1 + bx * 8 + wave : (bx - NGEMM) * 8 + wave, itN = bx < NGEMM ? NIT2 : N1, its = bx < NGEMM ? NGEMM * 8 : (G - NGEMM) * 8;
#pragma unroll 1
        for (int it = it0; it < itN; it += its) {
            int r = it;
            if (r < 4 * I_IN) { const int l = r / I_IN; r -= l * I_IN; transpose_item(((const float*)ap->in[10]) + (size_t)l * DM * DIN, DM, DIN, WSP(bf16_t, WS_WIN) + (size_t)l * DINP * DM, scr, r, lane); }
            else { r -= 4 * I_IN; const int l = r / I_OUT; r -= l * I_OUT; transpose_item(((const float*)ap->in[16]) + (size_t)l * DM * DM, DM, DM, WSP(bf16_t, WS_WOUT) + (size_t)l * DM * DM, scr, r, lane); }
        }
    }
    GBAR();
#pragma unroll 1
    for (int l = 0; l < DEPTH; ++l) {
        {
            FRESH();
            float* xcur = WSP(float, WS_X);
            phase_norm(l == 0 ? ((const float*)ap->in[0]) : xcur, l == 0 ? ((const float*)ap->in[1]) : xcur + (size_t)MP * DM, ((const float*)ap->in[7]) + l * DM, WSP(float, WS_MOD) + (size_t)l * 3 * DM, WSP(bf16_t, WS_HB), gw, NGW, lane);
        }
        GBAR();
        {
            FRESH();
            const bf16_t* Wi = WSP(bf16_t, WS_WIN) + (size_t)l * DINP * DM; const bf16_t* hb = WSP(bf16_t, WS_HB);
            {
                pg8::Gemm g{hb, Wi, MP, NZ, DM}; pg8::StaticOrder S; S.init(MP, NZ, G, bx);
                pg8::EpiBf16<0> E{WSP(bf16_t, WS_Z), NZ, nullptr, 0, 0, 1.f};
                pg8::gemm_phase<pg8::EpiBf16<0>, pg8::StaticOrder, true, true>(lds, g, S, E, tid);
            }
            float* zs = WSP(float, WS_ZS); float* ba = WSP(float, WS_BA);
            const int r = lane & 15, q8 = lane >> 4;
#pragma unroll 1
            for (int task = bx; task < NZ / 32; task += G) sample_gemm32(lds, hb + (size_t)MP * DM, Wi + (size_t)task * 32 * DM, zs, DINP, task * 32, tid, lane, wave);
            for (int task = wave * G + bx; task < 8 + MP / 16; task += NGW) {
                if (task < 8) { const int mt = task;
                    const f32x4 acc = skinny16(hb + (size_t)(MP + mt * 16) * DM, DM, Wi + (size_t)NZ * DM, DM, DM, lane);
#pragma unroll
                    for (int j = 0; j < 4; ++j) zs[(size_t)(mt * 16 + q8 * 4 + j) * DINP + NZ + r] = acc[j];
                } else { const int pt = task - 8;
                    const f32x4 acc = skinny16(hb + (size_t)pt * 16 * DM, DM, Wi + (size_t)NZ * DM, DM, DM, lane);
#pragma unroll
                    for (int j = 0; j < 4; ++j) ba[(size_t)(pt * 16 + q8 * 4 + j) * 16 + r] = acc[j];
                }
            }
        }
        GBAR();
        {
            FRESH();
            const bf16_t* z = WSP(bf16_t, WS_Z);
            PrepP P{z, WSP(float, WS_BA), ((const float*)ap->in[12]) + (size_t)l * 4 * 3072, ((const float*)ap->in[13]) + l * NH, ((const float*)ap->in[14]) + l * NH, WSP(unsigned char, WS_TR), WSP(float, WS_GL)};
            prep_weights(lds, P.cw, bx & 7, tid);
#pragma unroll 1
            for (int task = bx; task < NB * 32 * NH; task += G) prep_task(lds, P, task, tid, lane, wave);
        }
        GBAR();
        if (bx0 < 2 * NB * NH) {
            FRESH();
            const int b = bx >> 4, h = (bx >> 1) & 7, half = bx & 1;
            ScanP P{WSP(unsigned char, WS_TR), WSP(float, WS_GL), WSP(float, WS_OB), ((float*)ap->out) + O_SP + ((size_t)(l * NB + b) * NH + h) * HD * HD};
            scan_bh(lds, P, b, h, half, tid, lane, wave);
        } else {
            FRESH();
            SampP P{WSP(float, WS_ZS), ((const float*)ap->in[2]) + (size_t)l * DECB * 2 * 1024, ((const float*)ap->in[3]) + (size_t)l * DECB * 3 * 3072, ((const float*)ap->in[4]) + (size_t)l * DECB * NH * HD * HD, ((const float*)ap->in[11]) + (size_t)l * 3 * 1024,
                    ((const float*)ap->in[12]) + (size_t)l * 4 * 3072, ((const float*)ap->in[13]) + l * NH, ((const float*)ap->in[14]) + l * NH, ((const float*)ap->in[15]) + l * HD, WSP(bf16_t, WS_YCAT), ((float*)ap->out) + O_CAS + (size_t)l * DECB * 2 * 1024,
                    ((float*)ap->out) + O_CQS + (size_t)l * DECB * 3 * 3072, ((float*)ap->out) + O_SS + (size_t)l * DECB * NH * HD * HD};
#pragma unroll 1
            for (int task = bx - 2 * NB * NH; task < DECB * NH; task += G - 2 * NB * NH) sample_task(lds, P, task, tid, lane, wave);
            { constexpr int GT2 = (G - 2 * NB * NH) * 512; const int gt2 = (bx - 2 * NB * NH) * 512 + tid; const bf16_t* z = WSP(bf16_t, WS_Z);
              conva_prompt(z, ((const float*)ap->in[11]) + (size_t)l * 3 * 1024, WSP(bf16_t, WS_YCAT), gt2, GT2);
              conv_states_prompt(z, ((float*)ap->out) + O_CAP + (size_t)l * NB * 2 * 1024, ((float*)ap->out) + O_CQP + (size_t)l * NB * 3 * 3072, gt2, GT2); }
        }
        GBAR();
        {
            FRESH();
            if (wave >= 4) onorm_pass(WSP(float, WS_OB), WSP(bf16_t, WS_Z), ((const float*)ap->in[15]) + l * HD, WSP(bf16_t, WS_YCAT), bx * 4 + (wave - 4), G * 4, lane);
            else {
                const bf16_t* Wo = WSP(bf16_t, WS_WOUT) + (size_t)l * DM * DM; const bf16_t* ycat = WSP(bf16_t, WS_YCAT); float* xcur = WSP(float, WS_X);
                const float* modg = WSP(float, WS_MOD) + (size_t)l * 3 * DM + 2 * DM;
                const int r = lane & 15, q8 = lane >> 4;
                const float* xb = l == 0 ? ((const float*)ap->in[1]) : xcur + (size_t)MP * DM;
                const int task = wave * G + bx, mt = task & 7, nt = task >> 3;
                const f32x4 acc = skinny16(ycat + (size_t)(MP + mt * 16) * DM, DM, Wo + (size_t)nt * 16 * DM, DM, DM, lane);
#pragma unroll
                for (int j = 0; j < 4; ++j) { const int row = mt * 16 + q8 * 4 + j, col = nt * 16 + r;
                    xcur[(size_t)(MP + row) * DM + col] = xb[(size_t)row * DM + col] + modg[(size_t)(NB + row) * MODLD + col] * acc[j]; }
            }
        }
        GBAR();
        {
            FRESH();
            const bf16_t* Wo = WSP(bf16_t, WS_WOUT) + (size_t)l * DM * DM; const bf16_t* ycat = WSP(bf16_t, WS_YCAT); float* xcur = WSP(float, WS_X);
            const float* modg = WSP(float, WS_MOD) + (size_t)l * 3 * DM + 2 * DM;
            {
                pg8::Gemm g{ycat, Wo, MP, DM, DM}; pg8::StaticOrder S; S.init(MP, DM, G, bx);
                EpiResGate E{l == 0 ? ((const float*)ap->in[0]) : xcur, xcur, modg, DM};
                pg8::gemm_phase<EpiResGate, pg8::StaticOrder, true, true>(lds, g, S, E, tid);
            }
        }
        GBAR();
    }
    { FRESH(); phase_final(WSP(float, WS_X), ((const float*)ap->in[17]), ((float*)ap->out), gw, NGW, lane); }
#undef FRESH
#undef GBAR
#undef WSP
}

extern "C" void kernel_launch(void* const* d_in, const int* in_sizes, int n_in, void* d_out, int out_size, void* d_ws, size_t ws_size, hipStream_t stream) {
    static int grid = 0;
    if (!grid) {
        if (n_in != 18 || (size_t)out_size != O_END || ws_size < WS_END) { fprintf(stderr, "kernel_launch: unexpected shapes (n_in %d out %d ws %zu)\n", n_in, out_size, ws_size); grid = -1; return; }
        int dev = 0, cus = 0, per_cu = 0;
        (void)hipGetDevice(&dev);
        (void)hipDeviceGetAttribute(&cus, hipDeviceAttributeMultiprocessorCount, dev);
        (void)hipFuncSetAttribute((const void*)mega, hipFuncAttributeMaxDynamicSharedMemorySize, LDS_BYTES);
        (void)hipOccupancyMaxActiveBlocksPerMultiprocessor(&per_cu, (const void*)mega, 512, LDS_BYTES);
        if (per_cu < 1) per_cu = 1;
        grid = cus * per_cu;
        if (grid != 256) { fprintf(stderr, "kernel_launch: this kernel is built for a 256-workgroup grid (256 CUs x 1), got %d\n", grid); grid = -1; return; }
        fprintf(stderr, "kernel_launch: grid %d (cus %d per_cu %d)\n", grid, cus, per_cu);
    }
    if (grid < 0) return;
    if (hipMemsetAsync((char*)d_ws + WS_CTL, 0, 16384, stream) != hipSuccess) { fprintf(stderr, "kernel_launch: memset of the barrier words failed\n"); return; }
    Args a{};
    for (int i = 0; i < 18; ++i) a.in[i] = (const float*)d_in[i];
    a.out = (float*)d_out; a.ws = (unsigned char*)d_ws;
    void* args[] = {&a};
    hipError_t e = hipLaunchCooperativeKernel((void*)mega, dim3(grid), dim3(512), args, LDS_BYTES, stream);
    if (e != hipSuccess) fprintf(stderr, "cooperative launch failed: %s (grid %d)\n", hipGetErrorString(e), grid);
}
```

```cpp
#include <hip/hip_runtime.h>
#include <hip/hip_cooperative_groups.h>
#include <cstdio>
#include <cstdint>
namespace cg = cooperative_groups;
namespace pg8 {
#define PG8_LAS __attribute__((address_space(3)))
typedef unsigned short bf16_t;
typedef short bf16x8 __attribute__((ext_vector_type(8)));
typedef float f32x4 __attribute__((ext_vector_type(4)));
typedef unsigned u32x4 __attribute__((ext_vector_type(4)));
constexpr int BM = 256, BK = 64, HALF = 128, HTB = HALF * BK * 2  , STAGE_BYTES = 8 * HTB, NXCD = 8, WGM = 8;

__host__ __device__ __forceinline__ int lds_byte(int r, int c) { const int st = (r >> 4) * 2 + (c >> 5), rr = r & 15, cc = c & 31, ob = rr * 64 + cc * 2; return st * 1024 + (ob ^ (((ob >> 9) & 1) << 5)); }
__host__ __device__ __forceinline__ void stage_rc(int b, int& R, int& C) { const int st = b / 1024, sb = b % 1024, swz = sb ^ (((sb >> 9) & 1) << 5); R = (st >> 1) * 16 + swz / 64; C = (st & 1) * 32 + (swz % 64) / 2; }
__host__ __device__ __forceinline__ int perm32(int rho) { const int n = rho >> 4, i = rho & 15; return 8 * (i >> 2) + 4 * n + (i & 3); }

struct Unit { int pm, pn; };
struct Gemm { const bf16_t* A; const bf16_t* Bt; int M, N, K; };

struct StaticOrder {
    int nM, nN, nwg, G, c;
    __host__ __device__ void init(int M, int N, int G_, int c_) { nM = M / BM; nN = N / BM; nwg = nM * nN; G = G_; c = c_; }
    __host__ __device__ bool next(int i, Unit& u) const {
        const long L = (long)i * G + c; if (L >= nwg) return false;
        int wgid = (int)L; { const int q = nwg / NXCD, r = nwg % NXCD, xcd = wgid % NXCD, off = wgid / NXCD; wgid = (xcd < r ? xcd * (q + 1) : r * (q + 1) + (xcd - r) * q) + off; }
        const int nig = WGM * nN, gid = wgid / nig, fm = gid * WGM, gsz = (nM - fm) < WGM ? (nM - fm) : WGM;
        u.pm = fm + ((wgid % nig) % gsz); u.pn = (wgid % nig) / gsz; return true;
    }
    __device__ __forceinline__ void a_ready(const Unit&) const {}
    __device__ __forceinline__ void done(const Unit&) const {}
};

__device__ __forceinline__ unsigned cvt_pk_bf16(float lo, float hi) { unsigned r; asm("v_cvt_pk_bf16_f32 %0, %1, %2" : "=v"(r) : "v"(lo), "v"(hi)); return r; }
typedef float f32x2 __attribute__((ext_vector_type(2)));
__device__ __forceinline__ f32x2 gelu_pk(f32x2 v) {
    const f32x2 av = __builtin_elementwise_abs(v), d = av * 0.2316418882f + 1.0f;
    f32x2 t; t.x = __builtin_amdgcn_rcpf(d.x); t.y = __builtin_amdgcn_rcpf(d.y);
    f32x2 q = t * 0.5307027145f + (-0.7265760135f); q = q * t + 0.7107068705f; q = q * t + (-0.142248368f); q = q * t + 0.127414796f; q = q * t;
    const f32x2 s = (v * v) * (-0.72134752044f);
    f32x2 e; e.x = __builtin_amdgcn_exp2f(s.x); e.y = __builtin_amdgcn_exp2f(s.y);
    const f32x2 m = v * (q * e), r = v - m;
    f32x2 o; o.x = v.x < 0.f ? m.x : r.x; o.y = v.y < 0.f ? m.y : r.y; return o;
}

template <int ACT  > struct EpiBf16 {
    static constexpr bool PERM = true, AFTER_DRAIN = false; static_assert(ACT == 0 || ACT == 1, "EpiBf16: ACT is 0 (none) or 1 (gelu_pk)");
    bf16_t* O; int ldc; const float* bias; int split_cols; size_t split_stride; float scale0;
    __device__ __forceinline__ void operator()(const f32x4 (&acc)[2][2][4][2], const Unit& u, int wr, int wc, int fr, int fq) const {
        const int row0 = u.pm * BM + wr * 64 + fr; int colt = u.pn * BM; bf16_t* base = O;
        float sc = 1.f; if (split_cols) { const int t = colt / split_cols; base += (size_t)t * split_stride; colt -= t * split_cols; if (t == 0) sc = scale0; }
        const int col0 = colt + wc * 32 + 8 * fq, bcol0 = u.pn * BM + wc * 32 + 8 * fq;
        f32x4 bv[2][2];
#pragma unroll
        for (int bj = 0; bj < 2; ++bj)
#pragma unroll
            for (int n = 0; n < 2; ++n) bv[bj][n] = bias ? *(const f32x4*)(bias + bcol0 + bj * HALF + 4 * n) : (f32x4){0.f, 0.f, 0.f, 0.f};
#pragma unroll
        for (int ai = 0; ai < 2; ++ai)
#pragma unroll
            for (int m = 0; m < 4; ++m) { bf16_t* rowp = base + (size_t)(row0 + ai * HALF + m * 16) * ldc + col0;
#pragma unroll
                for (int bj = 0; bj < 2; ++bj) { f32x4 v0 = acc[ai][bj][m][0] + bv[bj][0], v1 = acc[ai][bj][m][1] + bv[bj][1];
                    if (ACT == 1) { f32x2 a = gelu_pk((f32x2){v0[0], v0[1]}), b = gelu_pk((f32x2){v0[2], v0[3]}), c = gelu_pk((f32x2){v1[0], v1[1]}), d = gelu_pk((f32x2){v1[2], v1[3]});
                        v0 = (f32x4){a.x, a.y, b.x, b.y}; v1 = (f32x4){c.x, c.y, d.x, d.y}; }
                    v0 = v0 * sc; v1 = v1 * sc; u32x4 w; w.x = cvt_pk_bf16(v0[0], v0[1]); w.y = cvt_pk_bf16(v0[2], v0[3]); w.z = cvt_pk_bf16(v1[0], v1[1]); w.w = cvt_pk_bf16(v1[2], v1[3]);
                    *(u32x4*)(rowp + bj * HALF) = w; } }
    }
};
template <class Epi, class Sched, bool ALIGN_EPI = false, bool SP2 = false>
__device__ __forceinline__ void gemm_phase(PG8_LAS unsigned char* lds, const Gemm g, const Sched& S, const Epi& E, int tid_in) {
    int tid_ = tid_in; asm volatile("" : "+v"(tid_));
    const int tid = tid_, wid = __builtin_amdgcn_readfirstlane(tid >> 6), lane = tid & 63, wr = wid >> 2, wc = wid & 3, fr = lane & 15, fq = lane >> 4;
    const int K = g.K, nt = K / BK;
    unsigned voffA[2], voffB[2];
#pragma unroll
    for (int i = 0; i < 2; ++i) { int R, C; stage_rc(tid * 16 + i * 8192, R, C); const int Rb = Epi::PERM ? ((R & ~31) + perm32(R & 31)) : R;
        voffA[i] = (unsigned)(R * K + C) * 2u; voffB[i] = (unsigned)(Rb * K + C) * 2u; }
    const size_t kstep = (size_t)(BK * 2);
    const size_t hstep = (size_t)HALF * K * 2;
    const size_t tstep = 2 * hstep;
    const unsigned ldsw = (unsigned)wid * 1024u;
    const int aoff = lds_byte(wr * 64 + fr, fq * 8), boff = lds_byte(wc * 32 + fr, fq * 8);
#define PG8_SA(b, h) (((b) * 2 + (h)) * HTB)
#define PG8_SB(b, h) ((4 + (b) * 2 + (h)) * HTB)
#define PG8_STAGE(bufoff, gbase, voff) do { _Pragma("unroll") for (int _i = 0; _i < 2; ++_i) \
        __builtin_amdgcn_global_load_lds((const unsigned*)((const char*)(gbase) + (voff)[_i]), (PG8_LAS unsigned*)(lds + (bufoff) + ldsw + _i * 8192), 16, 0, 0); } while (0)
#define PG8_LDA(dst, b, h) do { _Pragma("unroll") for (int m = 0; m < 4; ++m) _Pragma("unroll") for (int k = 0; k < 2; ++k) dst[m][k] = *(const PG8_LAS bf16x8*)(lds + PG8_SA(b, h) + aoff + m * 2048 + k * 1024); } while (0)
#define PG8_LDB(dst, b, h) do { _Pragma("unroll") for (int n = 0; n < 2; ++n) _Pragma("unroll") for (int k = 0; k < 2; ++k) dst[n][k] = *(const PG8_LAS bf16x8*)(lds + PG8_SB(b, h) + boff + n * 2048 + k * 1024); } while (0)
#define PG8_MMA(ai, bj, At, Bt) do { __builtin_amdgcn_s_setprio(1); _Pragma("unroll") for (int m = 0; m < 4; ++m) _Pragma("unroll") for (int n = 0; n < 2; ++n) _Pragma("unroll") for (int k = 0; k < 2; ++k) \
        acc[ai][bj][m][n] = __builtin_amdgcn_mfma_f32_16x16x32_bf16(Bt[n][k], At[m][k], acc[ai][bj][m][n], 0, 0, 0); __builtin_amdgcn_s_setprio(0); } while (0)
#define PG8_WAIT_V(n) asm volatile("s_waitcnt vmcnt(" #n ")" ::: "memory")
#define PG8_WAIT_L(n) asm volatile("s_waitcnt lgkmcnt(" #n ")" ::: "memory")
#define PG8_BAR __builtin_amdgcn_s_barrier()
#define PG8_SCHED __builtin_amdgcn_sched_barrier(0)
    Unit cur, nxt; int ui = 0;
    if (!S.next(0, cur)) return;
    f32x4 acc[2][2][4][2];
#pragma unroll
    for (int a = 0; a < 2; ++a)
#pragma unroll
        for (int b = 0; b < 2; ++b)
#pragma unroll
            for (int m = 0; m < 4; ++m)
#pragma unroll
                for (int n = 0; n < 2; ++n) acc[a][b][m][n] = (f32x4){0.f, 0.f, 0.f, 0.f};
    bf16x8 At[4][2], B0[2][2], B1[2][2];
    const char* cA = (const char*)g.A + (size_t)cur.pm * tstep; const char* cB = (const char*)g.Bt + (size_t)cur.pn * tstep;
    S.a_ready(cur);
    if constexpr (SP2) {
        PG8_STAGE(PG8_SB(0, 0), cB, voffB); PG8_STAGE(PG8_SB(0, 1), cB + hstep, voffB); PG8_STAGE(PG8_SA(0, 0), cA, voffA); PG8_STAGE(PG8_SA(0, 1), cA + hstep, voffA);
        if (wr == 1) PG8_BAR;
        PG8_WAIT_V(2); PG8_BAR;
        PG8_STAGE(PG8_SB(1, 0), cB + kstep, voffB); PG8_STAGE(PG8_SA(1, 0), cA + kstep, voffA); PG8_STAGE(PG8_SB(1, 1), cB + hstep + kstep, voffB);
        PG8_WAIT_V(6); PG8_BAR;
    } else {
        PG8_STAGE(PG8_SB(0, 0), cB, voffB); PG8_STAGE(PG8_SA(0, 0), cA, voffA); PG8_STAGE(PG8_SB(0, 1), cB + hstep, voffB); PG8_STAGE(PG8_SA(0, 1), cA + hstep, voffA);
        if (wr == 1) PG8_BAR;
        PG8_WAIT_V(4); PG8_BAR;
        PG8_STAGE(PG8_SB(1, 0), cB + kstep, voffB); PG8_STAGE(PG8_SA(1, 0), cA + kstep, voffA); PG8_STAGE(PG8_SB(1, 1), cB + hstep + kstep, voffB);
        PG8_WAIT_V(6); PG8_BAR;
    }
    for (;;) {
        const bool has_next = S.next(ui + 1, nxt);
        const char* nA = has_next ? (const char*)g.A + (size_t)nxt.pm * tstep : cA; const char* nB = has_next ? (const char*)g.Bt + (size_t)nxt.pn * tstep : cB;
        for (int t = 0; t < nt; t += 2) {
            const bool last = (t == nt - 2);
            const char* a1 = cA + (size_t)(t + 1) * kstep;
            const char* a2 = last ? nA : cA + (size_t)(t + 2) * kstep; const char* b2 = last ? nB : cB + (size_t)(t + 2) * kstep;
            const char* a3 = a2 + kstep; const char* b3 = b2 + kstep;
            if (last && has_next) S.a_ready(nxt);
            if constexpr (SP2) {
            PG8_LDB(B0, 0, 0); PG8_LDB(B1, 0, 1); PG8_SCHED; PG8_LDA(At, 0, 0); PG8_STAGE(PG8_SA(1, 1), a1 + hstep, voffA);
            PG8_WAIT_V(8); PG8_WAIT_L(0); PG8_BAR; PG8_MMA(0, 0, At, B0); PG8_MMA(0, 1, At, B1); PG8_BAR; PG8_SCHED;
            PG8_LDA(At, 0, 1); PG8_STAGE(PG8_SB(0, 0), b2, voffB); PG8_STAGE(PG8_SB(0, 1), b2 + hstep, voffB); PG8_STAGE(PG8_SA(0, 0), a2, voffA);
            PG8_WAIT_V(8); PG8_WAIT_L(0); PG8_BAR; PG8_MMA(1, 0, At, B0); PG8_MMA(1, 1, At, B1); PG8_BAR; PG8_SCHED;
            PG8_LDB(B0, 1, 0); PG8_LDB(B1, 1, 1); PG8_SCHED; PG8_LDA(At, 1, 0); PG8_STAGE(PG8_SA(0, 1), a2 + hstep, voffA);
            PG8_WAIT_V(8); PG8_WAIT_L(0); PG8_BAR; PG8_MMA(0, 0, At, B0); PG8_MMA(0, 1, At, B1); PG8_BAR; PG8_SCHED;
            PG8_LDA(At, 1, 1); PG8_STAGE(PG8_SB(1, 0), b3, voffB); PG8_STAGE(PG8_SB(1, 1), b3 + hstep, voffB); PG8_STAGE(PG8_SA(1, 0), a3, voffA);
            PG8_WAIT_V(8); PG8_WAIT_L(0); PG8_BAR; PG8_MMA(1, 0, At, B0); PG8_MMA(1, 1, At, B1); PG8_BAR; PG8_SCHED;
            } else {
            PG8_LDB(B0, 0, 0); PG8_SCHED; PG8_LDA(At, 0, 0); PG8_STAGE(PG8_SA(1, 1), a1 + hstep, voffA);
            PG8_WAIT_L(8); PG8_BAR; PG8_WAIT_L(0); PG8_MMA(0, 0, At, B0); PG8_BAR; PG8_SCHED;
            PG8_LDB(B1, 0, 1); PG8_STAGE(PG8_SB(0, 0), b2, voffB);
            PG8_BAR; PG8_WAIT_L(0); PG8_MMA(0, 1, At, B1); PG8_BAR;
            PG8_LDA(At, 0, 1); PG8_STAGE(PG8_SA(0, 0), a2, voffA);
            PG8_BAR; PG8_WAIT_L(0); PG8_MMA(1, 0, At, B0); PG8_BAR; PG8_SCHED;
            PG8_STAGE(PG8_SB(0, 1), b2 + hstep, voffB);
            PG8_WAIT_V(6); PG8_BAR; PG8_MMA(1, 1, At, B1); PG8_BAR;
            PG8_LDB(B0, 1, 0); PG8_SCHED; PG8_LDA(At, 1, 0); PG8_STAGE(PG8_SA(0, 1), a2 + hstep, voffA);
            PG8_WAIT_L(8); PG8_BAR; PG8_WAIT_L(0); PG8_MMA(0, 0, At, B0); PG8_BAR; PG8_SCHED;
            PG8_LDB(B1, 1, 1); PG8_STAGE(PG8_SB(1, 0), b3, voffB);
            PG8_BAR; PG8_WAIT_L(0); PG8_MMA(0, 1, At, B1); PG8_BAR;
            PG8_LDA(At, 1, 1); PG8_STAGE(PG8_SA(1, 0), a3, voffA);
            PG8_BAR; PG8_WAIT_L(0); PG8_MMA(1, 0, At, B0); PG8_BAR; PG8_SCHED;
            PG8_STAGE(PG8_SB(1, 1), b3 + hstep, voffB);
            PG8_WAIT_V(6); PG8_BAR; PG8_MMA(1, 1, At, B1); PG8_BAR;
            }
        }
        if constexpr (ALIGN_EPI) { if (wr == 0) PG8_BAR; }
        if constexpr (!Epi::AFTER_DRAIN) { E(acc, cur, wr, wc, fr, fq); S.done(cur); }
        if (!has_next) break;
#pragma unroll
        for (int a = 0; a < 2; ++a)
#pragma unroll
            for (int b = 0; b < 2; ++b)
#pragma unroll
                for (int m = 0; m < 4; ++m)
#pragma unroll
                    for (int n = 0; n < 2; ++n) acc[a][b][m][n] = (f32x4){0.f, 0.f, 0.f, 0.f};
        cur = nxt; cA = nA; cB = nB; ++ui;
        if constexpr (ALIGN_EPI) { if (wr == 1) PG8_BAR; }
    }
    PG8_WAIT_V(0);
    if constexpr (!ALIGN_EPI) { if (wr == 0) PG8_BAR; }
    PG8_BAR;
    if constexpr (Epi::AFTER_DRAIN) { E.fused(acc, cur, wr, wc, fr, fq, lds, wid, lane); S.done(cur); }
#undef PG8_SA
#undef PG8_SB
#undef PG8_STAGE
#undef PG8_LDA
#undef PG8_LDB
#undef PG8_MMA
#undef PG8_WAIT_V
#undef PG8_WAIT_L
#undef PG8_BAR
#undef PG8_SCHED
}
}
#define LAS __attribute__((address_space(3)))
typedef unsigned short bf16_t;
typedef short bf16x8 __attribute__((ext_vector_type(8)));
typedef float f32x4 __attribute__((ext_vector_type(4)));
typedef unsigned u32x4 __attribute__((ext_vector_type(4)));
typedef unsigned u32x2 __attribute__((ext_vector_type(2)));

constexpr int DM = 2048, NB = 4, SEQ = 2048, DEPTH = 4, DECB = 128, MP = NB * SEQ, MT = MP + DECB;
constexpr int NH = 8, HD = 128, DIN = 8208, DINP = 8224, NZ = 8192, MODLD = DEPTH * 3 * DM;
constexpr float EPS = 1e-6f;
constexpr size_t MiB = 1u << 20;
constexpr size_t WS_WIN = 0, WS_WOUT = 130 * MiB, WS_WADA = 162 * MiB, WS_CA = 258 * MiB, WS_MOD = 259 * MiB, WS_HB = 283 * MiB, WS_Z = 316 * MiB,
                 WS_ZS = 444 * MiB, WS_BA = 449 * MiB, WS_X = 450 * MiB, WS_YCAT = 515 * MiB, WS_TR = 548 * MiB, WS_GL = 652 * MiB, WS_CTL = 653 * MiB, WS_OB = 654 * MiB, WS_END = 686 * MiB;
constexpr size_t TR_W = 0, TR_Q = 16384, TR_A = 32768, TR_K = 40960, TR_G = 57344, TR_U = 73728, TR_SZ = 106496;
constexpr int LDS_BYTES = 147456;
constexpr size_t O_YP = 0, O_YS = O_YP + (size_t)MP * DM, O_CAP = O_YS + (size_t)DECB * DM, O_CQP = O_CAP + (size_t)DEPTH * NB * 2 * 1024,
                 O_SP = O_CQP + (size_t)DEPTH * NB * 3 * 3072, O_CAS = O_SP + (size_t)DEPTH * NB * NH * HD * HD, O_CQS = O_CAS + (size_t)DEPTH * DECB * 2 * 1024,
                 O_SS = O_CQS + (size_t)DEPTH * DECB * 3 * 3072, O_END = O_SS + (size_t)DEPTH * DECB * NH * HD * HD;

__device__ __forceinline__ float bflo(unsigned w) { return __uint_as_float(w << 16); }
__device__ __forceinline__ float bfhi(unsigned w) { return __uint_as_float(w & 0xffff0000u); }
__device__ __forceinline__ float bf2f(bf16_t h) { return __uint_as_float((unsigned)h << 16); }
__device__ __forceinline__ unsigned pk2(float lo, float hi) { return pg8::cvt_pk_bf16(lo, hi); }
__device__ __forceinline__ bf16_t f2bf(float f) { return (bf16_t)(pk2(f, 0.f) & 0xffffu); }
__device__ __forceinline__ float rcp_f(float x) { return __builtin_amdgcn_rcpf(x); }
__device__ __forceinline__ float rsq_f(float x) { return __builtin_amdgcn_rsqf(x); }
__device__ __forceinline__ float exp_f(float x) { return __builtin_amdgcn_exp2f(x * 1.4426950408889634f); }
__device__ __forceinline__ float silu_f(float x) { return x * rcp_f(1.f + exp_f(-x)); }
__device__ __forceinline__ float sigmoid_f(float x) { return rcp_f(1.f + exp_f(-x)); }
__device__ __forceinline__ float softplus_f(float x) { return fmaxf(x, 0.f) + __logf(1.f + exp_f(-fabsf(x))); }
__device__ __forceinline__ float wave_sum(float v) {
#pragma unroll
    for (int o = 1; o < 64; o <<= 1) v += __shfl_xor(v, o);
    return v;
}
__device__ __forceinline__ float wave_sum2(float v, int lane) {
    v += __builtin_bit_cast(float, __builtin_amdgcn_update_dpp(0, __builtin_bit_cast(int, v), 0xB1, 0xF, 0xF, true));
    v += __builtin_bit_cast(float, __builtin_amdgcn_update_dpp(0, __builtin_bit_cast(int, v), 0x4E, 0xF, 0xF, true));
    v += __builtin_bit_cast(float, __builtin_amdgcn_update_dpp(0, __builtin_bit_cast(int, v), 0x141, 0xF, 0xF, true));
    v += __builtin_bit_cast(float, __builtin_amdgcn_update_dpp(0, __builtin_bit_cast(int, v), 0x140, 0xF, 0xF, true));
    v += __builtin_bit_cast(float, __builtin_amdgcn_ds_bpermute((lane ^ 16) << 2, __builtin_bit_cast(int, v)));
    v += __builtin_bit_cast(float, __builtin_amdgcn_ds_bpermute((lane ^ 32) << 2, __builtin_bit_cast(int, v)));
    return v;
}
#define LBAR() do { asm volatile("s_waitcnt lgkmcnt(0)" ::: "memory"); __builtin_amdgcn_s_barrier(); asm volatile("" ::: "memory"); } while (0)
#define LDS_WAIT() asm volatile("s_waitcnt lgkmcnt(0)" ::: "memory")

struct EpiF32Bias {
    static constexpr bool PERM = false, AFTER_DRAIN = false;
    float* out; int ldc; const float* bias;
    __device__ __forceinline__ void operator()(const f32x4 (&acc)[2][2][4][2], const pg8::Unit& u, int wr, int wc, int fr, int fq) const {
        const int row0 = u.pm * 256 + wr * 64 + fr, col0 = u.pn * 256 + wc * 32 + 4 * fq;
#pragma unroll
        for (int ai = 0; ai < 2; ++ai)
#pragma unroll
            for (int m = 0; m < 4; ++m) { const size_t off = (size_t)(row0 + ai * 128 + m * 16) * ldc + col0;
#pragma unroll
                for (int bj = 0; bj < 2; ++bj)
#pragma unroll
                    for (int n = 0; n < 2; ++n) { const f32x4 bv = *(const f32x4*)(bias + col0 + bj * 128 + n * 16); *(f32x4*)(out + off + bj * 128 + n * 16) = acc[ai][bj][m][n] + bv; }
                asm volatile("" ::: "memory"); }
    }
};
struct EpiResGate {
    static constexpr bool PERM = false, AFTER_DRAIN = false;
    const float* base; float* out; const float* gate; int ldc;
    __device__ __forceinline__ void operator()(const f32x4 (&acc)[2][2][4][2], const pg8::Unit& u, int wr, int wc, int fr, int fq) const {
        const int row0 = u.pm * 256 + wr * 64 + fr, col0 = u.pn * 256 + wc * 32 + 4 * fq;
        const float* gp = gate + (size_t)((u.pm * 256) / SEQ) * MODLD + col0;
        f32x4 gv[2][2];
#pragma unroll
        for (int bj = 0; bj < 2; ++bj)
#pragma unroll
            for (int n = 0; n < 2; ++n) gv[bj][n] = *(const f32x4*)(gp + bj * 128 + n * 16);
#pragma unroll
        for (int ai = 0; ai < 2; ++ai)
#pragma unroll
            for (int m = 0; m < 4; ++m) { const size_t off = (size_t)(row0 + ai * 128 + m * 16) * ldc + col0;
#pragma unroll
                for (int bj = 0; bj < 2; ++bj)
#pragma unroll
                    for (int n = 0; n < 2; ++n) { const f32x4 b = *(const f32x4*)(base + off + bj * 128 + n * 16); *(f32x4*)(out + off + bj * 128 + n * 16) = b + gv[bj][n] * acc[ai][bj][m][n]; }
                asm volatile("" ::: "memory"); }
    }
};

__device__ __forceinline__ f32x4 skinny16(const bf16_t* A, int lda, const bf16_t* Bt, int ldb, int K, int lane) {
    const int r = lane & 15, q = lane >> 4;
    const bf16x8* ap = (const bf16x8*)(A + (size_t)r * lda + q * 8);
    const bf16x8* bp = (const bf16x8*)(Bt + (size_t)r * ldb + q * 8);
    f32x4 acc0 = {0.f, 0.f, 0.f, 0.f}, acc1 = {0.f, 0.f, 0.f, 0.f};
#pragma unroll 1
    for (int k = 0; k < K / 32; k += 16) {
        bf16x8 a[16], b[16];
#pragma unroll
        for (int i = 0; i < 16; ++i) { a[i] = ap[(k + i) * 4]; b[i] = bp[(k + i) * 4]; }
#pragma unroll
        for (int i = 0; i < 16; i += 2) { acc0 = __builtin_amdgcn_mfma_f32_16x16x32_bf16(a[i], b[i], acc0, 0, 0, 0); acc1 = __builtin_amdgcn_mfma_f32_16x16x32_bf16(a[i + 1], b[i + 1], acc1, 0, 0, 0); }
    }
    return acc0 + acc1;
}


__device__ __forceinline__ void sample_gemm32(LAS unsigned char* lds, const bf16_t* A, const bf16_t* Bt, float* out, int ldo, int n0, int tid, int lane, int wave) {
    constexpr int CK = 512, BS = CK + 8, BUFB = 32 * BS * 2, NC = DM / CK;
    const int r = lane & 15, q8 = lane >> 4;
    const bf16_t* ap = A + (size_t)(wave * 16 + r) * DM + q8 * 8;
    const bf16_t* bp = Bt + (size_t)(tid >> 6) * DM + (tid & 63) * 8;
    const unsigned bw = (unsigned)((tid >> 6) * BS + (tid & 63) * 8) * 2u;
    f32x4 acc[2] = {{0.f, 0.f, 0.f, 0.f}, {0.f, 0.f, 0.f, 0.f}};
    bf16x8 fa[16], fn[16]; u32x4 sb[4];
#define SG_LA(c, d) do { _Pragma("unroll") for (int ks = 0; ks < 16; ++ks) d[ks] = *(const bf16x8*)(ap + (c) * CK + ks * 32); } while (0)
#define SG_LB(c) do { _Pragma("unroll") for (int i = 0; i < 4; ++i) sb[i] = *(const u32x4*)(bp + (size_t)(8 * i) * DM + (c) * CK); } while (0)
#define SG_SB(bufp) do { _Pragma("unroll") for (int i = 0; i < 4; ++i) *(LAS u32x4*)((bufp) + bw + (unsigned)(8 * i * BS * 2)) = sb[i]; } while (0)
    SG_LB(0); SG_LA(0, fa);
    SG_SB(lds);
    SG_LB(1);
    __syncthreads();
#define SG_MM(f_, c_) do { const LAS bf16_t* Bl = (const LAS bf16_t*)(lds + ((c_) & 1) * BUFB); \
        _Pragma("unroll") for (int ks = 0; ks < 16; ++ks) { \
            const bf16x8 b0 = *(const LAS bf16x8*)(Bl + r * BS + ks * 32 + q8 * 8), b1 = *(const LAS bf16x8*)(Bl + (16 + r) * BS + ks * 32 + q8 * 8); \
            acc[0] = __builtin_amdgcn_mfma_f32_16x16x32_bf16(f_[ks], b0, acc[0], 0, 0, 0); acc[1] = __builtin_amdgcn_mfma_f32_16x16x32_bf16(f_[ks], b1, acc[1], 0, 0, 0); } } while (0)
#pragma unroll 1
    for (int c = 0; c < NC; c += 2) {
        SG_LA(c + 1, fn);
        SG_MM(fa, c);
        SG_SB(lds + ((c + 1) & 1) * BUFB);
        if (c + 2 < NC) SG_LB(c + 2);
        LBAR();
        if (c + 2 < NC) SG_LA(c + 2, fa);
        SG_MM(fn, c + 1);
        if (c + 2 < NC) SG_SB(lds + ((c + 2) & 1) * BUFB);
        if (c + 3 < NC) SG_LB(c + 3);
        LBAR();
    }
#undef SG_MM
#undef SG_LA
#undef SG_LB
#undef SG_SB
#pragma unroll
    for (int nt = 0; nt < 2; ++nt)
#pragma unroll
        for (int j = 0; j < 4; ++j) out[(size_t)(wave * 16 + q8 * 4 + j) * ldo + n0 + nt * 16 + r] = acc[nt][j];
}

__device__ __forceinline__ void transpose_item(const float* W, int K, int N, bf16_t* WT, LAS float* scr, int item, int lane) {
    const int nblk = (N + 31) / 32, kb = item / nblk, nb = item % nblk, k0 = 64 * kb, n0 = 32 * nb;
    const int nn = n0 + (lane & 31); const bool ok = nn < N;
    float v[32];
#pragma unroll
    for (int i = 0; i < 32; ++i) { const int kk = 2 * i + (lane >> 5); v[i] = ok ? W[(size_t)(k0 + kk) * N + nn] : 0.f; }
#pragma unroll
    for (int i = 0; i < 32; ++i) { const int kk = 2 * i + (lane >> 5); scr[kk * 33 + (lane & 31)] = v[i]; }
    LDS_WAIT(); asm volatile("" ::: "memory");
    const int c = lane & 7;
#pragma unroll
    for (int j = 0; j < 4; ++j) { const int n = (lane >> 3) + 8 * j; const LAS float* s = scr + (8 * c) * 33 + n;
        u32x4 o; o.x = pk2(s[0 * 33], s[1 * 33]); o.y = pk2(s[2 * 33], s[3 * 33]); o.z = pk2(s[4 * 33], s[5 * 33]); o.w = pk2(s[6 * 33], s[7 * 33]);
        *(u32x4*)(WT + (size_t)(n0 + n) * K + k0 + 8 * c) = o; }
    LDS_WAIT(); asm volatile("" ::: "memory");
}

#define RLX_AGENT __ATOMIC_RELAXED, __HIP_MEMORY_SCOPE_AGENT
#define XB_TMO      128
#define XB_XCNT(j)  (256  + 64 * (j))
#define XB_XSUB(j)  (1280 + 64 * (j))
#define XB_XGEN(j)  (2304 + 64 * (j))
#define XB_TOP      3328
#define XB_TOPGEN   3392
#define XCD_BAR_WORDS 3456
#define XB_SPIN_CAP (1u << 17)

__device__ __forceinline__ unsigned xb_ld(unsigned* p)              { return __hip_atomic_load(p, __ATOMIC_RELAXED, __HIP_MEMORY_SCOPE_AGENT); }
__device__ __forceinline__ unsigned xb_add(unsigned* p, unsigned v) { return __hip_atomic_fetch_add(p, v, __ATOMIC_RELAXED, __HIP_MEMORY_SCOPE_AGENT); }
__device__ __forceinline__ unsigned xb_xcc_id() { return (unsigned)__builtin_amdgcn_s_getreg((3 << 11) | 20) & 0xFu; }
#define XB_SPIN(cond, bar) do { unsigned _sp = 0; while (cond) { __builtin_amdgcn_s_sleep(6); \
    if ((++_sp & 255u) == 0u) { if (xb_ld(&(bar)[XB_TMO])) break; if (_sp > XB_SPIN_CAP) { atomicAdd(&(bar)[XB_TMO], 1u); break; } } } } while (0)

struct XcdBarrier {
    unsigned* bar; unsigned x;
    volatile LAS unsigned* st;
};

__device__ __forceinline__ XcdBarrier xcd_barrier_post(unsigned* bar, volatile LAS unsigned* st) {
    XcdBarrier b; b.bar = bar; b.x = xb_xcc_id(); b.st = st;
    if (threadIdx.x == 0) (void)xb_add(&bar[XB_XCNT(b.x)], 1u);
    return b;
}
__device__ __forceinline__ void xcd_barrier_complete(unsigned* bar, unsigned x, unsigned& nloc, unsigned& nx) {
    const unsigned G = gridDim.x * gridDim.y * gridDim.z;
    unsigned sum, cnt, mine, sp = 0u;
    for (;;) {
        sum = 0u; cnt = 0u; mine = 0u;
#pragma unroll
        for (unsigned j = 0; j < 16; ++j) { const unsigned c = xb_ld(&bar[XB_XCNT(j)]); sum += c; cnt += (c > 0u) ? 1u : 0u; mine = (j == x) ? c : mine; }
        if (sum == G) break;
        __builtin_amdgcn_s_sleep(6);
        if ((++sp & 255u) == 0u) { if (xb_ld(&bar[XB_TMO])) break; if (sp > XB_SPIN_CAP) { atomicAdd(&bar[XB_TMO], 1u); break; } }
    }
    nloc = mine > 0u ? mine : 1u; nx = cnt > 0u ? cnt : 1u;
}

__device__ __forceinline__ void xcd_barrier(const XcdBarrier& b) {
    asm volatile("s_waitcnt vmcnt(0)" ::: "memory");
    __syncthreads();
    if (threadIdx.x == 0) {
        unsigned* bar = b.bar;
        __builtin_amdgcn_s_waitcnt(0);
        unsigned nloc = b.st[0], nx = b.st[1];
        if (nloc == 0u) { xcd_barrier_complete(bar, b.x, nloc, nx); b.st[0] = nloc; b.st[1] = nx; }
        const unsigned old = xb_add(&bar[XB_XSUB(b.x)], 1u);
        const unsigned gen = old / nloc;
        if (old + 1u == (gen + 1u) * nloc) {
            __builtin_amdgcn_fence(__ATOMIC_RELEASE, "agent");
            asm volatile("s_waitcnt vmcnt(0)" ::: "memory");
            const unsigned og = xb_add(&bar[XB_TOP], 1u);
            const unsigned tg = og / nx;
            if (og + 1u == (tg + 1u) * nx) xb_add(&bar[XB_TOPGEN], 1u);
            else XB_SPIN(xb_ld(&bar[XB_TOPGEN]) == tg, bar);
            __builtin_amdgcn_fence(__ATOMIC_ACQUIRE, "agent");
            xb_add(&bar[XB_XGEN(b.x)], 1u);
            asm volatile("s_waitcnt vmcnt(0)" ::: "memory");
        } else {
            XB_SPIN(xb_ld(&bar[XB_XGEN(b.x)]) == gen, bar);
            __builtin_amdgcn_fence(__ATOMIC_ACQUIRE, "agent");
            asm volatile("s_waitcnt vmcnt(0)" ::: "memory");
        }
    }
    __syncthreads();
}

__device__ __forceinline__ void phase_norm(const float* xp, const float* xs, const float* ng, const float* modl, bf16_t* hb, int gw, int NGW, int lane) {
    {
        const int row0 = gw * 4, mrow = row0 / SEQ;
        const float* sh = modl + (size_t)mrow * MODLD; const float* sc = sh + DM;
        f32x4 gg[8], ss0[8];
#pragma unroll
        for (int j = 0; j < 8; ++j) { const int c4 = lane + 64 * j; gg[j] = ((const f32x4*)ng)[c4] * (1.f + ((const f32x4*)sc)[c4]); ss0[j] = ((const f32x4*)sh)[c4]; }
#pragma unroll
        for (int k = 0; k < 4; ++k) {
            f32x4 v[8]; float ss = 0.f;
#pragma unroll
            for (int j = 0; j < 8; ++j) { v[j] = ((const f32x4*)(xp + (size_t)(row0 + k) * DM))[lane + 64 * j]; ss += (v[j].x * v[j].x + v[j].y * v[j].y) + (v[j].z * v[j].z + v[j].w * v[j].w); }
            const float rstd = rsq_f(wave_sum2(ss, lane) * (1.f / DM) + EPS);
#pragma unroll
            for (int j = 0; j < 8; ++j) { const int c4 = lane + 64 * j; const f32x4 h = v[j] * rstd * gg[j] + ss0[j]; u32x2 o; o.x = pk2(h.x, h.y); o.y = pk2(h.z, h.w); *(u32x2*)(hb + (size_t)(row0 + k) * DM + c4 * 4) = o; }
        }
    }
    for (int rs = gw; rs < DECB; rs += NGW) {
        const int row = MP + rs; const float* xr = xs + (size_t)rs * DM;
        const float* sh = modl + (size_t)(NB + rs) * MODLD; const float* sc = sh + DM;
        f32x4 v[8]; float ss = 0.f;
#pragma unroll
        for (int j = 0; j < 8; ++j) { v[j] = ((const f32x4*)xr)[lane + 64 * j]; ss += (v[j].x * v[j].x + v[j].y * v[j].y) + (v[j].z * v[j].z + v[j].w * v[j].w); }
        const float rstd = rsq_f(wave_sum2(ss, lane) * (1.f / DM) + EPS);
#pragma unroll
        for (int j = 0; j < 8; ++j) { const int c4 = lane + 64 * j; const f32x4 g = ((const f32x4*)ng)[c4], s1 = ((const f32x4*)sc)[c4], s0 = ((const f32x4*)sh)[c4];
            const f32x4 h = v[j] * rstd * g * (1.f + s1) + s0; u32x2 o; o.x = pk2(h.x, h.y); o.y = pk2(h.z, h.w); *(u32x2*)(hb + (size_t)row * DM + c4 * 4) = o; }
    }
}
__device__ __forceinline__ void final_row(const f32x4 (&v)[8], const f32x4 (&g)[8], float* orow, int lane) {
    float ss = 0.f;
#pragma unroll
    for (int j = 0; j < 8; ++j) ss += (v[j].x * v[j].x + v[j].y * v[j].y) + (v[j].z * v[j].z + v[j].w * v[j].w);
    const float rstd = rsq_f(wave_sum(ss) * (1.f / DM) + EPS);
#pragma unroll
    for (int j = 0; j < 8; ++j) ((f32x4*)orow)[lane + 64 * j] = v[j] * rstd * g[j];
}
__device__ __forceinline__ void phase_final(const float* x, const float* g, float* out, int gw, int NGW, int lane) {
    f32x4 gg[8];
#pragma unroll
    for (int j = 0; j < 8; ++j) gg[j] = ((const f32x4*)g)[lane + 64 * j];
    const int row0 = gw * 4;
    f32x4 v[8], w[8];
#pragma unroll
    for (int j = 0; j < 8; ++j) v[j] = ((const f32x4*)(x + (size_t)row0 * DM))[lane + 64 * j];
#pragma unroll
    for (int k = 0; k < 4; ++k) {
        if (k < 3) {
#pragma unroll
            for (int j = 0; j < 8; ++j) w[j] = ((const f32x4*)(x + (size_t)(row0 + k + 1) * DM))[lane + 64 * j];
        }
        final_row(v, gg, out + (size_t)(row0 + k) * DM, lane);
#pragma unroll
        for (int j = 0; j < 8; ++j) v[j] = w[j];
    }
    for (int row = MP + gw; row < MT; row += NGW) {
#pragma unroll
        for (int j = 0; j < 8; ++j) v[j] = ((const f32x4*)(x + (size_t)row * DM))[lane + 64 * j];
        final_row(v, gg, out + (size_t)row * DM, lane);
    }
}

template <int I, int C> __device__ __forceinline__ void s2_load(const LAS float* Ll, f32x4 (&lr)[16]) {
    if constexpr (4 * C < I) { lr[C] = *(const LAS f32x4*)(Ll + I * 64 + 4 * C); s2_load<I, C + 1>(Ll, lr); }
}
template <int I, int C> __device__ __forceinline__ void s2_fma(const f32x4 (&lr)[16], const float (&Xc)[64], float& a0, float& a1, float& a2, float& a3) {
    if constexpr (4 * C < I) {
        a0 += lr[C].x * Xc[4 * C];
        if constexpr (4 * C + 1 < I) a1 += lr[C].y * Xc[4 * C + 1];
        if constexpr (4 * C + 2 < I) a2 += lr[C].z * Xc[4 * C + 2];
        if constexpr (4 * C + 3 < I) a3 += lr[C].w * Xc[4 * C + 3];
        s2_fma<I, C + 1>(lr, Xc, a0, a1, a2, a3);
    }
}
template <int I> __device__ __forceinline__ void s2_row(const LAS float* Ll, float (&Xc)[64], int lane) {
    if constexpr (I < 64) {
        float a0 = Ll[I * 64 + lane], a1 = 0.f, a2 = 0.f, a3 = 0.f;
        f32x4 lr[16];
        s2_load<I, 0>(Ll, lr);
        s2_fma<I, 0>(lr, Xc, a0, a1, a2, a3);
        Xc[I] = -((a0 + a1) + (a2 + a3));
        asm volatile("" ::: "memory");
        s2_row<I + 1>(Ll, Xc, lane);
    }
}
struct PrepP { const bf16_t* z; const float* ba; const float* cw; const float* alog; const float* dtb; unsigned char* tr; float* gl; };
constexpr int PS = 136, TS = 72;
__device__ __forceinline__ void conv8(const u32x4 (&x)[4], const LAS float* w, float (&o)[8]) {
    f32x4 wa[4], wb[4];
#pragma unroll
    for (int j = 0; j < 4; ++j) { wa[j] = *(const LAS f32x4*)(w + j * 384); wb[j] = *(const LAS f32x4*)(w + j * 384 + 4); }
#pragma unroll
    for (int i = 0; i < 8; ++i) o[i] = 0.f;
#pragma unroll
    for (int j = 0; j < 4; ++j) {
        o[0] += wa[j].x * bflo(x[j].x); o[1] += wa[j].y * bfhi(x[j].x); o[2] += wa[j].z * bflo(x[j].y); o[3] += wa[j].w * bfhi(x[j].y);
        o[4] += wb[j].x * bflo(x[j].z); o[5] += wb[j].y * bfhi(x[j].z); o[6] += wb[j].z * bflo(x[j].w); o[7] += wb[j].w * bfhi(x[j].w); }
#pragma unroll
    for (int i = 0; i < 8; ++i) o[i] = silu_f(o[i]);
}
__device__ __forceinline__ u32x4 pack8(const float* v) { u32x4 o; o.x = pk2(v[0], v[1]); o.y = pk2(v[2], v[3]); o.z = pk2(v[4], v[5]); o.w = pk2(v[6], v[7]); return o; }
__device__ __forceinline__ void prep_weights(LAS unsigned char* lds, const float* cqw, int h, int tid) {
    LAS float* wl = (LAS float*)(lds + 114688);
#pragma unroll
    for (int i = 0; i < 3; ++i) { const int idx = tid + 512 * i, j = idx / 384, rem = idx - j * 384, m = rem >> 7, c = rem & 127; wl[idx] = cqw[j * 3072 + m * 1024 + h * 128 + c]; }
}
__device__ __forceinline__ void prep_task(LAS unsigned char* lds, const PrepP& P, int task, int tid, int lane, int wave) {
    asm volatile("" : "+v"(tid));
    lane = tid & 63;
    unsigned lb = 0; asm volatile("" : "+v"(lb)); lds += (lb & ~15u);
    const int h = task & 7, n = (task >> 3) & 31, b = task >> 8;
    const int row0 = b * SEQ + n * 64;
    unsigned char* trp = P.tr + (size_t)task * TR_SZ;
    LAS bf16_t* Kl = (LAS bf16_t*)lds; LAS bf16_t* Ql = Kl + 64 * PS; LAS bf16_t* Vl = Ql + 64 * PS; LAS bf16_t* KBl = Vl + 64 * PS; LAS bf16_t* KTl = KBl + 64 * PS;
    LAS float* Ll = (LAS float*)(lds + 5 * 64 * PS * 2);
    LAS bf16_t* Tl = (LAS bf16_t*)(lds + 5 * 64 * PS * 2 + 16384);
    LAS float* gcl = (LAS float*)(lds + 5 * 64 * PS * 2 + 16384 + 64 * TS * 2);
    const int r = lane & 15, q8 = lane >> 4;
    if (wave == 0) {
        const float* bar = P.ba + (size_t)(row0 + lane) * 16;
        float g = -exp_f(P.alog[h]) * softplus_f(bar[8 + h] + P.dtb[h]);
#pragma unroll
        for (int o = 1; o < 64; o <<= 1) { const float v = __shfl_up(g, o); if (lane >= o) g += v; }
        gcl[lane] = g; gcl[64 + lane] = sigmoid_f(bar[h]);
        if (lane == 63) P.gl[task] = exp_f(g);
    }
    LBAR();
    {
        const int t = tid >> 3, seg = tid & 7;
        const float beta = gcl[64 + t], gc = gcl[t], glc = gcl[63];
        const float eg = exp_f(gc), et = exp_f(glc - gc);
        const int tt = n * 64 + t;
        const bf16_t* zr = P.z + (size_t)(row0 + t) * NZ + 4096 + h * 128 + seg * 16;
        const LAS float* cw = (const LAS float*)(lds + 114688) + seg * 16;
        u32x4 xz[3][2][4];
#pragma unroll
        for (int m = 0; m < 3; ++m)
#pragma unroll
            for (int hf = 0; hf < 2; ++hf)
#pragma unroll
                for (int j = 0; j < 4; ++j) { const bool ok = tt - 3 + j >= 0; xz[m][hf][j] = *(const u32x4*)(zr + m * 1024 + hf * 8 + (ptrdiff_t)(ok ? j - 3 : 0) * NZ); if (!ok) xz[m][hf][j] = (u32x4){0u, 0u, 0u, 0u}; }
        const int lo = t * PS + seg * 16;
        float x[16], y[16];
        { float o[8]; conv8(xz[2][0], cw + 256, o);
#pragma unroll
          for (int i = 0; i < 8; ++i) x[i] = o[i] * beta;
          conv8(xz[2][1], cw + 256 + 8, o);
#pragma unroll
          for (int i = 0; i < 8; ++i) x[8 + i] = o[i] * beta; }
        *(LAS u32x4*)(Vl + lo) = pack8(x); *(LAS u32x4*)(Vl + lo + 8) = pack8(x + 8);
        asm volatile("" ::: "memory");
        { float o[8]; conv8(xz[1][0], cw + 128, o);
#pragma unroll
          for (int i = 0; i < 8; ++i) x[i] = o[i];
          conv8(xz[1][1], cw + 128 + 8, o);
#pragma unroll
          for (int i = 0; i < 8; ++i) x[8 + i] = o[i]; }
        { float sk = 0.f;
#pragma unroll
          for (int i = 0; i < 16; ++i) sk += x[i] * x[i];
          sk += __shfl_xor(sk, 1); sk += __shfl_xor(sk, 2); sk += __shfl_xor(sk, 4);
          const float rk = rsq_f(sk + EPS);
#pragma unroll
          for (int i = 0; i < 16; ++i) x[i] *= rk; }
        *(LAS u32x4*)(Kl + lo) = pack8(x); *(LAS u32x4*)(Kl + lo + 8) = pack8(x + 8);
#pragma unroll
        for (int i = 0; i < 16; ++i) y[i] = x[i] * (beta * eg);
        *(LAS u32x4*)(KBl + lo) = pack8(y); *(LAS u32x4*)(KBl + lo + 8) = pack8(y + 8);
#pragma unroll
        for (int i = 0; i < 16; ++i) y[i] = x[i] * et;
        *(LAS u32x4*)(KTl + lo) = pack8(y); *(LAS u32x4*)(KTl + lo + 8) = pack8(y + 8);
        asm volatile("" ::: "memory");
        { float o[8]; conv8(xz[0][0], cw, o);
#pragma unroll
          for (int i = 0; i < 8; ++i) x[i] = o[i];
          conv8(xz[0][1], cw + 8, o);
#pragma unroll
          for (int i = 0; i < 8; ++i) x[8 + i] = o[i]; }
        { float sq = 0.f;
#pragma unroll
          for (int i = 0; i < 16; ++i) sq += x[i] * x[i];
          sq += __shfl_xor(sq, 1); sq += __shfl_xor(sq, 2); sq += __shfl_xor(sq, 4);
          const float rq = rsq_f(sq + EPS) * 0.08838834764831845f;
#pragma unroll
          for (int i = 0; i < 16; ++i) x[i] *= rq; }
        *(LAS u32x4*)(Ql + lo) = pack8(x); *(LAS u32x4*)(Ql + lo + 8) = pack8(x + 8);
#pragma unroll
        for (int i = 0; i < 16; ++i) y[i] = x[i] * eg;
        bf16_t* qo = (bf16_t*)(trp + TR_Q) + t * 128 + seg * 16;
        *(u32x4*)qo = pack8(y); *(u32x4*)(qo + 8) = pack8(y + 8);
    }
    LBAR();
    {
        const int it = wave >> 1, jt0 = (wave & 1) * 2;
        bf16x8 aK[4], aQ[4];
#pragma unroll
        for (int ks = 0; ks < 4; ++ks) { aK[ks] = *(const LAS bf16x8*)(Kl + (it * 16 + r) * PS + ks * 32 + q8 * 8); aQ[ks] = *(const LAS bf16x8*)(Ql + (it * 16 + r) * PS + ks * 32 + q8 * 8); }
#pragma unroll
        for (int jj = 0; jj < 2; ++jj) {
            const int jt = jt0 + jj;
            bf16_t* ap = (bf16_t*)(trp + TR_A) + (it * 16 + r) * 64 + jt * 16 + q8 * 4;
            if (jt > it) { *(u32x2*)ap = (u32x2){lb, lb};
#pragma unroll
                for (int j = 0; j < 4; ++j) Ll[(it * 16 + q8 * 4 + j) * 64 + jt * 16 + r] = 0.f;
                continue; }
            f32x4 accL = {0.f, 0.f, 0.f, 0.f}, accA = {0.f, 0.f, 0.f, 0.f};
#pragma unroll
            for (int ks = 0; ks < 4; ++ks) { const bf16x8 bK = *(const LAS bf16x8*)(Kl + (jt * 16 + r) * PS + ks * 32 + q8 * 8);
                accL = __builtin_amdgcn_mfma_f32_16x16x32_bf16(aK[ks], bK, accL, 0, 0, 0);
                accA = __builtin_amdgcn_mfma_f32_16x16x32_bf16(bK, aQ[ks], accA, 0, 0, 0); }
            float av[4];
#pragma unroll
            for (int j = 0; j < 4; ++j) {
                { const int i = it * 16 + q8 * 4 + j, jx = jt * 16 + r; const float e = exp_f(gcl[i] - gcl[jx]) * gcl[64 + i] * accL[j]; Ll[i * 64 + jx] = (i > jx) ? e : 0.f; }
                { const int i = it * 16 + r, jx = jt * 16 + q8 * 4 + j; const float e = exp_f(gcl[i] - gcl[jx]) * accA[j]; av[j] = (i >= jx) ? e : 0.f; } }
            u32x2 o; o.x = pk2(av[0], av[1]); o.y = pk2(av[2], av[3]); *(u32x2*)ap = o;
        }
    }
    LBAR();
    if (wave == 0) {
        float Xc[64];
        s2_row<0>(Ll, Xc, lane);
#pragma unroll
        for (int i = 0; i < 64; ++i) Tl[i * TS + lane] = f2bf(Xc[i]);
        asm volatile("s_waitcnt lgkmcnt(0)" ::: "memory");
        Tl[lane * TS + lane] = (bf16_t)0x3F80u;
    }
    LBAR();
    {
        const int c0 = wave * 16;
        bf16x8 bv[2], bk[2];
#pragma unroll
        for (int ks = 0; ks < 2; ++ks)
#pragma unroll
            for (int j = 0; j < 8; ++j) { const int tok = ks * 32 + q8 * 8 + j; bv[ks][j] = (short)Vl[tok * PS + c0 + r]; bk[ks][j] = (short)KBl[tok * PS + c0 + r]; }
#pragma unroll
        for (int mt = 0; mt < 4; ++mt) {
            f32x4 aU = {0.f, 0.f, 0.f, 0.f}, aW = {0.f, 0.f, 0.f, 0.f};
#pragma unroll
            for (int ks = 0; ks < 2; ++ks) { if (ks == 1 && mt < 2) continue;
                const bf16x8 aT = *(const LAS bf16x8*)(Tl + (mt * 16 + r) * TS + ks * 32 + q8 * 8);
                aU = __builtin_amdgcn_mfma_f32_16x16x32_bf16(aT, bv[ks], aU, 0, 0, 0);
                aW = __builtin_amdgcn_mfma_f32_16x16x32_bf16(bk[ks], aT, aW, 0, 0, 0); }
            *(f32x4*)((float*)(trp + TR_U) + ((wave * 4 + mt) * 64 + lane) * 4) = aU;
            u32x2 o; o.x = pk2(-aW[0], -aW[1]); o.y = pk2(-aW[2], -aW[3]);
            *(u32x2*)((bf16_t*)(trp + TR_W) + (mt * 16 + r) * 128 + c0 + q8 * 4) = o;
        }
#pragma unroll
        for (int ii = 0; ii < 2; ++ii) { const int item = tid + 512 * ii, dk = item & 127, oct = item >> 7; float kv[8];
#pragma unroll
            for (int j = 0; j < 8; ++j) kv[j] = bf2f(KTl[(oct * 8 + j) * PS + dk]);
            *(u32x4*)((bf16_t*)(trp + TR_K) + dk * 64 + oct * 8) = pack8(kv); }
    }
    LBAR();
}
__device__ __forceinline__ void conva_prompt(const bf16_t* z, const float* caw, bf16_t* ycat, int gt, int GT) {
#pragma unroll 2
    for (int idx = gt; idx < MP * 128; idx += GT) {
        const int row = idx >> 7, c8 = (idx & 127) * 8, t = row & (SEQ - 1);
        const bf16_t* zr = z + (size_t)row * NZ + c8;
        float conv[8];
#pragma unroll
        for (int i = 0; i < 8; ++i) conv[i] = 0.f;
#pragma unroll
        for (int j = 0; j < 3; ++j) {
            const bool ok = t - 2 + j >= 0; const ptrdiff_t ro = (ptrdiff_t)(ok ? j - 2 : 0) * NZ;
            u32x4 c = *(const u32x4*)(zr + ro + 1024); const u32x4 hh = *(const u32x4*)(zr + ro + 2048);
            if (!ok) c = (u32x4){0u, 0u, 0u, 0u};
            const f32x4 w0 = *(const f32x4*)(caw + j * 1024 + c8), w1 = *(const f32x4*)(caw + j * 1024 + c8 + 4);
            conv[0] += w0.x * (bflo(c.x) * bflo(hh.x)); conv[1] += w0.y * (bfhi(c.x) * bfhi(hh.x)); conv[2] += w0.z * (bflo(c.y) * bflo(hh.y)); conv[3] += w0.w * (bfhi(c.y) * bfhi(hh.y));
            conv[4] += w1.x * (bflo(c.z) * bflo(hh.z)); conv[5] += w1.y * (bfhi(c.z) * bfhi(hh.z)); conv[6] += w1.z * (bflo(c.w) * bflo(hh.w)); conv[7] += w1.w * (bfhi(c.w) * bfhi(hh.w));
        }
        const u32x4 bb = *(const u32x4*)zr, gg = *(const u32x4*)(zr + 3072);
        float y[8];
        y[0] = bflo(bb.x) * conv[0] * silu_f(bflo(gg.x)); y[1] = bfhi(bb.x) * conv[1] * silu_f(bfhi(gg.x)); y[2] = bflo(bb.y) * conv[2] * silu_f(bflo(gg.y)); y[3] = bfhi(bb.y) * conv[3] * silu_f(bfhi(gg.y));
        y[4] = bflo(bb.z) * conv[4] * silu_f(bflo(gg.z)); y[5] = bfhi(bb.z) * conv[5] * silu_f(bfhi(gg.z)); y[6] = bflo(bb.w) * conv[6] * silu_f(bflo(gg.w)); y[7] = bfhi(bb.w) * conv[7] * silu_f(bfhi(gg.w));
        *(u32x4*)(ycat + (size_t)row * DM + c8) = pack8(y);
    }
}
__device__ __forceinline__ void conv_states_prompt(const bf16_t* z, float* oca, float* ocq, int gt, int GT) {
    for (int idx = gt; idx < NB * 2 * 1024; idx += GT) { const int c = idx & 1023, j = (idx >> 10) & 1, b = idx >> 11;
        const bf16_t* zr = z + (size_t)(b * SEQ + SEQ - 2 + j) * NZ; oca[idx] = bf2f(zr[1024 + c]) * bf2f(zr[2048 + c]); }
    for (int idx = gt; idx < NB * 3 * 3072; idx += GT) { const int c = (int)((unsigned)idx % 3072u), j = (int)((unsigned)idx / 3072u) % 3, b = (int)((unsigned)idx / 9216u);
        ocq[idx] = bf2f(z[(size_t)(b * SEQ + SEQ - 3 + j) * NZ + 4096 + c]); }
}

struct ScanP { const unsigned char* tr; const float* gl; float* obuf; float* sout; };
constexpr int SB_W = 0, SB_Q = 64 * PS * 2, SB_A = 2 * 64 * PS * 2, SB_K = SB_A + 64 * TS * 2, SB_SZ = SB_K + 128 * TS * 2;
static_assert(2 * SB_SZ <= 131072, "scan LDS");
__device__ __forceinline__ bf16x8 frag1(const LAS bf16_t* p) { return *(const LAS bf16x8*)p; }
__device__ __forceinline__ bf16x8 packB(const f32x4& a, const f32x4& b) { u32x4 v = {pk2(a[0], a[1]), pk2(a[2], a[3]), pk2(b[0], b[1]), pk2(b[2], b[3])}; return __builtin_bit_cast(bf16x8, v); }
__device__ __forceinline__ void scan_bh(LAS unsigned char* lds, const ScanP& P, int b, int h, int half, int tid, int lane, int wave) {
    const bool cw = wave < 4;
    const int r = lane & 15, q8 = lane >> 4, ct = half * 4 + (wave & 3), c0 = ct * 16;
    if (!cw) {
        const int lt = tid - 256, wrow = lt >> 4, wc16 = lt & 15, arow = lt >> 3, ac16 = lt & 7;
        const int wperm = (wc16 >> 2) * 32 + ((((wc16 & 3) * 8) & 15) >> 2) * 8 + (((wc16 & 3) * 8) >> 4) * 4, aperm = (ac16 >> 2) * 32 + ((((ac16 & 3) * 8) & 15) >> 2) * 8 + (((ac16 & 3) * 8) >> 4) * 4;
        const unsigned oW = (unsigned)TR_W + (unsigned)(wrow * 128 + wc16 * 8) * 2u, oQ = oW + (unsigned)(TR_Q - TR_W), oA = (unsigned)TR_A + (unsigned)(arow * 64 + ac16 * 8) * 2u, oK = oA + (unsigned)(TR_K - TR_A);
        const unsigned lW = (unsigned)(wrow * PS + wperm) * 2u, lA = (unsigned)(arow * TS + aperm) * 2u;
        u32x4 sa[14], sb[14];
#define L_LOAD(nn, d) do { const unsigned char* tr_ = P.tr + (size_t)((b << 8) | ((nn) << 3) | h) * TR_SZ; \
            _Pragma("unroll") for (int i = 0; i < 4; ++i) { d[i] = *(const u32x4*)(tr_ + (oW + 4096u * i)); d[4 + i] = *(const u32x4*)(tr_ + (oQ + 4096u * i)); d[10 + i] = *(const u32x4*)(tr_ + (oK + 4096u * i)); } \
            d[8] = *(const u32x4*)(tr_ + oA); d[9] = *(const u32x4*)(tr_ + (oA + 4096u)); } while (0)
#define ST2(base, boff, v) do { *(LAS u32x2*)((base) + (boff)) = (u32x2){(v).x, (v).y}; *(LAS u32x2*)((base) + (boff) + 16u) = (u32x2){(v).z, (v).w}; } while (0)
#define L_STORE(bufp, s_) do { LAS unsigned char* bp_ = (bufp); \
            _Pragma("unroll") for (int i = 0; i < 4; ++i) { ST2(bp_ + SB_W, lW + (unsigned)(16 * PS * 2 * i), s_[i]); ST2(bp_ + SB_Q, lW + (unsigned)(16 * PS * 2 * i), s_[4 + i]); ST2(bp_ + SB_K, lA + (unsigned)(32 * TS * 2 * i), s_[10 + i]); } \
            ST2(bp_ + SB_A, lA, s_[8]); ST2(bp_ + SB_A, lA + (unsigned)(32 * TS * 2), s_[9]); } while (0)
        L_LOAD(0, sa); L_STORE(lds, sa); L_LOAD(1, sa);
        __syncthreads();
#pragma unroll 1
        for (int n = 0; n < 32; n += 2) {
            if (n + 2 < 32) L_LOAD(n + 2, sb);
            L_STORE(lds + ((n + 1) & 1) * SB_SZ, sa);
            LBAR();
            if (n + 3 < 32) L_LOAD(n + 3, sa);
            if (n + 2 < 32) L_STORE(lds + ((n + 2) & 1) * SB_SZ, sb);
            LBAR();
        }
#undef L_LOAD
#undef L_STORE
#undef ST2
    } else {
        f32x4 S[8];
#pragma unroll
        for (int i = 0; i < 8; ++i) S[i] = (f32x4){0.f, 0.f, 0.f, 0.f};
        const float glv = (lane < 32) ? P.gl[(b << 8) | (lane << 3) | h] : 0.f;
        f32x4 ubn[4];
        const unsigned oU = (unsigned)TR_U + (unsigned)(ct * 256 + lane) * 16u;
#define U_LOAD(nn) do { const unsigned char* tr_ = P.tr + (size_t)((b << 8) | ((nn) << 3) | h) * TR_SZ; \
            _Pragma("unroll") for (int mt_ = 0; mt_ < 4; ++mt_) ubn[mt_] = *(const f32x4*)(tr_ + (oU + (unsigned)mt_ * 1024u)); } while (0)
        U_LOAD(0);
        __syncthreads();
#pragma unroll 1
        for (int n = 0; n < 32; ++n) {
            LAS unsigned char* buf = lds + (n & 1) * SB_SZ;
            const LAS bf16_t* Wl = (const LAS bf16_t*)(buf + SB_W); const LAS bf16_t* Ql = (const LAS bf16_t*)(buf + SB_Q);
            const LAS bf16_t* Al = (const LAS bf16_t*)(buf + SB_A); const LAS bf16_t* Kl = (const LAS bf16_t*)(buf + SB_K);
            f32x4 u[4], o[4];
#pragma unroll
            for (int mt = 0; mt < 4; ++mt) { u[mt] = ubn[mt]; o[mt] = (f32x4){0.f, 0.f, 0.f, 0.f}; }
            if (n + 1 < 32) U_LOAD(n + 1);
        bf16x8 Sb[4];
#pragma unroll
        for (int ks = 0; ks < 4; ++ks) Sb[ks] = packB(S[2 * ks], S[2 * ks + 1]);
#define SBAR() __builtin_amdgcn_sched_barrier(0)
#define LD4(d, base, mt, stride) do { _Pragma("unroll") for (int ks = 0; ks < 4; ++ks) d[ks] = frag1((base) + ((mt) * 16 + r) * (stride) + ks * 32 + q8 * 8); } while (0)
#define MM4(acc, s_) do { _Pragma("unroll") for (int ks = 0; ks < 4; ++ks) acc = __builtin_amdgcn_mfma_f32_16x16x32_bf16(s_[ks], Sb[ks], acc, 0, 0, 0); } while (0)
        {
            bf16x8 fA[4], fB[4];
            LD4(fA, Wl, 0, PS); SBAR(); LD4(fB, Ql, 0, PS); SBAR();
            MM4(u[0], fA); SBAR(); LD4(fA, Wl, 1, PS); SBAR(); MM4(o[0], fB); SBAR(); LD4(fB, Ql, 1, PS); SBAR();
            MM4(u[1], fA); SBAR(); LD4(fA, Wl, 2, PS); SBAR(); MM4(o[1], fB); SBAR(); LD4(fB, Ql, 2, PS); SBAR();
            MM4(u[2], fA); SBAR(); LD4(fA, Wl, 3, PS); SBAR(); MM4(o[2], fB); SBAR(); LD4(fB, Ql, 3, PS); SBAR();
            MM4(u[3], fA); SBAR(); MM4(o[3], fB); SBAR();
        }
        bf16x8 Ub[2];
        Ub[0] = packB(u[0], u[1]); Ub[1] = packB(u[2], u[3]);
        const float gl = __shfl(glv, n);
#define LDK(d, dt0) do { d[0] = frag1(Kl + ((dt0) * 16 + r) * TS + q8 * 8); d[1] = frag1(Kl + ((dt0) * 16 + r) * TS + 32 + q8 * 8); d[2] = frag1(Kl + (((dt0) + 1) * 16 + r) * TS + q8 * 8); d[3] = frag1(Kl + (((dt0) + 1) * 16 + r) * TS + 32 + q8 * 8); } while (0)
#define MMK(s_, dt0) do { S[dt0] = S[dt0] * gl; S[(dt0) + 1] = S[(dt0) + 1] * gl; \
            S[dt0] = __builtin_amdgcn_mfma_f32_16x16x32_bf16(s_[0], Ub[0], S[dt0], 0, 0, 0); S[(dt0) + 1] = __builtin_amdgcn_mfma_f32_16x16x32_bf16(s_[2], Ub[0], S[(dt0) + 1], 0, 0, 0); \
            S[dt0] = __builtin_amdgcn_mfma_f32_16x16x32_bf16(s_[1], Ub[1], S[dt0], 0, 0, 0); S[(dt0) + 1] = __builtin_amdgcn_mfma_f32_16x16x32_bf16(s_[3], Ub[1], S[(dt0) + 1], 0, 0, 0); } while (0)
        {
            bf16x8 aA[6], kA[4], kB[4];
            aA[0] = frag1(Al + (0 * 16 + r) * TS + q8 * 8); aA[1] = frag1(Al + (1 * 16 + r) * TS + q8 * 8);
            aA[2] = frag1(Al + (2 * 16 + r) * TS + q8 * 8); aA[3] = frag1(Al + (2 * 16 + r) * TS + 32 + q8 * 8);
            aA[4] = frag1(Al + (3 * 16 + r) * TS + q8 * 8); aA[5] = frag1(Al + (3 * 16 + r) * TS + 32 + q8 * 8);
            SBAR(); LDK(kA, 0); SBAR();
            o[0] = __builtin_amdgcn_mfma_f32_16x16x32_bf16(aA[0], Ub[0], o[0], 0, 0, 0); o[1] = __builtin_amdgcn_mfma_f32_16x16x32_bf16(aA[1], Ub[0], o[1], 0, 0, 0);
            o[2] = __builtin_amdgcn_mfma_f32_16x16x32_bf16(aA[2], Ub[0], o[2], 0, 0, 0); o[3] = __builtin_amdgcn_mfma_f32_16x16x32_bf16(aA[4], Ub[0], o[3], 0, 0, 0);
            o[2] = __builtin_amdgcn_mfma_f32_16x16x32_bf16(aA[3], Ub[1], o[2], 0, 0, 0); o[3] = __builtin_amdgcn_mfma_f32_16x16x32_bf16(aA[5], Ub[1], o[3], 0, 0, 0);
            SBAR(); LDK(kB, 2); SBAR(); MMK(kA, 0); SBAR(); LDK(kA, 4); SBAR(); MMK(kB, 2); SBAR(); LDK(kB, 6); SBAR(); MMK(kA, 4); SBAR(); MMK(kB, 6); SBAR();
        }
#undef LD4
#undef MM4
#undef LDK
#undef MMK
#undef SBAR
        { unsigned oO = (unsigned)((q8 * 4) * 1024 + c0 + r) * 4u; asm volatile("" : "+v"(oO));
          unsigned char* ob = (unsigned char*)(P.obuf + (size_t)(b * SEQ + n * 64) * 1024 + h * 128);
#pragma unroll
          for (int mt = 0; mt < 4; ++mt)
#pragma unroll
              for (int j = 0; j < 4; ++j) *(float*)(ob + (oO + (unsigned)(mt * 16 + j) * 4096u)) = o[mt][j]; }
            LBAR();
        }
#undef U_LOAD
#pragma unroll
        for (int dt = 0; dt < 8; ++dt)
#pragma unroll
            for (int j = 0; j < 4; ++j) P.sout[(size_t)(dt * 16 + q8 * 4 + j) * HD + c0 + r] = S[dt][j];
    }
    __syncthreads();
}
__device__ __forceinline__ void onorm_pass(const float* obuf, const bf16_t* z, const float* ong, bf16_t* ycat, int gw, int NGW, int lane) {
    const int cl = (lane & 7) * 16;
    f32x4 g[4];
#pragma unroll
    for (int i = 0; i < 4; ++i) g[i] = *(const f32x4*)(ong + cl + 4 * i);
#pragma unroll 2
    for (int row = gw; row < MP; row += NGW) {
        const float* op = obuf + (size_t)row * 1024 + lane * 16; const bf16_t* zp = z + (size_t)row * NZ + 7168 + lane * 16;
        f32x4 v[4]; float ss = 0.f;
#pragma unroll
        for (int i = 0; i < 4; ++i) { v[i] = *(const f32x4*)(op + 4 * i); ss += (v[i].x * v[i].x + v[i].y * v[i].y) + (v[i].z * v[i].z + v[i].w * v[i].w); }
        const u32x4 g0 = *(const u32x4*)zp, g1 = *(const u32x4*)(zp + 8);
        ss += __builtin_bit_cast(float, __builtin_amdgcn_update_dpp(0, __builtin_bit_cast(int, ss), 0xB1, 0xF, 0xF, true));
        ss += __builtin_bit_cast(float, __builtin_amdgcn_update_dpp(0, __builtin_bit_cast(int, ss), 0x4E, 0xF, 0xF, true));
        ss += __builtin_bit_cast(float, __builtin_amdgcn_update_dpp(0, __builtin_bit_cast(int, ss), 0x141, 0xF, 0xF, true));
        const float rstd = rsq_f(ss * (1.f / HD) + EPS);
        float y[16];
        y[0] = v[0].x * rstd * g[0].x * silu_f(bflo(g0.x)); y[1] = v[0].y * rstd * g[0].y * silu_f(bfhi(g0.x)); y[2] = v[0].z * rstd * g[0].z * silu_f(bflo(g0.y)); y[3] = v[0].w * rstd * g[0].w * silu_f(bfhi(g0.y));
        y[4] = v[1].x * rstd * g[1].x * silu_f(bflo(g0.z)); y[5] = v[1].y * rstd * g[1].y * silu_f(bfhi(g0.z)); y[6] = v[1].z * rstd * g[1].z * silu_f(bflo(g0.w)); y[7] = v[1].w * rstd * g[1].w * silu_f(bfhi(g0.w));
        y[8] = v[2].x * rstd * g[2].x * silu_f(bflo(g1.x)); y[9] = v[2].y * rstd * g[2].y * silu_f(bfhi(g1.x)); y[10] = v[2].z * rstd * g[2].z * silu_f(bflo(g1.y)); y[11] = v[2].w * rstd * g[2].w * silu_f(bfhi(g1.y));
        y[12] = v[3].x * rstd * g[3].x * silu_f(bflo(g1.z)); y[13] = v[3].y * rstd * g[3].y * silu_f(bfhi(g1.z)); y[14] = v[3].z * rstd * g[3].z * silu_f(bflo(g1.w)); y[15] = v[3].w * rstd * g[3].w * silu_f(bfhi(g1.w));
        bf16_t* yp = ycat + (size_t)row * DM + 1024 + lane * 16;
        *(u32x4*)yp = pack8(y); *(u32x4*)(yp + 8) = pack8(y + 8);
    }
}
struct SampP { const float* zs; const float* sca; const float* scq; const float* s0; const float* caw; const float* cqw; const float* alog; const float* dtb; const float* ong;
               bf16_t* ycat; float* oca; float* ocq; float* oss; };
__device__ __forceinline__ void sample_task(LAS unsigned char* lds, const SampP& P, int task, int tid, int lane, int wave) {
    const int h = task & 7, bs = task >> 3;
    LAS float* qv = (LAS float*)lds; LAS float* kv = qv + 128; LAS float* vv = kv + 128; LAS float* part = vv + 128; LAS float* pks = part + 16; LAS float* pqs = pks + 1024;
    const float* s0 = P.s0 + (size_t)(bs * 8 + h) * 16384; float* so = P.oss + (size_t)(bs * 8 + h) * 16384;
    const int half = lane >> 5, c4 = (lane & 31) * 4;
    f32x4 sr[8];
#pragma unroll
    for (int i = 0; i < 8; ++i) sr[i] = *(const f32x4*)(s0 + (size_t)(wave * 16 + 2 * i + half) * 128 + c4);
    const float* zr = P.zs + (size_t)bs * DINP;
    const float zbeta = zr[8192 + h], zalpha = zr[8200 + h], alg = P.alog[h], dtbv = P.dtb[h];
    f32x4 ongv = {0.f, 0.f, 0.f, 0.f}, gbv = {0.f, 0.f, 0.f, 0.f};
    if (wave == 0 && lane < 32) { ongv = *(const f32x4*)(P.ong + c4); gbv = *(const f32x4*)(zr + 7168 + h * 128 + c4); }
    float qkv[3] = {0.f, 0.f, 0.f};
    if (tid < 128) {
        const int cc = h * 128 + tid;
        { const float ch = zr[1024 + cc] * zr[2048 + cc]; const float s0a = P.sca[(bs * 2 + 0) * 1024 + cc], s1a = P.sca[(bs * 2 + 1) * 1024 + cc];
          const float conv = P.caw[cc] * s0a + P.caw[1024 + cc] * s1a + P.caw[2048 + cc] * ch;
          P.ycat[(size_t)(MP + bs) * DM + cc] = f2bf(zr[cc] * conv * silu_f(zr[3072 + cc]));
          P.oca[(bs * 2 + 0) * 1024 + cc] = s1a; P.oca[(bs * 2 + 1) * 1024 + cc] = ch; }
#pragma unroll
        for (int m = 0; m < 3; ++m) { const int c3 = m * 1024 + cc; const float pre = zr[4096 + c3];
            const float a0 = P.scq[(bs * 3 + 0) * 3072 + c3], a1 = P.scq[(bs * 3 + 1) * 3072 + c3], a2 = P.scq[(bs * 3 + 2) * 3072 + c3];
            qkv[m] = silu_f(P.cqw[c3] * a0 + P.cqw[3072 + c3] * a1 + P.cqw[2 * 3072 + c3] * a2 + P.cqw[3 * 3072 + c3] * pre);
            P.ocq[(bs * 3 + 0) * 3072 + c3] = a1; P.ocq[(bs * 3 + 1) * 3072 + c3] = a2; P.ocq[(bs * 3 + 2) * 3072 + c3] = pre; }
        const float sq = wave_sum(qkv[0] * qkv[0]), sk = wave_sum(qkv[1] * qkv[1]);
        if (lane == 0) { part[wave * 2] = sq; part[wave * 2 + 1] = sk; }
    }
    __syncthreads();
    if (tid < 128) { const float sq = part[0] + part[2], sk = part[1] + part[3];
        qv[tid] = qkv[0] * rsq_f(sq + EPS) * 0.08838834764831845f; kv[tid] = qkv[1] * rsq_f(sk + EPS); vv[tid] = qkv[2]; }
    __syncthreads();
    f32x4 pk = {0.f, 0.f, 0.f, 0.f}, pq = {0.f, 0.f, 0.f, 0.f};
#pragma unroll
    for (int i = 0; i < 8; ++i) { const int row = wave * 16 + 2 * i + half; pk += kv[row] * sr[i]; pq += qv[row] * sr[i]; }
#pragma unroll
    for (int e = 0; e < 4; ++e) { pk[e] += __shfl_xor(pk[e], 32); pq[e] += __shfl_xor(pq[e], 32); }
    if (lane < 32) { *(LAS f32x4*)(pks + wave * 128 + c4) = pk; *(LAS f32x4*)(pqs + wave * 128 + c4) = pq; }
    const float qk = wave_sum(qv[lane] * kv[lane] + qv[lane + 64] * kv[lane + 64]);
    __syncthreads();
    f32x4 ks = {0.f, 0.f, 0.f, 0.f}, qs = {0.f, 0.f, 0.f, 0.f};
#pragma unroll
    for (int w = 0; w < 8; ++w) { ks += *(const LAS f32x4*)(pks + w * 128 + c4); qs += *(const LAS f32x4*)(pqs + w * 128 + c4); }
    const float beta = sigmoid_f(zbeta);
    const float eg = exp_f(-exp_f(alg) * softplus_f(zalpha + dtbv));
    const f32x4 v4 = *(const LAS f32x4*)(vv + c4);
    const f32x4 u = beta * (v4 - eg * ks);
    const f32x4 o = eg * qs + qk * u;
#pragma unroll
    for (int i = 0; i < 8; ++i) { const int row = wave * 16 + 2 * i + half; *(f32x4*)(so + (size_t)row * 128 + c4) = eg * sr[i] + kv[row] * u; }
    if (wave == 0) {
        float ss = (lane < 32) ? (o.x * o.x + o.y * o.y) + (o.z * o.z + o.w * o.w) : 0.f;
        const float rstd = rsq_f(wave_sum(ss) * (1.f / HD) + EPS);
        if (lane < 32) { const f32x4 g = ongv, gb = gbv;
            u32x2 w; w.x = pk2(o.x * rstd * g.x * silu_f(gb.x), o.y * rstd * g.y * silu_f(gb.y)); w.y = pk2(o.z * rstd * g.z * silu_f(gb.z), o.w * rstd * g.w * silu_f(gb.w));
            *(u32x2*)(P.ycat + (size_t)(MP + bs) * DM + 1024 + h * 128 + c4) = w; }
    }
    __syncthreads();
}

struct Args { const float* in[18]; float* out; unsigned char* ws; };
#define GAS __attribute__((address_space(1)))
struct ArgsG { const GAS float* in[18]; GAS float* out; GAS unsigned char* ws; };
__global__ void __launch_bounds__(512, 2) mega(Args a) {
    extern __shared__ __attribute__((aligned(16))) unsigned char lds_raw[];
    cg::grid_group grid = cg::this_grid();
    LAS unsigned char* lds = (LAS unsigned char*)lds_raw;
    constexpr int G = 256, NGW = G * 8, GT = G * 512;
    const int bx0 = blockIdx.x, wave0 = __builtin_amdgcn_readfirstlane(threadIdx.x >> 6);
    const ArgsG* ap0 = (const ArgsG*)__builtin_amdgcn_kernarg_segment_ptr();
#define FRESH() unsigned m_ = ~0u; asm volatile("" : "+s"(m_)); int tid = (wave0 << 6) | (int)__builtin_amdgcn_mbcnt_hi(m_, __builtin_amdgcn_mbcnt_lo(m_, 0u)); asm volatile("" : "+v"(tid)); FRESH_S(); const int lane = tid & 63, wave = __builtin_amdgcn_readfirstlane(tid >> 6), gw = bx * 8 + wave, gt = bx * 512 + tid; (void)lane; (void)gw; (void)gt
#define FRESH_S() int bx = bx0; const ArgsG* ap = ap0; asm volatile("" : "+s"(bx), "+s"(ap)); unsigned char* ws = (unsigned char*)ap->ws
#define GBAR() do { FRESH_S(); XcdBarrier xb_; xb_.bar = (unsigned*)(ws + WS_CTL); xb_.x = xb_xcc_id(); xb_.st = (volatile LAS unsigned*)(lds + 131072 + 32); xcd_barrier(xb_); } while (0)
#define WSP(T, off) ((T*)(ws + (off)))
    { volatile LAS unsigned* misc = (volatile LAS unsigned*)(lds + 131072); if (threadIdx.x < 32) misc[threadIdx.x] = 0u; __syncthreads();
      (void)xcd_barrier_post((unsigned*)((unsigned char*)ap0->ws + WS_CTL), misc + 8); }
    constexpr int I_IN = 32 * 257, I_OUT = 32 * 64, I_ADA = 32 * 192;
    {
        FRESH();
        LAS float* scr = (LAS float*)(lds + wave * 16384);
#pragma unroll 1
        for (int it = gw; it < 4 * I_ADA; it += NGW) { const int l = it / I_ADA, r = it - l * I_ADA;
            transpose_item(((const float*)ap->in[8]) + (size_t)l * DM * 3 * DM, DM, 3 * DM, WSP(bf16_t, WS_WADA) + (size_t)l * 3 * DM * DM, scr, r, lane); }
        const float* c_prompt = ((const float*)ap->in[5]); const float* c_sample = ((const float*)ap->in[6]); bf16_t* ca = WSP(bf16_t, WS_CA);
        for (int idx = gt; idx < (NB + DECB) * DM; idx += GT) { const int row = idx >> 11, c = idx & 2047;
            const float v = row < NB ? c_prompt[row * DM + c] : c_sample[(row - NB) * DM + c]; ca[idx] = f2bf(silu_f(v)); }
    }
    if (ap0->out == nullptr) grid.sync();
    GBAR();
    {
        FRESH();
        constexpr int NGEMM = MODLD / 256, NIT2 = 4 * (I_IN + I_OUT), N1 = 35000;
        if (bx < NGEMM) {
            pg8::Gemm g{WSP(bf16_t, WS_CA), WSP(bf16_t, WS_WADA), 256, MODLD, DM}; pg8::StaticOrder S; S.init(256, MODLD, G, bx);
            EpiF32Bias E{WSP(float, WS_MOD), MODLD, ((const float*)ap->in[9])};
            pg8::gemm_phase<EpiF32Bias, pg8::StaticOrder, true, true>(lds, g, S, E, tid);
        }
        LAS float* scr = (LAS float*)(lds + wave * 16384);
        const int it0 = bx < NGEMM ? N1 + bx * 8 + wave : (bx - NGEMM) * 8 + wave, itN = bx < NGEMM ? NIT2 : N1, its = bx < NGEMM ? NGEMM * 8 : (G - NGEMM) * 8;
#pragma unroll 1
        for (int it = it0; it < itN; it += its) {
            int r = it;
            if (r < 4 * I_IN) { const int l = r / I_IN; r -= l * I_IN; transpose_item(((const float*)ap->in[10]) + (size_t)l * DM * DIN, DM, DIN, WSP(bf16_t, WS_WIN) + (size_t)l * DINP * DM, scr, r, lane); }
            else { r -= 4 * I_IN; const int l = r / I_OUT; r -= l * I_OUT; transpose_item(((const float*)ap->in[16]) + (size_t)l * DM * DM, DM, DM, WSP(bf16_t, WS_WOUT) + (size_t)l * DM * DM, scr, r, lane); }
        }
    }
    GBAR();
#pragma unroll 1
    for (int l = 0; l < DEPTH; ++l) {
        {
            FRESH();
            float* xcur = WSP(float, WS_X);
            phase_norm(l == 0 ? ((const float*)ap->in[0]) : xcur, l == 0 ? ((const float*)ap->in[1]) : xcur + (size_t)MP * DM, ((const float*)ap->in[7]) + l * DM, WSP(float, WS_MOD) + (size_t)l * 3 * DM, WSP(bf16_t, WS_HB), gw, NGW, lane);
        }
        GBAR();
        {
            FRESH();
            const bf16_t* Wi = WSP(bf16_t, WS_WIN) + (size_t)l * DINP * DM; const bf16_t* hb = WSP(bf16_t, WS_HB);
            {
                pg8::Gemm g{hb, Wi, MP, NZ, DM}; pg8::StaticOrder S; S.init(MP, NZ, G, bx);
                pg8::EpiBf16<0> E{WSP(bf16_t, WS_Z), NZ, nullptr, 0, 0, 1.f};
                pg8::gemm_phase<pg8::EpiBf16<0>, pg8::StaticOrder, true, true>(lds, g, S, E, tid);
            }
            float* zs = WSP(float, WS_ZS); float* ba = WSP(float, WS_BA);
            const int r = lane & 15, q8 = lane >> 4;
#pragma unroll 1
            for (int task = bx; task < NZ / 32; task += G) sample_gemm32(lds, hb + (size_t)MP * DM, Wi + (size_t)task * 32 * DM, zs, DINP, task * 32, tid, lane, wave);
            for (int task = wave * G + bx; task < 8 + MP / 16; task += NGW) {
                if (task < 8) { const int mt = task;
                    const f32x4 acc = skinny16(hb + (size_t)(MP + mt * 16) * DM, DM, Wi + (size_t)NZ * DM, DM, DM, lane);
#pragma unroll
                    for (int j = 0; j < 4; ++j) zs[(size_t)(mt * 16 + q8 * 4 + j) * DINP + NZ + r] = acc[j];
                } else { const int pt = task - 8;
                    const f32x4 acc = skinny16(hb + (size_t)pt * 16 * DM, DM, Wi + (size_t)NZ * DM, DM, DM, lane);
#pragma unroll
                    for (int j = 0; j < 4; ++j) ba[(size_t)(pt * 16 + q8 * 4 + j) * 16 + r] = acc[j];
                }
            }
        }
        GBAR();
        {
            FRESH();
            const bf16_t* z = WSP(bf16_t, WS_Z);
            PrepP P{z, WSP(float, WS_BA), ((const float*)ap->in[12]) + (size_t)l * 4 * 3072, ((const float*)ap->in[13]) + l * NH, ((const float*)ap->in[14]) + l * NH, WSP(unsigned char, WS_TR), WSP(float, WS_GL)};
            prep_weights(lds, P.cw, bx & 7, tid);
#pragma unroll 1
            for (int task = bx; task < NB * 32 * NH; task += G) prep_task(lds, P, task, tid, lane, wave);
        }
        GBAR();
        if (bx0 < 2 * NB * NH) {
            FRESH();
            const int pr = (bx & 7) + 8 * (bx >> 4), b = pr >> 3, h = pr & 7, half = (bx >> 3) & 1;
            ScanP P{WSP(unsigned char, WS_TR), WSP(float, WS_GL), WSP(float, WS_OB), ((float*)ap->out) + O_SP + ((size_t)(l * NB + b) * NH + h) * HD * HD};
            scan_bh(lds, P, b, h, half, tid, lane, wave);
        } else {
            FRESH();
            SampP P{WSP(float, WS_ZS), ((const float*)ap->in[2]) + (size_t)l * DECB * 2 * 1024, ((const float*)ap->in[3]) + (size_t)l * DECB * 3 * 3072, ((const float*)ap->in[4]) + (size_t)l * DECB * NH * HD * HD, ((const float*)ap->in[11]) + (size_t)l * 3 * 1024,
                    ((const float*)ap->in[12]) + (size_t)l * 4 * 3072, ((const float*)ap->in[13]) + l * NH, ((const float*)ap->in[14]) + l * NH, ((const float*)ap->in[15]) + l * HD, WSP(bf16_t, WS_YCAT), ((float*)ap->out) + O_CAS + (size_t)l * DECB * 2 * 1024,
                    ((float*)ap->out) + O_CQS + (size_t)l * DECB * 3 * 3072, ((float*)ap->out) + O_SS + (size_t)l * DECB * NH * HD * HD};
#pragma unroll 1
            for (int task = bx - 2 * NB * NH; task < DECB * NH; task += G - 2 * NB * NH) sample_task(lds, P, task, tid, lane, wave);
            { constexpr int GT2 = (G - 2 * NB * NH) * 512; const int gt2 = (bx - 2 * NB * NH) * 512 + tid; const bf16_t* z = WSP(bf16_t, WS_Z);
              conva_prompt(z, ((const float*)ap->in[11]) + (size_t)l * 3 * 1024, WSP(bf16_t, WS_YCAT), gt2, GT2);
              conv_states_prompt(z, ((float*)ap->out) + O_CAP + (size_t)l * NB * 2 * 1024, ((float*)ap->out) + O_CQP + (size_t)l * NB * 3 * 3072, gt2, GT2); }
        }
        GBAR();
        {
            FRESH();
            if (wave >= 4) onorm_pass(WSP(float, WS_OB), WSP(bf16_t, WS_Z), ((const float*)ap->in[15]) + l * HD, WSP(bf16_t, WS_YCAT), bx * 4 + (wave - 4), G * 4, lane);
            else {
                const bf16_t* Wo = WSP(bf16_t, WS_WOUT) + (size_t)l * DM * DM; const bf16_t* ycat = WSP(bf16_t, WS_YCAT); float* xcur = WSP(float, WS_X);
                const float* modg = WSP(float, WS_MOD) + (size_t)l * 3 * DM + 2 * DM;
                const int r = lane & 15, q8 = lane >> 4;
                const float* xb = l == 0 ? ((const float*)ap->in[1]) : xcur + (size_t)MP * DM;
                const int task = wave * G + bx, mt = task & 7, nt = task >> 3;
                const f32x4 acc = skinny16(ycat + (size_t)(MP + mt * 16) * DM, DM, Wo + (size_t)nt * 16 * DM, DM, DM, lane);
#pragma unroll
                for (int j = 0; j < 4; ++j) { const int row = mt * 16 + q8 * 4 + j, col = nt * 16 + r;
                    xcur[(size_t)(MP + row) * DM + col] = xb[(size_t)row * DM + col] + modg[(size_t)(NB + row) * MODLD + col] * acc[j]; }
            }
        }
        GBAR();
        {
            FRESH();
            const bf16_t* Wo = WSP(bf16_t, WS_WOUT) + (size_t)l * DM * DM; const bf16_t* ycat = WSP(bf16_t, WS_YCAT); float* xcur = WSP(float, WS_X);
            const float* modg = WSP(float, WS_MOD) + (size_t)l * 3 * DM + 2 * DM;
            {
                pg8::Gemm g{ycat, Wo, MP, DM, DM}; pg8::StaticOrder S; S.init(MP, DM, G, bx);
                EpiResGate E{l == 0 ? ((const float*)ap->in[0]) : xcur, xcur, modg, DM};
                pg8::gemm_phase<EpiResGate, pg8::StaticOrder, true, true>(lds, g, S, E, tid);
            }
        }
        GBAR();
    }
    { FRESH(); phase_final(WSP(float, WS_X), ((const float*)ap->in[17]), ((float*)ap->out), gw, NGW, lane); }
#undef FRESH
#undef GBAR
#undef WSP
}

extern "C" void kernel_launch(void* const* d_in, const int* in_sizes, int n_in, void* d_out, int out_size, void* d_ws, size_t ws_size, hipStream_t stream) {
    static int grid = 0;
    if (!grid) {
        if (n_in != 18 || (size_t)out_size != O_END || ws_size < WS_END) { fprintf(stderr, "kernel_launch: unexpected shapes (n_in %d out %d ws %zu)\n", n_in, out_size, ws_size); grid = -1; return; }
        int dev = 0, cus = 0, per_cu = 0;
        (void)hipGetDevice(&dev);
        (void)hipDeviceGetAttribute(&cus, hipDeviceAttributeMultiprocessorCount, dev);
        (void)hipFuncSetAttribute((const void*)mega, hipFuncAttributeMaxDynamicSharedMemorySize, LDS_BYTES);
        (void)hipOccupancyMaxActiveBlocksPerMultiprocessor(&per_cu, (const void*)mega, 512, LDS_BYTES);
        if (per_cu < 1) per_cu = 1;
        grid = cus * per_cu;
        if (grid != 256) { fprintf(stderr, "kernel_launch: this kernel is built for a 256-workgroup grid (256 CUs x 1), got %d\n", grid); grid = -1; return; }
        fprintf(stderr, "kernel_launch: grid %d (cus %d per_cu %d)\n", grid, cus, per_cu);
    }
    if (grid < 0) return;
    if (hipMemsetAsync((char*)d_ws + WS_CTL, 0, 16384, stream) != hipSuccess) { fprintf(stderr, "kernel_launch: memset of the barrier words failed\n"); return; }
    Args a{};
    for (int i = 0; i < 18; ++i) a.in[i] = (const float*)d_in[i];
    a.out = (float*)d_out; a.ws = (unsigned char*)d_ws;
    void* args[] = {&a};
    hipError_t e = hipLaunchCooperativeKernel((void*)mega, dim3(grid), dim3(512), args, LDS_BYTES, stream);
    if (e != hipSuccess) fprintf(stderr, "cooperative launch failed: %s (grid %d)\n", hipGetErrorString(e), grid);
}
```
